# Optimizing an MI355X kernel written in HIP

```python
import math
import jax, jax.numpy as jnp
from jax import lax
import numpy as np

D_MODEL = 1024
BATCH = 4
SEQ = 4096
DEPTH = 4

N_MIXERS = 4
GRID_W = 64
FNET_GROUPS = 4
ATTN_Q_HEADS = 8
ATTN_KV_HEADS = 4
ATTN_HEAD_DIM = D_MODEL // ATTN_Q_HEADS
ATTN_Q_BLOCK = 128
ROPE_THETA = 10000.0
S5_GROUP_CH = 16
S5_GROUPS = D_MODEL // S5_GROUP_CH
S5_STATE = 64
HG_HEAD_DIM = 128
HG_HEADS = D_MODEL // HG_HEAD_DIM
HG_CHUNK = 64
N_EXPERTS = 32
TOP_K = 4
D_EXPERT = D_MODEL
SWIGLU_LIMIT = 7.0
SWIGLU_ALPHA = 1.702
MOE_BLOCK = 128
LN_EPS = 1e-5
RMS_EPS = 1e-6
DEEPNORM_ALPHA = (2 * DEPTH) ** 0.25
DEEPNORM_BETA = (8 * DEPTH) ** -0.25

kernel_name = "hybrid_interleaved_fnet_gqa_s5_hgrn2_moe_encoder"

F32 = jnp.float32


def _layernorm(x):
    xf = x.astype(F32)
    mu = jnp.mean(xf, -1, keepdims=True)
    var = jnp.mean(jnp.square(xf - mu), -1, keepdims=True)
    return (xf - mu) * lax.rsqrt(var + LN_EPS)


def _post_norm(z, g, b):
    return (_layernorm(z) * g.astype(F32) + b.astype(F32)).astype(z.dtype)


def _rmsnorm(x, g):
    xf = x.astype(F32)
    y = xf * lax.rsqrt(jnp.mean(jnp.square(xf), -1, keepdims=True) + RMS_EPS)
    return (y * g.astype(F32)).astype(x.dtype)


def _axial_rope_tables(L):
    rows = L // GRID_W
    row = jnp.broadcast_to(jnp.arange(rows)[:, None], (rows, GRID_W)).reshape(L).astype(F32)
    col = jnp.broadcast_to(jnp.arange(GRID_W)[None, :], (rows, GRID_W)).reshape(L).astype(F32)
    axis_dim = ATTN_HEAD_DIM // 2
    inv_freq = ROPE_THETA ** (-jnp.arange(0, axis_dim, 2, dtype=F32) / axis_dim)
    ang_r = (row[:, None] * inv_freq)[:, None, :]
    ang_c = (col[:, None] * inv_freq)[:, None, :]
    return (jnp.cos(ang_r), jnp.sin(ang_r), jnp.cos(ang_c), jnp.sin(ang_c))


def _rot_half(xp, cos, sin):
    x1, x2 = jnp.split(xp, 2, axis=-1)
    return jnp.concatenate([x1 * cos - x2 * sin, x2 * cos + x1 * sin], axis=-1)


def _apply_axial_rope(x, rope):
    cr, sr, cc, sc = rope
    xf = x.astype(F32)
    half = ATTN_HEAD_DIM // 2
    out = jnp.concatenate([_rot_half(xf[..., :half], cr, sr), _rot_half(xf[..., half:], cc, sc)], axis=-1)
    return out.astype(x.dtype)


def _fnet_mixer(h, w_out, b_out):
    B, L, D = h.shape
    hg = h.astype(F32).reshape(B, L, FNET_GROUPS, D // FNET_GROUPS)
    mixed = jnp.fft.fft2(hg, axes=(1, 3), norm="ortho").real
    return mixed.reshape(B, L, D).astype(h.dtype) @ w_out + b_out


def _attention_mixer(h, w_qkv, q_gain, k_gain, w_out, rope):
    B, L, D = h.shape
    HQ, HK, DH = ATTN_Q_HEADS, ATTN_KV_HEADS, ATTN_HEAD_DIM
    GQ = HQ // HK
    qkv = h @ w_qkv
    q = qkv[..., :HQ * DH].reshape(B, L, HQ, DH)
    k = qkv[..., HQ * DH:(HQ + HK) * DH].reshape(B, L, HK, DH)
    v = qkv[..., (HQ + HK) * DH:].reshape(B, L, HK, DH)
    q = _apply_axial_rope(_rmsnorm(q, q_gain), rope)
    k = _apply_axial_rope(_rmsnorm(k, k_gain), rope)
    q = q.reshape(B, L, HK, GQ, DH).transpose(0, 2, 3, 1, 4)
    k = k.transpose(0, 2, 1, 3)
    v = v.transpose(0, 2, 1, 3)
    nblk = L // ATTN_Q_BLOCK
    qb = q.reshape(B, HK, GQ, nblk, ATTN_Q_BLOCK, DH).transpose(3, 0, 1, 2, 4, 5)
    scale = DH ** -0.5

    def block(qi):
        s = jnp.einsum('bkgqd,bksd->bkgqs', qi, k).astype(F32) * scale
        p = jax.nn.softmax(s, axis=-1).astype(v.dtype)
        return jnp.einsum('bkgqs,bksd->bkgqd', p, v)

    o = lax.map(block, qb)
    o = o.transpose(1, 0, 4, 2, 3, 5).reshape(B, L, HQ * DH)
    return o @ w_out


def _s5_combine(e1, e2):
    a1, b1 = e1
    a2, b2 = e2
    return a1 * a2, a2 * b1 + b2


def _s5_mixer(h, a_re, a_im, log_dt, b_re, b_im, c_re, c_im, d, w_glu, w_out):
    B, L, D = h.shape
    hf = h.astype(F32)
    u = hf.reshape(B, L, S5_GROUPS, S5_GROUP_CH).astype(jnp.complex64)
    y = d.astype(F32) * hf
    for direction in range(2):
        lam = lax.complex(a_re[direction].astype(F32), a_im[direction].astype(F32))
        dt = jnp.exp(log_dt[direction].astype(F32))[:, None]
        a_bar = jnp.exp(lam * dt)
        bmat = lax.complex(b_re[direction].astype(F32), b_im[direction].astype(F32))
        b_bar = ((a_bar - 1.0) / lam)[..., None] * bmat
        bu = jnp.einsum('blgc,gpc->blgp', u, b_bar)
        a_seq = jnp.broadcast_to(a_bar[None, None], (1, L, S5_GROUPS, S5_STATE))
        _, states = lax.associative_scan(_s5_combine, (a_seq, bu), axis=1, reverse=(direction == 1))
        cmat = lax.complex(c_re[direction].astype(F32), c_im[direction].astype(F32))
        y = y + jnp.einsum('blgp,gcp->blgc', states, cmat).real.reshape(B, L, D)
    y = jax.nn.gelu(y).astype(h.dtype)
    y = y * jax.nn.sigmoid(y @ w_glu)
    return y @ w_out


def _hgrn2_chunk_scan(q, k, v, log_f):
    B, H, L, dk = q.shape
    dv = v.shape[-1]
    C = HG_CHUNK
    N = L // C
    q, k, v, log_f = [t.reshape(B, H, N, C, t.shape[-1]) for t in (q, k, v, log_f)]
    b = jnp.cumsum(log_f, axis=3)
    b_last = b[:, :, :, -1:, :]
    q_dec = q * jnp.exp(b)
    att = jnp.einsum('bhncd,bhnsd->bhncs', q_dec, k * jnp.exp(-b))
    att = jnp.where(jnp.tril(jnp.ones((C, C), bool)), att, 0.0)
    o_intra = jnp.einsum('bhncs,bhnsv->bhncv', att, v)
    kv_chunk = jnp.einsum('bhncd,bhncv->bhndv', k * jnp.exp(b_last - b), v)
    decay = jnp.exp(b_last[:, :, :, 0, :])

    def step(S, inp):
        dec, kv = inp
        return dec[..., None] * S + kv, S

    S0 = jnp.zeros((B, H, dk, dv), F32)
    _, S_prev = lax.scan(step, S0, (jnp.moveaxis(decay, 2, 0), jnp.moveaxis(kv_chunk, 2, 0)))
    o_inter = jnp.einsum('bhncd,nbhdv->bhncv', q_dec, S_prev)
    return (o_intra + o_inter).reshape(B, H, L, dv)


def _hgrn2_mixer(h, w_in, lb, norm_g, w_out):
    B, L, D = h.shape
    q, f_fw, f_bw, inp, g = jnp.split(h @ w_in, 5, axis=-1)

    def heads(t):
        return t.reshape(B, L, HG_HEADS, HG_HEAD_DIM).transpose(0, 2, 1, 3).astype(F32)

    lbh = lb.astype(F32).reshape(HG_HEADS, 1, HG_HEAD_DIM)

    def gates(fraw):
        fr = heads(fraw)
        log_f = jnp.log(lbh + (1.0 - lbh) * jax.nn.sigmoid(fr))
        k = (1.0 - lbh) * jax.nn.sigmoid(-fr)
        return k, log_f

    qh = jax.nn.silu(heads(q))
    vh = heads(inp)
    k_fw, lf_fw = gates(f_fw)
    k_bw, lf_bw = gates(f_bw)
    flip = lambda t: jnp.flip(t, axis=2)
    o_fw = _hgrn2_chunk_scan(qh, k_fw, vh, lf_fw)
    o_bw = flip(_hgrn2_chunk_scan(flip(qh), flip(k_bw), flip(vh), flip(lf_bw)))
    o = (o_fw + o_bw).transpose(0, 2, 1, 3)
    o = _rmsnorm(o, norm_g.reshape(HG_HEADS, HG_HEAD_DIM)).reshape(B, L, D).astype(h.dtype)
    return (o * jax.nn.silu(g)) @ w_out


def _moe(h, w_r, b_r, w_gu, b_gu, w_down, b_down):
    B, L, D = h.shape
    N = B * L
    t = h.reshape(N, D)
    logits = (t @ w_r + b_r).astype(F32)
    top_v, top_i = lax.top_k(logits, TOP_K)
    gates = jax.nn.softmax(top_v, axis=-1)
    e_flat = top_i.reshape(-1)
    g_flat = gates.reshape(-1)
    M = N * TOP_K
    tok = jnp.arange(M, dtype=jnp.int32) // TOP_K
    order = jnp.argsort(e_flat, stable=True)
    e_s, tok_s, g_s = e_flat[order], tok[order], g_flat[order]
    gs = jnp.bincount(e_flat, length=N_EXPERTS)
    start = jnp.cumsum(gs) - gs
    ps = ((gs + MOE_BLOCK - 1) // MOE_BLOCK) * MOE_BLOCK
    pend = jnp.cumsum(ps)
    pstart = pend - ps
    dest = pstart[e_s] + jnp.arange(M, dtype=jnp.int32) - start[e_s]
    cap = M + N_EXPERTS * MOE_BLOCK
    nb = cap // MOE_BLOCK
    buf = jnp.zeros((cap, D), t.dtype).at[dest].set(t[tok_s])
    blk_e = jnp.clip(jnp.searchsorted(pend, jnp.arange(nb) * MOE_BLOCK, side='right'), 0, N_EXPERTS - 1)

    def run_block(args):
        xb, e = args
        hgu = xb @ w_gu[e] + b_gu[e]
        gate, up = jnp.split(hgu, 2, axis=-1)
        gate = jnp.minimum(gate, SWIGLU_LIMIT)
        up = jnp.clip(up, -SWIGLU_LIMIT, SWIGLU_LIMIT)
        act = (up + 1.0) * gate * jax.nn.sigmoid(SWIGLU_ALPHA * gate)
        return act @ w_down[e] + b_down[e]

    y = lax.map(run_block, (buf.reshape(nb, MOE_BLOCK, D), blk_e)).reshape(cap, D)[dest]
    out = jnp.zeros((N, D), h.dtype).at[tok_s].add(y * g_s[:, None].astype(y.dtype))
    return out.reshape(B, L, D)


def setup_inputs(seed: int = 0) -> dict:
    key = jax.random.key(seed)
    ks = list(jax.random.split(key, 48))
    D, E, F = D_MODEL, N_EXPERTS, D_EXPERT
    G, P, CH = S5_GROUPS, S5_STATE, S5_GROUP_CH

    def nrm(shape, scale):
        return jax.random.normal(ks.pop(), shape, F32) * scale

    nA, nB, nC, nD = [len(range(m, DEPTH, N_MIXERS)) for m in range(N_MIXERS)]
    w_std = D ** -0.5
    out_std = w_std * DEEPNORM_BETA
    qkv_cols = (ATTN_Q_HEADS + 2 * ATTN_KV_HEADS) * ATTN_HEAD_DIM
    n_idx = jnp.arange(P, dtype=F32)
    return {
        "x": nrm((BATCH, SEQ, D), 1.0),
        "c": nrm((BATCH, D), 1.0),
        "ada_w": nrm((DEPTH, D, 6 * D), 0.5 * w_std),
        "ada_b": nrm((DEPTH, 6 * D), 0.02),
        "post_ln_g": 1.0 + nrm((DEPTH, 2, D), 0.02),
        "post_ln_b": nrm((DEPTH, 2, D), 0.02),
        "fnet_w_out": nrm((nA, D, D), out_std),
        "fnet_b_out": nrm((nA, D), 0.02),
        "attn_w_qkv": nrm((nB, D, qkv_cols), w_std),
        "attn_q_norm": 1.0 + nrm((nB, ATTN_HEAD_DIM), 0.02),
        "attn_k_norm": 1.0 + nrm((nB, ATTN_HEAD_DIM), 0.02),
        "attn_w_out": nrm((nB, ATTN_Q_HEADS * ATTN_HEAD_DIM, D), out_std),
        "s5_a_re": -0.5 + nrm((nC, 2, G, P), 0.01),
        "s5_a_im": jnp.pi * n_idx + nrm((nC, 2, G, P), 0.01),
        "s5_log_dt": jax.random.uniform(ks.pop(), (nC, 2, G), F32, math.log(1e-3), math.log(1e-1)),
        "s5_b_re": nrm((nC, 2, G, P, CH), (2 * CH) ** -0.5),
        "s5_b_im": nrm((nC, 2, G, P, CH), (2 * CH) ** -0.5),
        "s5_c_re": nrm((nC, 2, G, CH, P), P ** -0.5),
        "s5_c_im": nrm((nC, 2, G, CH, P), P ** -0.5),
        "s5_d": nrm((nC, D), 1.0),
        "s5_w_glu": nrm((nC, D, D), w_std),
        "s5_w_out": nrm((nC, D, D), out_std),
        "hg_w_in": nrm((nD, D, 5 * D), w_std),
        "hg_lb": nrm((DEPTH, D), 0.1),
        "hg_norm": 1.0 + nrm((nD, D), 0.02),
        "hg_w_out": nrm((nD, D, D), out_std),
        "moe_w_router": nrm((DEPTH, D, E), w_std),
        "moe_b_router": nrm((DEPTH, E), 0.01),
        "moe_w_gu": nrm((DEPTH, E, D, 2 * F), w_std),
        "moe_b_gu": nrm((DEPTH, E, 2 * F), 0.02),
        "moe_w_down": nrm((DEPTH, E, F, D), F ** -0.5 * DEEPNORM_BETA),
        "moe_b_down": nrm((DEPTH, E, D), 0.02),
    }


def reference(x, c, ada_w, ada_b, post_ln_g, post_ln_b, fnet_w_out, fnet_b_out, attn_w_qkv, attn_q_norm, attn_k_norm, attn_w_out, s5_a_re, s5_a_im, s5_log_dt, s5_b_re, s5_b_im, s5_c_re, s5_c_im, s5_d, s5_w_glu, s5_w_out, hg_w_in, hg_lb, hg_norm, hg_w_out, moe_w_router, moe_b_router, moe_w_gu, moe_b_gu, moe_w_down, moe_b_down):
    dt = x.dtype
    L = x.shape[1]
    rope = _axial_rope_tables(L)
    lb_soft = jax.nn.softmax(hg_lb.astype(F32), axis=0)
    lb_all = jnp.cumsum(lb_soft, axis=0) - lb_soft[0]
    cond = jax.nn.silu(c)
    for i in range(DEPTH):
        mod = (cond @ ada_w[i] + ada_b[i])[:, None, :]
        sh1, sc1, g1, sh2, sc2, g2 = jnp.split(mod, 6, axis=-1)
        h = (_layernorm(x) * (1.0 + sc1) + sh1).astype(dt)
        m, j = i % N_MIXERS, i // N_MIXERS
        if m == 0:
            y = _fnet_mixer(h, fnet_w_out[j], fnet_b_out[j])
        elif m == 1:
            y = _attention_mixer(h, attn_w_qkv[j], attn_q_norm[j], attn_k_norm[j], attn_w_out[j], rope)
        elif m == 2:
            y = _s5_mixer(h, s5_a_re[j], s5_a_im[j], s5_log_dt[j], s5_b_re[j], s5_b_im[j], s5_c_re[j], s5_c_im[j], s5_d[j], s5_w_glu[j], s5_w_out[j])
        else:
            y = _hgrn2_mixer(h, hg_w_in[j], lb_all[i], hg_norm[j], hg_w_out[j])
        x = _post_norm(DEEPNORM_ALPHA * x + g1 * y, post_ln_g[i, 0], post_ln_b[i, 0])
        h = (_layernorm(x) * (1.0 + sc2) + sh2).astype(dt)
        y = _moe(h, moe_w_router[i], moe_b_router[i], moe_w_gu[i], moe_b_gu[i], moe_w_down[i], moe_b_down[i])
        x = _post_norm(DEEPNORM_ALPHA * x + g2 * y, post_ln_g[i, 1], post_ln_b[i, 1])
    return x
```

```cpp
#include <hip/hip_runtime.h>
#include <cstdio>
#include <cstdint>

#ifndef PROBE_KIND
#define PROBE_KIND 0
#endif
#define LAS __attribute__((address_space(3)))
#define GAS __attribute__((address_space(1)))
typedef unsigned short bf16_t;
typedef short bf16x8 __attribute__((ext_vector_type(8)));
typedef short s16x4 __attribute__((ext_vector_type(4)));
typedef float f32x2 __attribute__((ext_vector_type(2)));
typedef float f32x4 __attribute__((ext_vector_type(4)));
typedef float f32x8 __attribute__((ext_vector_type(8)));
typedef float f32x16 __attribute__((ext_vector_type(16)));
typedef unsigned u32x2 __attribute__((ext_vector_type(2)));
typedef unsigned u32x4 __attribute__((ext_vector_type(4)));

constexpr int D = 1024, NB = 4, SEQ = 4096, NTOK = NB * SEQ, DEPTH = 4;
constexpr int HQ = 8, HK = 4, DH = 128, QKVC = (HQ + 2 * HK) * DH;
constexpr int S5G = 64, S5C = 16, S5P = 64, S5T = 16, S5NCH = SEQ / S5T;
constexpr int HGH = 8, HGD = 128, HGC = 64, HGNCH = SEQ / HGC;
constexpr int NE = 32, TOPK = 4, DEX = 1024;
constexpr int CAP = NTOK * TOPK + NE * 256;
constexpr float LN_EPS = 1e-5f, RMS_EPS = 1e-6f;
constexpr float DN_ALPHA = 1.6817928305074290f;
constexpr int NWAVES = 8, NTHR = 512;
constexpr int ADA_PARTS = 2, ADA_KP = D / ADA_PARTS;

constexpr size_t MiB = 1u << 20;
constexpr size_t WS_CTL = 0, CTL_ZERO_BYTES = 64 * 1024;
constexpr size_t WS_MODP = 1 * MiB;
constexpr size_t WS_SMALL = 4 * MiB;
constexpr size_t   SM_LB = 0;
constexpr size_t   SM_AT = 8192;
constexpr size_t   SM_TILE = 131072;
constexpr size_t   SM_DFTC = 262144;
constexpr size_t WS_ROUTE = 5 * MiB;
constexpr size_t   RT_TOPI = 0, RT_TOPG = 262144, RT_DEST = 524288, RT_HIST = 786432, RT_ROWTOK = 851968;
constexpr size_t WS_WSM = 6 * MiB;
constexpr size_t   W_FNET = 0, W_QKV = 2 * MiB, W_AO = 6 * MiB, W_GLU = 8 * MiB, W_SO = 10 * MiB, W_HIN = 12 * MiB, W_HO = 22 * MiB;
constexpr size_t WS_S5M = 30 * MiB;
constexpr size_t WS_S5T = 38 * MiB;
constexpr size_t WS_DFTL = 54 * MiB;
constexpr size_t WS_WGU = 118 * MiB;
constexpr size_t WS_HGIMG = 374 * MiB;
constexpr size_t WS_WDN = 630 * MiB;
constexpr size_t WS_H = 886 * MiB;
constexpr size_t WS_Y = 918 * MiB;
constexpr size_t WS_SCR = 982 * MiB;
constexpr size_t   SC_DNO = 0, SC_BUF = 144 * MiB, SC_ACT = 216 * MiB;
constexpr size_t   SC_C1 = 0, SC_MIX = 64 * MiB;
constexpr size_t   SC_QKV = 0, SC_O = 64 * MiB;
constexpr size_t   SC_AOP = 144 * MiB, SC_SST = 208 * MiB, SC_YBF = 272 * MiB, SC_Z = 0;
constexpr size_t   SC_P = 0, SC_OFB = 160 * MiB, SC_HA = 288 * MiB;
constexpr size_t WS_X16 = 1302 * MiB;
constexpr size_t WS_END = 1334 * MiB;

typedef _Float16 h16x4 __attribute__((ext_vector_type(4)));
typedef _Float16 h16x8 __attribute__((ext_vector_type(8)));
constexpr int RING_BYTES = 131072, LDSCTL_OFF = RING_BYTES, MISC_OFF = LDSCTL_OFF + 320, LDS_BYTES = 147456;

#define RLX_AGENT __ATOMIC_RELAXED, __HIP_MEMORY_SCOPE_AGENT
#define LDS_WAIT() asm volatile("s_waitcnt lgkmcnt(0)" ::: "memory")
#define VM_WAIT() asm volatile("s_waitcnt vmcnt(0)" ::: "memory")
__device__ __forceinline__ unsigned cvt_pk_bf16(float lo, float hi) { unsigned r; asm volatile("v_cvt_pk_bf16_f32 %0, %1, %2" : "=v"(r) : "v"(lo), "v"(hi)); return r; }
__device__ __forceinline__ float bf2f(unsigned short b) { return __uint_as_float(((unsigned)b) << 16); }
__device__ __forceinline__ float bflo(unsigned w) { return __uint_as_float(w << 16); }
__device__ __forceinline__ float bfhi(unsigned w) { return __uint_as_float(w & 0xffff0000u); }
__device__ __forceinline__ unsigned short f2bf(float f) { unsigned u = __float_as_uint(f); return (unsigned short)((u + 0x7fffu + ((u >> 16) & 1u)) >> 16); }
__device__ __forceinline__ float wave_sum(float v) {
    v += __uint_as_float(__builtin_amdgcn_update_dpp(0, __float_as_uint(v), 0xB1, 0xF, 0xF, true));
    v += __uint_as_float(__builtin_amdgcn_update_dpp(0, __float_as_uint(v), 0x4E, 0xF, 0xF, true));
    v += __uint_as_float(__builtin_amdgcn_update_dpp(0, __float_as_uint(v), 0x141, 0xF, 0xF, true));
    v += __uint_as_float(__builtin_amdgcn_update_dpp(0, __float_as_uint(v), 0x140, 0xF, 0xF, true));
    { const auto r = __builtin_amdgcn_permlane16_swap(__float_as_uint(v), __float_as_uint(v), false, false); const float a = __uint_as_float(r[0]), b = __uint_as_float(r[1]); v = a + b; }
    { const auto r = __builtin_amdgcn_permlane32_swap(__float_as_uint(v), __float_as_uint(v), false, false); const float a = __uint_as_float(r[0]), b = __uint_as_float(r[1]); v = a + b; }
    return v;
}
__device__ __forceinline__ float half_wave_sum(float v) {
    v += __uint_as_float(__builtin_amdgcn_update_dpp(0, __float_as_uint(v), 0xB1, 0xF, 0xF, true));
    v += __uint_as_float(__builtin_amdgcn_update_dpp(0, __float_as_uint(v), 0x4E, 0xF, 0xF, true));
    v += __uint_as_float(__builtin_amdgcn_update_dpp(0, __float_as_uint(v), 0x141, 0xF, 0xF, true));
    v += __uint_as_float(__builtin_amdgcn_update_dpp(0, __float_as_uint(v), 0x140, 0xF, 0xF, true));
    { const auto r = __builtin_amdgcn_permlane16_swap(__float_as_uint(v), __float_as_uint(v), false, false); const float a = __uint_as_float(r[0]), b = __uint_as_float(r[1]); v = a + b; }
    return v;
}
__device__ __forceinline__ float frcp(float x) { return __builtin_amdgcn_rcpf(x); }
__device__ __forceinline__ float sigmoidf_(float x) { return frcp(1.f + __builtin_amdgcn_exp2f(x * -1.4426950408889634f)); }
__device__ __forceinline__ float siluf_(float x) { return x * sigmoidf_(x); }
__device__ __forceinline__ int lane_now() { int l; asm volatile("v_mbcnt_lo_u32_b32 %0, -1, 0\n\tv_mbcnt_hi_u32_b32 %0, -1, %0" : "=v"(l)); return l; }
__device__ __forceinline__ int tid_from(int wave) { return wave * 64 + lane_now(); }
#ifndef Q8_MODE
#define Q8_MODE 0
#endif
__device__ __forceinline__ float q8(float x, float s) { const int p = __builtin_amdgcn_cvt_pk_fp8_f32(x * s, x * s, 0, false); return __builtin_amdgcn_cvt_f32_fp8(p, 0) * (1.0f / s); }
constexpr float S8_H = 16.f, S8_WGU = 256.f, S8_ACT = 4.f, S8_WDN = 512.f, S8_Y = 32.f;
__device__ __forceinline__ float sat8(float a) { return __builtin_amdgcn_fmed3f(a, -448.f, 448.f); }
__device__ __forceinline__ unsigned pk4_fp8(float a, float b, float c, float d) { int w = __builtin_amdgcn_cvt_pk_fp8_f32(sat8(a), sat8(b), 0, false); w = __builtin_amdgcn_cvt_pk_fp8_f32(sat8(c), sat8(d), w, true); return (unsigned)w; }
namespace pg8 {
constexpr int BIAS_LDS_OFF = 131072 + 1024;
constexpr int BM = 256, BK = 64, HALF = 128, HTB = HALF * BK * 2, STAGE_BYTES = 8 * HTB, NXCD = 8, WGM = 8;
__host__ __device__ __forceinline__ int lds_byte(int r, int c) { const int st = (r >> 4) * 2 + (c >> 5), rr = r & 15, cc = c & 31, ob = rr * 64 + cc * 2; return st * 1024 + (ob ^ (((ob >> 9) & 1) << 5)); }
__host__ __device__ __forceinline__ void stage_rc(int b, int& R, int& C) { const int st = b / 1024, sb = b % 1024, swz = sb ^ (((sb >> 9) & 1) << 5); R = (st >> 1) * 16 + swz / 64; C = (st & 1) * 32 + (swz % 64) / 2; }
__host__ __device__ __forceinline__ int perm32(int rho) { const int n = rho >> 4, i = rho & 15; return 8 * (i >> 2) + 4 * n + (i & 3); }

struct Unit { int pm, pn, z; size_t aoff, boff, ooff; };
struct Gemm { const char* A; const char* Bt; int lda, ldb, K; int kstepA = 128, kstepB = 128; };

template <class Map> struct Order {
    int nM, nN, per, total, G, c; Map mp;
    __device__ void init(int nM_, int nN_, int nz, int G_, int c_, const Map& m) { nM = nM_; nN = nN_; per = nM * nN; total = per * nz; G = G_; c = c_; mp = m; }
    __device__ bool next(int i, Unit& u) const {
        const long L = (long)i * G + c; if (L >= total) return false;
        int id = (int)L; { const int q = total / NXCD, r = total % NXCD, xcd = id % NXCD, off = id / NXCD; id = (xcd < r ? xcd * (q + 1) : r * (q + 1) + (xcd - r) * q) + off; }
        const int z = id / per, w = id - z * per;
        const int nig = WGM * nN, gid = w / nig, fm = gid * WGM, gsz = (nM - fm) < WGM ? (nM - fm) : WGM;
        u.pm = fm + ((w % nig) % gsz); u.pn = (w % nig) / gsz; u.z = z; mp(u); return true;
    }
};

typedef int v4i_t __attribute__((ext_vector_type(4)));
typedef int v8i_t __attribute__((ext_vector_type(8)));
template <class Epi, class Sched, bool FP8 = false, bool AIND = false>
__device__ __forceinline__ void gemm_phase(LAS unsigned char* lds, const int wave, const Gemm g, const Sched& S, const Epi& E, const LAS unsigned short* tbl = nullptr) {
    const int wid = wave, lane = lane_now(), tid = wid * 64 + lane, wr = wid >> 2, wc = wid & 3, fr = lane & 15, fq = lane >> 4;
    const int K = g.K, nt = K / BK;
    unsigned voffA[2], voffB[2];
#pragma unroll
    for (int i = 0; i < 2; ++i) { int R, C; stage_rc(tid * 16 + i * 8192, R, C); const int Rb = Epi::PERM ? ((R & ~31) + perm32(R & 31)) : R;
        voffA[i] = (unsigned)(R * g.lda + C) * 2u; voffB[i] = (unsigned)(Rb * g.ldb + C) * 2u; }
    const size_t kstepA = (size_t)g.kstepA, kstepB = (size_t)g.kstepB;
    int aR[2], aC[2];
#pragma unroll
    for (int i = 0; i < 2; ++i) stage_rc(tid * 16 + i * 8192, aR[i], aC[i]);
    unsigned voA[2][2], vnA[2][2];
#define PG8_AOFFS(dst, ui_) do { _Pragma("unroll") for (int h_ = 0; h_ < 2; ++h_) _Pragma("unroll") for (int i_ = 0; i_ < 2; ++i_) dst[h_][i_] = (unsigned)tbl[(ui_) * 256 + h_ * 128 + aR[i_]] * 1024u + (unsigned)aC[i_] * 2u; } while (0)
#define PG8_STAGEA(bufoff, ptr, h, nx) do { if constexpr (AIND) { const unsigned vv_[2] = {(nx) ? vnA[h][0] : voA[h][0], (nx) ? vnA[h][1] : voA[h][1]}; PG8_STAGE(bufoff, ptr, vv_); } else PG8_STAGE(bufoff, (ptr) + (h) * hstepA, voffA); } while (0)
    const size_t hstepA = (size_t)HALF * g.lda * 2, hstepB = (size_t)HALF * g.ldb * 2;
    const unsigned ldsw = (unsigned)wid * 1024u;
    const int aoff = lds_byte(wr * 64 + fr, fq * 8), boff = lds_byte(wc * 32 + fr, fq * 8);
#define PG8_SA(b, h) (((b) * 2 + (h)) * HTB)
#define PG8_SB(b, h) ((4 + (b) * 2 + (h)) * HTB)
#define PG8_STAGE(bufoff, gbase, voff) do { _Pragma("unroll") for (int _i = 0; _i < 2; ++_i) \
        __builtin_amdgcn_global_load_lds((const unsigned*)((const char*)(gbase) + (voff)[_i]), (LAS unsigned*)(lds + (bufoff) + ldsw + _i * 8192), 16, 0, 0); } while (0)
#define PG8_LD8(base_) __builtin_shufflevector(*(const LAS v4i_t*)(base_), *(const LAS v4i_t*)((base_) + 1024), 0, 1, 2, 3, 4, 5, 6, 7)
#define PG8_LDA(dst, b, h) do { _Pragma("unroll") for (int m = 0; m < 4; ++m) dst[m] = PG8_LD8(lds + PG8_SA(b, h) + aoff + m * 2048); } while (0)
#define PG8_LDB(dst, b, h) do { _Pragma("unroll") for (int n = 0; n < 2; ++n) dst[n] = PG8_LD8(lds + PG8_SB(b, h) + boff + n * 2048); } while (0)
#define PG8_HALF(v, k) __builtin_bit_cast(bf16x8, (k) ? __builtin_shufflevector(v, v, 4, 5, 6, 7) : __builtin_shufflevector(v, v, 0, 1, 2, 3))
#define PG8_MMA(ai, bj, At, Bt) do { __builtin_amdgcn_s_setprio(1); \
        if constexpr (FP8) { _Pragma("unroll") for (int m = 0; m < 4; ++m) _Pragma("unroll") for (int n = 0; n < 2; ++n) \
            asm volatile("v_mfma_f32_16x16x128_f8f6f4 %0, %1, %2, %0" : "+v"(acc[ai][bj][m][n]) : "v"(Bt[n]), "v"(At[m])); } \
        else { _Pragma("unroll") for (int m = 0; m < 4; ++m) _Pragma("unroll") for (int n = 0; n < 2; ++n) _Pragma("unroll") for (int k = 0; k < 2; ++k) \
            acc[ai][bj][m][n] = __builtin_amdgcn_mfma_f32_16x16x32_bf16(PG8_HALF(Bt[n], k), PG8_HALF(At[m], k), acc[ai][bj][m][n], 0, 0, 0); } \
        __builtin_amdgcn_s_setprio(0); } while (0)
#define PG8_WAIT_V(n) asm volatile("s_waitcnt vmcnt(" #n ")" ::: "memory")
#define PG8_WAIT_L(n) asm volatile("s_waitcnt lgkmcnt(" #n ")" ::: "memory")
#define PG8_BAR __builtin_amdgcn_s_barrier()
#define PG8_SCHED __builtin_amdgcn_sched_barrier(0)
    Unit cur, nxt; int ui = 0;
    if (!S.next(0, cur)) return;
    f32x4 acc[2][2][4][2];
#pragma unroll
    for (int a = 0; a < 2; ++a)
#pragma unroll
        for (int b = 0; b < 2; ++b)
#pragma unroll
            for (int m = 0; m < 4; ++m)
#pragma unroll
                for (int n = 0; n < 2; ++n) acc[a][b][m][n] = (f32x4){0.f, 0.f, 0.f, 0.f};
    v8i_t At[4], B0[2], B1[2];
    const char* cA = g.A + cur.aoff; const char* cB = g.Bt + cur.boff;
    if constexpr (AIND) { PG8_AOFFS(voA, 0); }
    PG8_STAGE(PG8_SB(0, 0), cB, voffB); PG8_STAGE(PG8_SB(0, 1), cB + hstepB, voffB); PG8_STAGEA(PG8_SA(0, 0), cA, 0, false); PG8_STAGEA(PG8_SA(0, 1), cA, 1, false);
    if (wr == 1) PG8_BAR;
    PG8_WAIT_V(2); PG8_BAR;
    PG8_STAGE(PG8_SB(1, 0), cB + kstepB, voffB); PG8_STAGEA(PG8_SA(1, 0), cA + kstepA, 0, false); PG8_STAGE(PG8_SB(1, 1), cB + hstepB + kstepB, voffB);
    PG8_WAIT_V(6); PG8_BAR;
    for (;;) {
        const bool has_next = S.next(ui + 1, nxt);
        const char* nA = has_next ? g.A + nxt.aoff : cA; const char* nB = has_next ? g.Bt + nxt.boff : cB;
        if constexpr (AIND) { if (has_next) { PG8_AOFFS(vnA, ui + 1); } else { _Pragma("unroll") for (int h_ = 0; h_ < 2; ++h_) _Pragma("unroll") for (int i_ = 0; i_ < 2; ++i_) vnA[h_][i_] = voA[h_][i_]; } }
#pragma nounroll
        for (int t = 0; t < nt; t += 2) {
            const bool last = (t == nt - 2);
            const char* a1 = cA + (size_t)(t + 1) * kstepA;
            const char* a2 = last ? nA : cA + (size_t)(t + 2) * kstepA; const char* b2 = last ? nB : cB + (size_t)(t + 2) * kstepB;
            const char* a3 = a2 + kstepA; const char* b3 = b2 + kstepB;
            if constexpr (Epi::BIAS_LDS) { if (last) __builtin_amdgcn_global_load_lds((const unsigned*)E.bias_ptr(cur, lane), (LAS unsigned*)(lds + BIAS_LDS_OFF + wid * 1024), 16, 0, 0); }
            PG8_LDB(B0, 0, 0); PG8_LDB(B1, 0, 1); PG8_SCHED; PG8_LDA(At, 0, 0); PG8_STAGEA(PG8_SA(1, 1), a1, 1, false);
            PG8_WAIT_V(8); PG8_WAIT_L(0); PG8_BAR; PG8_MMA(0, 0, At, B0); PG8_MMA(0, 1, At, B1); PG8_BAR; PG8_SCHED;
            PG8_LDA(At, 0, 1); PG8_STAGE(PG8_SB(0, 0), b2, voffB); PG8_STAGE(PG8_SB(0, 1), b2 + hstepB, voffB); PG8_STAGEA(PG8_SA(0, 0), a2, 0, last);
            PG8_WAIT_V(8); PG8_WAIT_L(0); PG8_BAR; PG8_MMA(1, 0, At, B0); PG8_MMA(1, 1, At, B1); PG8_BAR; PG8_SCHED;
            PG8_LDB(B0, 1, 0); PG8_LDB(B1, 1, 1); PG8_SCHED; PG8_LDA(At, 1, 0); PG8_STAGEA(PG8_SA(0, 1), a2, 1, last);
            PG8_WAIT_V(8); PG8_WAIT_L(0); PG8_BAR; PG8_MMA(0, 0, At, B0); PG8_MMA(0, 1, At, B1); PG8_BAR; PG8_SCHED;
            PG8_LDA(At, 1, 1); PG8_STAGE(PG8_SB(1, 0), b3, voffB); PG8_STAGE(PG8_SB(1, 1), b3 + hstepB, voffB); PG8_STAGEA(PG8_SA(1, 0), a3, 0, last);
            PG8_WAIT_V(8); PG8_WAIT_L(0); PG8_BAR; PG8_MMA(1, 0, At, B0); PG8_MMA(1, 1, At, B1); PG8_BAR; PG8_SCHED;
        }
        if (wr == 0) PG8_BAR;
        if constexpr (FP8) asm volatile("s_nop 15\n\ts_nop 15" ::: "memory");
        { const int t2_ = lane_now(), fr_ = t2_ & 15, fq_ = (t2_ >> 4) & 3; const LAS float* bl_ = (const LAS float*)(lds + BIAS_LDS_OFF + wid * 1024); E(acc, cur, wr, wc, fr_, fq_, bl_);
#if defined(PROBE_KIND)
          if (PROBE_KIND == 12) { asm volatile("" ::: "memory"); E(acc, cur, wr, wc, fr_, fq_, bl_); }
#endif
        }
        if (!has_next) break;
#pragma unroll
        for (int a = 0; a < 2; ++a)
#pragma unroll
            for (int b = 0; b < 2; ++b)
#pragma unroll
                for (int m = 0; m < 4; ++m)
#pragma unroll
                    for (int n = 0; n < 2; ++n) acc[a][b][m][n] = (f32x4){0.f, 0.f, 0.f, 0.f};
        cur = nxt; cA = nA; cB = nB; ++ui;
        if constexpr (AIND) { _Pragma("unroll") for (int h_ = 0; h_ < 2; ++h_) _Pragma("unroll") for (int i_ = 0; i_ < 2; ++i_) voA[h_][i_] = vnA[h_][i_]; }
        if (wr == 1) PG8_BAR;
    }
    PG8_WAIT_V(0);
    PG8_BAR;
#undef PG8_SA
#undef PG8_SB
#undef PG8_STAGE
#undef PG8_STAGEA
#undef PG8_AOFFS
#undef PG8_LDA
#undef PG8_LD8
#undef PG8_HALF
#undef PG8_LDB
#undef PG8_MMA
#undef PG8_WAIT_V
#undef PG8_WAIT_L
#undef PG8_BAR
#undef PG8_SCHED
}

__device__ __forceinline__ u32x4 pack8(const f32x4& v0, const f32x4& v1) { u32x4 w; w.x = cvt_pk_bf16(v0[0], v0[1]); w.y = cvt_pk_bf16(v0[2], v0[3]); w.z = cvt_pk_bf16(v1[0], v1[1]); w.w = cvt_pk_bf16(v1[2], v1[3]); return w; }
}
using pg8::Unit;
typedef f32x4 AccT[2][2][4][2];

template <bool HAS_BIAS> struct EpiBf16T {
    static constexpr bool PERM = true, BIAS_LDS = HAS_BIAS;
    bf16_t* O; int ldc; float scale = 1.f; const float* bias = nullptr;
    __device__ __forceinline__ const float* bias_ptr(const Unit& u, int lane) const { return bias + u.pn * 256 + 4 * lane; }
    __device__ __forceinline__ void operator()(const AccT& acc, const Unit& u, int wr, int wc, int fr, int fq, const LAS float* bl) const {
        bf16_t* base = O + u.ooff + (size_t)(wr * 64 + fr) * ldc + wc * 32 + 8 * fq;
        f32x4 b0[2], b1[2];
#pragma unroll
        for (int bj = 0; bj < 2; ++bj) { b0[bj] = HAS_BIAS ? *(const LAS f32x4*)(bl + bj * 128 + wc * 32 + 8 * fq) : (f32x4){0.f, 0.f, 0.f, 0.f}; b1[bj] = HAS_BIAS ? *(const LAS f32x4*)(bl + bj * 128 + wc * 32 + 8 * fq + 4) : (f32x4){0.f, 0.f, 0.f, 0.f}; }
#pragma unroll
        for (int ai = 0; ai < 2; ++ai)
#pragma unroll
            for (int m = 0; m < 4; ++m) { bf16_t* rowp = base + (size_t)(ai * 128 + m * 16) * ldc;
#pragma unroll
                for (int bj = 0; bj < 2; ++bj) *(u32x4*)(rowp + bj * 128) = pg8::pack8(acc[ai][bj][m][0] * scale + b0[bj], acc[ai][bj][m][1] * scale + b1[bj]); }
    }
};
typedef EpiBf16T<false> EpiBf16;
typedef EpiBf16T<true> EpiBf16B;
template <bool HAS_BIAS> struct EpiF32T {
    static constexpr bool PERM = false, BIAS_LDS = HAS_BIAS;
    float* C; int ldc; const float* bias;
    __device__ __forceinline__ const float* bias_ptr(const Unit& u, int lane) const { return bias + u.pn * 256 + 4 * lane; }
    __device__ __forceinline__ void operator()(const AccT& acc, const Unit& u, int wr, int wc, int fr, int fq, const LAS float* bl) const {
        const int col0 = wc * 32 + 4 * fq;
        f32x4 bv[2][2];
#pragma unroll
        for (int bj = 0; bj < 2; ++bj)
#pragma unroll
            for (int n = 0; n < 2; ++n) bv[bj][n] = HAS_BIAS ? *(const LAS f32x4*)(bl + col0 + bj * 128 + n * 16) : (f32x4){0.f, 0.f, 0.f, 0.f};
        float* base = C + u.ooff + (size_t)(wr * 64 + fr) * ldc + col0;
#pragma unroll
        for (int ai = 0; ai < 2; ++ai)
#pragma unroll
            for (int m = 0; m < 4; ++m) { float* rowp = base + (size_t)(ai * 128 + m * 16) * ldc;
#pragma unroll
                for (int bj = 0; bj < 2; ++bj)
#pragma unroll
                    for (int n = 0; n < 2; ++n) *(f32x4*)(rowp + bj * 128 + n * 16) = acc[ai][bj][m][n] + bv[bj][n]; }
    }
};
typedef EpiF32T<false> EpiF32;
typedef EpiF32T<true> EpiF32B;
__device__ __forceinline__ float gelu_tanh(float x) {
    const float u = 0.7978845608028654f * (x + 0.044715f * x * x * x);
    const float t = 1.f - 2.f * frcp(1.f + __builtin_amdgcn_exp2f(u * 2.8853900817779268f));
    return 0.5f * x * (1.f + t);
}
struct EpiS5Out {
    static constexpr bool PERM = true, BIAS_LDS = false;
    bf16_t* O;
    __device__ __forceinline__ void operator()(const AccT& acc, const Unit& u, int wr, int wc, int fr, int fq, const LAS float* bl) const {
        const int g = u.z, b = u.pm;
#pragma unroll
        for (int ai = 0; ai < 2; ++ai)
#pragma unroll
            for (int m = 0; m < 4; ++m) { const int j = ai * 128 + wr * 64 + m * 16 + fr;
#pragma unroll
                for (int bj = 0; bj < 2; ++bj) { const int col = bj * 128 + wc * 32 + 8 * fq, t = col >> 4, c8 = col & 15;
                    f32x4 v0 = acc[ai][bj][m][0], v1 = acc[ai][bj][m][1];
#pragma unroll
                    for (int i = 0; i < 4; ++i) { v0[i] = gelu_tanh(v0[i]); v1[i] = gelu_tanh(v1[i]); }
                    *(u32x4*)(O + ((size_t)(b * SEQ + j * 16 + t)) * D + g * 16 + c8) = pg8::pack8(v0, v1); } }
    }
};
struct EpiGlu {
    static constexpr bool PERM = true, BIAS_LDS = false;
    const bf16_t* Yb; bf16_t* Z;
    __device__ __forceinline__ void operator()(const AccT& acc, const Unit& u, int wr, int wc, int fr, int fq, const LAS float* bl) const {
        const size_t base = u.ooff + (size_t)(wr * 64 + fr) * D + wc * 32 + 8 * fq;
#pragma unroll
        for (int ai = 0; ai < 2; ++ai)
#pragma unroll
            for (int m = 0; m < 4; ++m) {
#pragma unroll
                for (int bj = 0; bj < 2; ++bj) { const size_t off = base + (size_t)(ai * 128 + m * 16) * D + bj * 128;
                    const u32x4 yw = *(const u32x4*)(Yb + off);
                    f32x4 v0 = acc[ai][bj][m][0], v1 = acc[ai][bj][m][1];
                    v0[0] = bflo(yw.x) * sigmoidf_(v0[0]); v0[1] = bfhi(yw.x) * sigmoidf_(v0[1]); v0[2] = bflo(yw.y) * sigmoidf_(v0[2]); v0[3] = bfhi(yw.y) * sigmoidf_(v0[3]);
                    v1[0] = bflo(yw.z) * sigmoidf_(v1[0]); v1[1] = bfhi(yw.z) * sigmoidf_(v1[1]); v1[2] = bflo(yw.w) * sigmoidf_(v1[2]); v1[3] = bfhi(yw.w) * sigmoidf_(v1[3]);
                    *(u32x4*)(Z + off) = pg8::pack8(v0, v1); } }
    }
};
struct EpiMoeGU {
    static constexpr bool PERM = true, BIAS_LDS = true;
    __device__ __forceinline__ const float* bias_ptr(const Unit& u, int lane) const { return bgu + (size_t)u.z * 2048 + u.pn * 128 + (lane < 32 ? 4 * lane : 1024 + 4 * (lane - 32)); }
    unsigned char* ACT; const float* bgu;
    __device__ __forceinline__ void operator()(const AccT& acc, const Unit& u, int wr, int wc, int fr, int fq, const LAS float* bl) const {
        const int f0 = u.pn * 128 + wc * 32 + 8 * fq;
        const LAS float* bg = bl + wc * 32 + 8 * fq;
        const f32x4 bg0 = *(const LAS f32x4*)bg, bg1 = *(const LAS f32x4*)(bg + 4), bu0 = *(const LAS f32x4*)(bg + 128) + 1.f, bu1 = *(const LAS f32x4*)(bg + 132) + 1.f;
        unsigned char* base = ACT + (size_t)u.pm * 262144 + (size_t)u.pn * 32768 + (wr * 64 + fr) * 128 + wc * 32 + 8 * fq;
        constexpr float SC = 1.0f / (S8_H * S8_WGU), C1 = -1.702f * 1.4426950408889634f, Q = 1.0f / S8_ACT;
#define GU1(G, U) do { const float ga_ = fminf((G), 7.f), up1_ = __builtin_amdgcn_fmed3f((U), -6.f, 8.f), e_ = __builtin_amdgcn_exp2f(ga_ * C1); (G) = (ga_ * up1_) * frcp(__builtin_fmaf(e_, Q, Q)); } while (0)
#pragma unroll
        for (int ai = 0; ai < 2; ++ai)
#pragma unroll
            for (int m = 0; m < 4; ++m) {
                f32x4 g0 = acc[ai][0][m][0] * SC + bg0, g1 = acc[ai][0][m][1] * SC + bg1, u0 = acc[ai][1][m][0] * SC + bu0, u1 = acc[ai][1][m][1] * SC + bu1;
#pragma unroll
                for (int i = 0; i < 4; ++i) { GU1(g0[i], u0[i]); GU1(g1[i], u1[i]); }
                int w0 = __builtin_amdgcn_cvt_pk_fp8_f32(g0[0], g0[1], 0, false); w0 = __builtin_amdgcn_cvt_pk_fp8_f32(g0[2], g0[3], w0, true);
                int w1 = __builtin_amdgcn_cvt_pk_fp8_f32(g1[0], g1[1], 0, false); w1 = __builtin_amdgcn_cvt_pk_fp8_f32(g1[2], g1[3], w1, true);
                *(u32x2*)(base + (ai * 128 + m * 16) * 128) = (u32x2){(unsigned)w0, (unsigned)w1}; }
#undef GU1
    }
};
struct EpiMoeDown {
    static constexpr bool PERM = true, BIAS_LDS = true;
    __device__ __forceinline__ const float* bias_ptr(const Unit& u, int lane) const { return bdn + (size_t)u.z * 1024 + u.pn * 256 + 4 * lane; }
    unsigned char* YB; const float* bdn;
    __device__ __forceinline__ void operator()(const AccT& acc, const Unit& u, int wr, int wc, int fr, int fq, const LAS float* bl) const {
        const int c0 = u.pn * 256 + wc * 32 + 8 * fq;
        const LAS float* bp = bl + wc * 32 + 8 * fq;
        f32x4 b0[2], b1[2];
#pragma unroll
        for (int bj = 0; bj < 2; ++bj) { b0[bj] = *(const LAS f32x4*)(bp + bj * 128) * S8_Y; b1[bj] = *(const LAS f32x4*)(bp + bj * 128 + 4) * S8_Y; }
        unsigned char* base = YB + (size_t)(u.pm * 256 + wr * 64 + fr) * D + c0;
        constexpr float SC = S8_Y / (S8_ACT * S8_WDN);
#pragma unroll
        for (int ai = 0; ai < 2; ++ai)
#pragma unroll
            for (int m = 0; m < 4; ++m) { unsigned char* rowp = base + (size_t)(ai * 128 + m * 16) * D;
#pragma unroll
                for (int bj = 0; bj < 2; ++bj) { const f32x4 v0 = acc[ai][bj][m][0] * SC + b0[bj], v1 = acc[ai][bj][m][1] * SC + b1[bj];
                    *(u32x2*)(rowp + bj * 128) = (u32x2){pk4_fp8(v0[0], v0[1], v0[2], v0[3]), pk4_fp8(v1[0], v1[1], v1[2], v1[3])}; } }
    }
};

struct EpiQKV {
    static constexpr bool PERM = true, BIAS_LDS = false;
    bf16_t* O; float scale; const float* qg; const float* kg; const LAS unsigned* cs2;
    __device__ __forceinline__ void operator()(const AccT& acc, const Unit& u, int wr, int wc, int fr, int fq, const LAS float* bl) const {
        bf16_t* base = O + u.ooff + (size_t)(wr * 64 + fr) * QKVC + wc * 32 + 8 * fq;
#pragma unroll
        for (int ai = 0; ai < 2; ++ai)
#pragma unroll
            for (int m = 0; m < 4; ++m) { bf16_t* rowp = base + (size_t)(ai * 128 + m * 16) * QKVC;
#pragma unroll
                for (int bj = 0; bj < 2; ++bj) *(u32x4*)(rowp + bj * 128) = pg8::pack8(acc[ai][bj][m][0] * scale, acc[ai][bj][m][1] * scale); }
        if (u.pn >= 6) return;
        asm volatile("s_waitcnt vmcnt(0)" ::: "memory");
        __builtin_amdgcn_s_barrier();
        __builtin_amdgcn_fence(__ATOMIC_ACQUIRE, "agent"); asm volatile("s_waitcnt vmcnt(0)" ::: "memory");
        const int lane = lane_now(), w = wr * 4 + wc, hd = lane >> 5, lp = lane & 31, hs = lp >> 4, i2 = (lp & 15) * 2;
        const float* gn = (u.pn < 4) ? qg : kg;
        const float ga0 = gn[hs * 64 + i2], ga1 = gn[hs * 64 + i2 + 1], gb0 = gn[hs * 64 + 32 + i2], gb1 = gn[hs * 64 + 32 + i2 + 1];
        bf16_t* tp = O + u.ooff + (size_t)(32 * w) * QKVC + hd * 128 + hs * 64 + i2;
        const int row0 = u.pm * 256 + 32 * w;
#pragma unroll 1
        for (int rb8 = 0; rb8 < 32; rb8 += 8) { unsigned xa[8], xb[8];
#pragma unroll
            for (int q = 0; q < 8; ++q) { const bf16_t* p = tp + (size_t)(rb8 + q) * QKVC; xa[q] = *(const unsigned*)p; xb[q] = *(const unsigned*)(p + 32); }
#pragma unroll
            for (int q = 0; q < 8; ++q) { const int l = (row0 + rb8 + q) & (SEQ - 1), pos = hs ? (l & 63) : (l >> 6);
                const float a0 = bflo(xa[q]), a1 = bfhi(xa[q]), b0 = bflo(xb[q]), b1 = bfhi(xb[q]);
                const float ss = half_wave_sum((a0 * a0 + a1 * a1) + (b0 * b0 + b1 * b1)), r = __builtin_amdgcn_rsqf(ss * (1.f / 128.f) + RMS_EPS);
                const unsigned c0 = cs2[pos * 32 + i2], c1 = cs2[pos * 32 + i2 + 1];
                const float ya0 = a0 * r * ga0, ya1 = a1 * r * ga1, yb0 = b0 * r * gb0, yb1 = b1 * r * gb1;
                bf16_t* p = tp + (size_t)(rb8 + q) * QKVC;
                *(unsigned*)p = cvt_pk_bf16(ya0 * bflo(c0) - yb0 * bfhi(c0), ya1 * bflo(c1) - yb1 * bfhi(c1));
                *(unsigned*)(p + 32) = cvt_pk_bf16(yb0 * bflo(c0) + ya0 * bfhi(c0), yb1 * bflo(c1) + ya1 * bfhi(c1)); } }
    }
};

struct EpiNull {
    static constexpr bool PERM = true, BIAS_LDS = false;
    __device__ __forceinline__ void operator()(const AccT& acc, const Unit& u, int wr, int wc, int fr, int fq, const LAS float* bl) const {}
};

struct MapPlain {
    int lda, ldb, ldc;
    __device__ __forceinline__ void operator()(Unit& u) const { u.aoff = (size_t)u.pm * 256 * lda * 2; u.boff = (size_t)u.pn * 256 * ldb * 2; u.ooff = (size_t)u.pm * 256 * ldc + u.pn * 256; }
};
struct MapF1 {
    __device__ __forceinline__ void operator()(Unit& u) const { u.aoff = ((size_t)(u.pm >> 3) * 4096 + (u.pm & 7) * 256) * SEQ; u.boff = ((size_t)u.z * D + u.pn * 256) * SEQ;
        u.ooff = (((size_t)u.z * SEQ + (u.pm & 7) * 256) * 4 + u.pn) * 512 + (u.pm >> 3) * 256; }
};
struct MapF2h {
    __device__ __forceinline__ void operator()(Unit& u) const { const int b = u.pm / 33, t = u.pm - b * 33; const size_t row0 = (size_t)b * 16384 + 256 * t; u.aoff = row0 * 512 * 2; u.boff = 0; u.ooff = row0 * 256; u.z = t; }
};
struct EpiF2 {
    static constexpr bool PERM = true, BIAS_LDS = false;
    bf16_t* O;
    __device__ __forceinline__ const float* bias_ptr(const Unit& u, int lane) const { return nullptr; }
    __device__ __forceinline__ void operator()(const AccT& acc, const Unit& u, int wr, int wc, int fr, int fq, const LAS float* bl) const {
        const int c0 = wc * 32 + 8 * fq;
#pragma unroll
        for (int ai = 0; ai < 2; ++ai)
#pragma unroll
            for (int m = 0; m < 4; ++m) { const int r = ai * 128 + wr * 64 + m * 16 + fr, lq = u.z * 64 + (r >> 2);
                if (lq <= 2048) { bf16_t* rowp = O + u.ooff + (size_t)r * 256; bf16_t* mir = rowp + (size_t)(4096 - 2 * lq) * 1024; const bool hasm = lq > 0 && lq < 2048;
#pragma unroll
                    for (int bj = 0; bj < 2; ++bj) { const int cb = bj * 128 + c0; const u32x4 w = pg8::pack8(acc[ai][bj][m][0], acc[ai][bj][m][1]);
                        *(u32x4*)(rowp + cb) = w;
                        if (hasm) { unsigned short* mp = (unsigned short*)mir;
                            mp[(256 - cb) & 255] = (unsigned short)(w.x & 0xffffu);
                            mp[249 - cb] = (unsigned short)(w.w >> 16);
                            *(unsigned*)(mp + 250 - cb) = (w.w & 0xffffu) | (w.z & 0xffff0000u);
                            *(unsigned*)(mp + 252 - cb) = (w.z & 0xffffu) | (w.y & 0xffff0000u);
                            *(unsigned*)(mp + 254 - cb) = (w.y & 0xffffu) | (w.x & 0xffff0000u); } } } }
    }
};
struct MapS5 {
    int ldb;
    __device__ __forceinline__ void operator()(Unit& u) const { u.aoff = ((size_t)u.z * 1024 + u.pm * 256) * 512 * 2; u.boff = (size_t)u.z * 256 * ldb * 2; u.ooff = ((size_t)u.z * 1024 + u.pm * 256) * 256; }
};
struct MapMoe {
    const LAS int* tile_e; size_t wbase; int nrows; int a_tiled = 1; int probe = 0;
    __device__ __forceinline__ void operator()(Unit& u) const { const int e = __builtin_amdgcn_readfirstlane(tile_e[u.pm]); u.z = e; u.aoff = a_tiled ? (size_t)u.pm * 256 * 1024 : 0; u.boff = wbase + ((size_t)e * nrows + u.pn * 256) * 1024; u.ooff = 0;
        if (probe == 1) u.boff = wbase; }
};
constexpr int TILE_LDS_OFF = 131072 + 1024 + 8192;
constexpr int ROWTBL_LDS_OFF = TILE_LDS_OFF + 1280, ROWTBL_MAXU = 10;
static_assert(ROWTBL_LDS_OFF + ROWTBL_MAXU * 512 <= LDS_BYTES, "LDS map");
namespace att {
constexpr int NW = 8, QBLK = 32, KVBLK = 64;
constexpr float SCALE = 0.088388347648318440f;
constexpr float THR = 8.f;
constexpr int LDQ = QKVC, LDK = QKVC, LDO = D;
constexpr size_t SHM_V = KVBLK * DH * 2, SHM_K = KVBLK * DH * 2, SHM_ATTN = 2 * SHM_V + 2 * SHM_K + NW * 64 * 4;
#define KSWZ(row, colB) ((row) * 256 + ((colB) ^ (((row) & 7) << 4)))
#define SBAR() __builtin_amdgcn_sched_barrier(0)
__device__ __forceinline__ int crow(int r, int hi) { return (r & 3) + 8 * (r >> 2) + 4 * hi; }
__device__ __forceinline__ void partialSM(f32x16& p0, f32x16& p1, float& m_reg, float& mn, float& alpha) {
  constexpr float C = SCALE * 1.4426950408889634f;
  float pmax = p0[0]; for (int r = 1; r < 16; ++r) pmax = fmaxf(pmax, p0[r]); for (int r = 0; r < 16; ++r) pmax = fmaxf(pmax, p1[r]);
  { auto rr = __builtin_amdgcn_permlane32_swap(__float_as_uint(pmax), __float_as_uint(pmax), false, false);
    pmax = fmaxf(__uint_as_float(rr[0]), __uint_as_float(rr[1])); }
  if (__builtin_expect(__all(pmax - m_reg <= THR / SCALE), 1)) { mn = m_reg; alpha = 1.f; }
  else { mn = fmaxf(m_reg, pmax); alpha = __builtin_amdgcn_exp2f((m_reg - mn) * C); m_reg = mn; }
  float mnC = -mn * C;
  for (int r = 0; r < 16; ++r) p0[r] = fmaf(p0[r], C, mnC); for (int r = 0; r < 16; ++r) p1[r] = fmaf(p1[r], C, mnC);
  for (int r = 0; r < 16; ++r) p0[r] = __builtin_amdgcn_exp2f(p0[r]);
}
__device__ __forceinline__ void finishSM(f32x16& p0, f32x16& p1, float alpha, float& l_reg, bf16x8& pa0, bf16x8& pa1, bf16x8& pa2, bf16x8& pa3) {
  for (int r = 0; r < 16; ++r) p1[r] = __builtin_amdgcn_exp2f(p1[r]);
  float ps = 0; for (int r = 0; r < 16; ++r) ps += p0[r]; for (int r = 0; r < 16; ++r) ps += p1[r];
  { auto rr = __builtin_amdgcn_permlane32_swap(__float_as_uint(ps), __float_as_uint(ps), false, false);
    ps = __uint_as_float(rr[0]) + __uint_as_float(rr[1]); }
  l_reg = l_reg * alpha + ps;
#define PK4(P, BASE, OUT) do { unsigned a0 = cvt_pk_bf16(P[BASE + 0], P[BASE + 1]), a1 = cvt_pk_bf16(P[BASE + 2], P[BASE + 3]);   \
    unsigned b0 = cvt_pk_bf16(P[BASE + 4], P[BASE + 5]), b1 = cvt_pk_bf16(P[BASE + 6], P[BASE + 7]);                              \
    auto r0 = __builtin_amdgcn_permlane32_swap(a0, b0, false, false); auto r1 = __builtin_amdgcn_permlane32_swap(a1, b1, false, false); \
    u32x4 w = {r0[0], r1[0], r0[1], r1[1]}; OUT = *reinterpret_cast<bf16x8*>(&w); } while (0)
  PK4(p0, 0, pa0); PK4(p0, 8, pa1); PK4(p1, 0, pa2); PK4(p1, 8, pa3);
#undef PK4
}
__device__ __forceinline__ void qkt(f32x16& p0, f32x16& p1, const bf16_t* Ks, const bf16x8* qr, int r32, int hi) {
  p0 = f32x16{}; p1 = f32x16{};
  for (int d0 = 0; d0 < 8; ++d0) { int cb = (d0 * 16 + hi * 8) * 2;
    bf16x8 b0 = *reinterpret_cast<const bf16x8*>((const char*)Ks + KSWZ(r32, cb));
    bf16x8 b1 = *reinterpret_cast<const bf16x8*>((const char*)Ks + KSWZ(32 + r32, cb));
    p0 = __builtin_amdgcn_mfma_f32_32x32x16_bf16(b0, qr[d0], p0, 0, 0, 0);
    p1 = __builtin_amdgcn_mfma_f32_32x32x16_bf16(b1, qr[d0], p1, 0, 0, 0); }
}
__device__ __forceinline__ int v_st(int k, int c) { const int kk = (k & ~0xC) | ((k & 4) << 1) | ((k & 8) >> 1); return ((kk >> 3) * 4 + (c >> 5)) * 512 + ((kk & 7) * 32 + (c & 31)) * 2; }
__device__ __forceinline__ int v_rd_base(int lane) { return ((lane & 3) << 3) | (((lane >> 2) & 3) << 6) | (((lane >> 4) & 1) << 5) | (((lane >> 5) & 1) << 8); }
constexpr int v_rd_off(int d0, int ks, int half) { return d0 * 512 + ks * 4096 + half * 2048; }
template <int OFF> __device__ __forceinline__ s16x4 tr_read(int vb) {
  s16x4 r; asm volatile("ds_read_b64_tr_b16 %0, %1 offset:%2" : "=&v"(r) : "v"(vb), "i"(OFF) : "memory"); return r;
}
template <int D0> __device__ __forceinline__ void pv_one(f32x16& od, int vb, bf16x8 pa0, bf16x8 pa1, bf16x8 pa2, bf16x8 pa3) {
  const s16x4 l0 = tr_read<v_rd_off(D0, 0, 0)>(vb), h0 = tr_read<v_rd_off(D0, 0, 1)>(vb), l1 = tr_read<v_rd_off(D0, 1, 0)>(vb), h1 = tr_read<v_rd_off(D0, 1, 1)>(vb);
  const s16x4 l2 = tr_read<v_rd_off(D0, 2, 0)>(vb), h2 = tr_read<v_rd_off(D0, 2, 1)>(vb), l3 = tr_read<v_rd_off(D0, 3, 0)>(vb), h3 = tr_read<v_rd_off(D0, 3, 1)>(vb);
  asm volatile("s_waitcnt lgkmcnt(0)" ::: "memory"); SBAR();
#define PK(L, H) (bf16x8){L[0], L[1], L[2], L[3], H[0], H[1], H[2], H[3]}
  od = __builtin_amdgcn_mfma_f32_32x32x16_bf16(pa0, PK(l0, h0), od, 0, 0, 0);
  od = __builtin_amdgcn_mfma_f32_32x32x16_bf16(pa1, PK(l1, h1), od, 0, 0, 0);
  od = __builtin_amdgcn_mfma_f32_32x32x16_bf16(pa2, PK(l2, h2), od, 0, 0, 0);
  od = __builtin_amdgcn_mfma_f32_32x32x16_bf16(pa3, PK(l3, h3), od, 0, 0, 0);
#undef PK
}
__device__ __forceinline__ void pv_d0(f32x16* o, int vb, bf16x8 pa0, bf16x8 pa1, bf16x8 pa2, bf16x8 pa3) {
  pv_one<0>(o[0], vb, pa0, pa1, pa2, pa3); pv_one<1>(o[1], vb, pa0, pa1, pa2, pa3); pv_one<2>(o[2], vb, pa0, pa1, pa2, pa3); pv_one<3>(o[3], vb, pa0, pa1, pa2, pa3);
}
__device__ __forceinline__ void attn_dense_body(const bf16_t* __restrict__ Qb, const bf16_t* __restrict__ Kh, const bf16_t* __restrict__ Vh,
                                                bf16_t* __restrict__ Ob, int seq, char* lds, const int wave) {
  const int wid = wave, lane = lane_now(), tid = wid * 64 + lane, r32 = lane & 31, hi = lane >> 5;
  bf16_t* V_lds = (bf16_t*)lds; bf16_t* K_lds = (bf16_t*)(lds + 2 * SHM_V);
  float* ws = (float*)(lds + 2 * SHM_V + 2 * SHM_K) + wid * 64; float* li_l = ws; float* al_l = ws + 32;
  float m_reg = -1e30f, l_reg = 0; f32x16 o[4] = {}; bf16x8 qr[8];
  const bf16_t* Qw = Qb + (long)(wid * QBLK + r32) * LDQ + hi * 8;
#pragma unroll
  for (int d0 = 0; d0 < 8; ++d0) qr[d0] = *reinterpret_cast<const bf16x8*>(Qw + d0 * 16);
  const int sr = tid >> 4, sc = (tid & 15) * 8, vst0 = v_st(sr, sc), vst1 = v_st(32 + sr, sc);
  const int vb0 = (int)(uintptr_t)V_lds + v_rd_base(lane);
  const unsigned goff = (unsigned)(sr * LDK + sc) * 2u;
  struct { bf16x8 vs0, vs1, ks0, ks1; } sr_[2];
#define SLOAD(i, k0) do { const char* kb_ = (const char*)Kh + (size_t)(k0) * (LDK * 2); \
    sr_[i].ks0 = *reinterpret_cast<const bf16x8*>(kb_ + goff); sr_[i].ks1 = *reinterpret_cast<const bf16x8*>(kb_ + goff + 32 * LDK * 2); \
    sr_[i].vs0 = *reinterpret_cast<const bf16x8*>(kb_ + goff + 1024); sr_[i].vs1 = *reinterpret_cast<const bf16x8*>(kb_ + goff + 32 * LDK * 2 + 1024); } while (0)
#define SWRITE(b, i) do { *(bf16x8*)((char*)V_lds + (b) * SHM_V + vst0) = sr_[i].vs0;          \
    *(bf16x8*)((char*)V_lds + (b) * SHM_V + vst1) = sr_[i].vs1; int kc = sc * 2;               \
    *(bf16x8*)((char*)K_lds + (b) * SHM_K + KSWZ(sr, kc)) = sr_[i].ks0;                       \
    *(bf16x8*)((char*)K_lds + (b) * SHM_K + KSWZ(32 + sr, kc)) = sr_[i].ks1; } while (0)
#define SWAIT() asm volatile("s_waitcnt vmcnt(4)" ::: "memory")
#define RESC(a) do { if (__any((a) < 1.f)) { if (hi == 0) al_l[r32] = (a); asm volatile("s_waitcnt lgkmcnt(0)" ::: "memory"); \
    for (int d = 0; d < 4; ++d) for (int r = 0; r < 16; ++r) o[d][r] *= al_l[crow(r, hi)]; } } while (0)
  f32x16 pA0, pA1, pB0, pB1; float mnA, mnB, alA, alB; bf16x8 pa0, pa1, pa2, pa3; const int NT = seq / KVBLK;
  constexpr int SE = 0, SO = 1;
  SLOAD(SE, 0); asm volatile("s_waitcnt vmcnt(0)" ::: "memory"); SWRITE(0, SE); __syncthreads();
  qkt(pA0, pA1, K_lds, qr, r32, hi); partialSM(pA0, pA1, m_reg, mnA, alA);
  SLOAD(SO, KVBLK); if (2 < NT) SLOAD(SE, 2 * KVBLK);
  SWAIT(); SWRITE(1, SO); __syncthreads();
  for (int j = 1; j + 1 < NT; j += 2) {
    SBAR(); qkt(pB0, pB1, (bf16_t*)((char*)K_lds + SHM_K), qr, r32, hi);
    finishSM(pA0, pA1, alA, l_reg, pa0, pa1, pa2, pa3); SBAR();
    SLOAD(SO, (j + 2) * KVBLK); SBAR();
    pv_d0(o, vb0, pa0, pa1, pa2, pa3); partialSM(pB0, pB1, m_reg, mnB, alB);
    __syncthreads(); SWAIT(); SWRITE(0, SE);
    RESC(alB); __syncthreads();
    SBAR(); qkt(pA0, pA1, K_lds, qr, r32, hi);
    finishSM(pB0, pB1, alB, l_reg, pa0, pa1, pa2, pa3); SBAR();
    if (j + 3 < NT) SLOAD(SE, (j + 3) * KVBLK); SBAR();
    pv_d0(o, vb0 + (int)SHM_V, pa0, pa1, pa2, pa3); partialSM(pA0, pA1, m_reg, mnA, alA);
    __syncthreads(); SWAIT(); SWRITE(1, SO);
    RESC(alA); __syncthreads();
  }
  SBAR(); qkt(pB0, pB1, (bf16_t*)((char*)K_lds + SHM_K), qr, r32, hi);
  finishSM(pA0, pA1, alA, l_reg, pa0, pa1, pa2, pa3); SBAR();
  pv_d0(o, vb0, pa0, pa1, pa2, pa3); partialSM(pB0, pB1, m_reg, mnB, alB);
  __syncthreads(); RESC(alB);
  finishSM(pB0, pB1, alB, l_reg, pa0, pa1, pa2, pa3); SBAR();
  pv_d0(o, vb0 + (int)SHM_V, pa0, pa1, pa2, pa3);
  if (hi == 0) li_l[r32] = l_reg; asm volatile("s_waitcnt lgkmcnt(0)" ::: "memory");
  float rli[16];
#pragma unroll
  for (int r = 0; r < 16; ++r) rli[r] = __builtin_amdgcn_rcpf(li_l[crow(r, hi)]);
  bf16_t* Ow = Ob + (long)(wid * QBLK) * LDO;
#pragma unroll
  for (int r = 0; r < 16; ++r) { int orow = crow(r, hi);
    for (int d0 = 0; d0 < 4; ++d0) Ow[(long)orow * LDO + d0 * 32 + r32] = f2bf(o[d0][r] * rli[r]); }
  __syncthreads();
#undef SLOAD
#undef SWRITE
#undef SWAIT
#undef RESC
}
#undef KSWZ
#undef SBAR
}
#define XB_TMO      128
#define XB_XCNT(j)  (256  + 64 * (j))
#define XB_XSUB(j)  (1280 + 64 * (j))
#define XB_XGEN(j)  (2304 + 64 * (j))
#define XB_TOP      3328
#define XB_TOPGEN   3392
#define XCD_BAR_WORDS 3456
#define XB_SPIN_CAP (1u << 20)
__device__ __forceinline__ unsigned xb_ld(unsigned* p)              { return __hip_atomic_load(p, __ATOMIC_RELAXED, __HIP_MEMORY_SCOPE_AGENT); }
__device__ __forceinline__ unsigned xb_add(unsigned* p, unsigned v) { return __hip_atomic_fetch_add(p, v, __ATOMIC_RELAXED, __HIP_MEMORY_SCOPE_AGENT); }
__device__ __forceinline__ unsigned xb_xcc_id() { return (unsigned)__builtin_amdgcn_s_getreg((3 << 11) | 20) & 0xFu; }
#define XB_SPIN(cond, bar) do { unsigned _sp = 0; while (cond) { __builtin_amdgcn_s_sleep(1); \
    if ((++_sp & 255u) == 0u) { if (xb_ld(&(bar)[XB_TMO])) break; if (_sp > XB_SPIN_CAP) { atomicAdd(&(bar)[XB_TMO], 1u); break; } } } } while (0)
struct XcdBarrier { unsigned* bar; unsigned x; volatile LAS unsigned* st; int wave; };
__device__ __forceinline__ XcdBarrier xcd_barrier_post(unsigned* bar, volatile LAS unsigned* st, int wave) {
    XcdBarrier b; b.bar = bar; b.x = xb_xcc_id(); b.st = st; b.wave = wave;
    if (tid_from(wave) == 0) (void)xb_add(&bar[XB_XCNT(b.x)], 1u);
    return b;
}
__device__ __forceinline__ void xcd_barrier_complete(unsigned* bar, unsigned x, unsigned& nloc, unsigned& nx) {
    const unsigned G = gridDim.x * gridDim.y * gridDim.z;
    unsigned sum, cnt, mine, sp = 0u;
    for (;;) {
        sum = 0u; cnt = 0u; mine = 0u;
#pragma unroll
        for (unsigned j = 0; j < 16; ++j) { const unsigned c = xb_ld(&bar[XB_XCNT(j)]); sum += c; cnt += (c > 0u) ? 1u : 0u; mine = (j == x) ? c : mine; }
        if (sum == G) break;
        __builtin_amdgcn_s_sleep(1);
        if ((++sp & 255u) == 0u) { if (xb_ld(&bar[XB_TMO])) break; if (sp > XB_SPIN_CAP) { atomicAdd(&bar[XB_TMO], 1u); break; } }
    }
    nloc = mine > 0u ? mine : 1u; nx = cnt > 0u ? cnt : 1u;
}
__device__ __forceinline__ void xcd_barrier(const XcdBarrier& b) {
    asm volatile("s_waitcnt vmcnt(0)" ::: "memory");
    __syncthreads();
    if (tid_from(b.wave) == 0) {
        unsigned* bar = b.bar;
        __builtin_amdgcn_s_waitcnt(0);
        unsigned nloc = b.st[0], nx = b.st[1];
        if (nloc == 0u) { xcd_barrier_complete(bar, b.x, nloc, nx); b.st[0] = nloc; b.st[1] = nx; }
        const unsigned old = xb_add(&bar[XB_XSUB(b.x)], 1u);
        const unsigned gen = old / nloc;
        if (old + 1u == (gen + 1u) * nloc) {
            __builtin_amdgcn_fence(__ATOMIC_RELEASE, "agent");
            asm volatile("s_waitcnt vmcnt(0)" ::: "memory");
            const unsigned og = xb_add(&bar[XB_TOP], 1u);
            const unsigned tg = og / nx;
            if (og + 1u == (tg + 1u) * nx) xb_add(&bar[XB_TOPGEN], 1u);
            else XB_SPIN(xb_ld(&bar[XB_TOPGEN]) == tg, bar);
            __builtin_amdgcn_fence(__ATOMIC_ACQUIRE, "agent");
            xb_add(&bar[XB_XGEN(b.x)], 1u);
            asm volatile("s_waitcnt vmcnt(0)" ::: "memory");
        } else {
            XB_SPIN(xb_ld(&bar[XB_XGEN(b.x)]) == gen, bar);
            __builtin_amdgcn_fence(__ATOMIC_ACQUIRE, "agent");
            asm volatile("s_waitcnt vmcnt(0)" ::: "memory");
        }
    }
    __syncthreads();
}

struct Frame {
    LAS unsigned char* lds; char* ldsg;
    int tid, lane, wave, vcu, G;
    const float* const* in; float* out; unsigned char* ws;
};
struct Args { const float* in[32]; float* out; unsigned char* ws; int ph_lo, ph_hi; };
__device__ __forceinline__ void transpose_item64(const float* __restrict__ W, int K, int N, bf16_t* __restrict__ WT, int drow0, LAS float* scr, int k0, int n0, int lane, float qs = 0.f) {
    const int kr = lane >> 4, n4 = (lane & 15) * 4;
#pragma unroll 4
    for (int i = 0; i < 16; ++i) { const int kk = 4 * i + kr; const f32x4 v = *(const f32x4*)(W + (size_t)(k0 + kk) * N + n0 + n4);
        LAS float* s = scr + kk * 64;
        s[(n4 + 0) ^ kk] = v[0]; s[(n4 + 1) ^ kk] = v[1]; s[(n4 + 2) ^ kk] = v[2]; s[(n4 + 3) ^ kk] = v[3]; }
    LDS_WAIT(); asm volatile("" ::: "memory");
    const int c = lane & 7;
#pragma unroll
    for (int j = 0; j < 8; ++j) { const int n = (lane >> 3) + 8 * j; float v[8];
#pragma unroll
        for (int q = 0; q < 8; ++q) { const int kk = 8 * c + q; v[q] = scr[kk * 64 + (n ^ kk)]; if (qs != 0.f) v[q] = q8(v[q], qs); }
        u32x4 o; o.x = cvt_pk_bf16(v[0], v[1]); o.y = cvt_pk_bf16(v[2], v[3]); o.z = cvt_pk_bf16(v[4], v[5]); o.w = cvt_pk_bf16(v[6], v[7]);
        *(u32x4*)(WT + (size_t)(drow0 + n) * K + k0 + 8 * c) = o; }
    LDS_WAIT(); asm volatile("" ::: "memory");
}
__device__ __forceinline__ void transpose_matrix_items(const float* W, int K, int N, bf16_t* WT, int gu, LAS float* scr, int item, int lane, float qs = 0.f) {
    const int nblk = N / 64, kb = item / nblk, nb = item % nblk, k0 = 64 * kb, n0 = 64 * nb;
    int drow0 = n0;
    if (gu) { const int f0 = n0 & 1023; drow0 = (f0 >> 7) * 256 + ((n0 >= 1024) ? 128 : 0) + (f0 & 127); }
    transpose_item64(W, K, N, WT, drow0, scr, k0, n0, lane, qs);
}

__device__ __forceinline__ void transpose_item_f8(const float* __restrict__ W, int K, int N, unsigned char* __restrict__ WT8, int drow0, LAS float* scr, int k0, int n0, int lane, float sc, bool readonly = false) {
    const int kr = lane >> 3, n4 = (lane & 7) * 4;
    if (readonly) { f32x4 a = {0.f, 0.f, 0.f, 0.f};
        const int item = (k0 >> 7) * (N / 32) + (n0 >> 5), nb256 = N / 256, kq = item / nb256, nq = item % nb256;
#pragma unroll
        for (int i = 0; i < 16; ++i) a += *(const f32x4*)(W + (size_t)(16 * kq + i) * N + 256 * nq + 4 * lane);
        asm volatile("" :: "v"(a)); return; }
#define TSWZ(kk) (((kk) & 7) | ((((kk) >> 4) & 3) << 3))
#pragma unroll
    for (int h = 0; h < 2; ++h) { f32x4 v[8];
#pragma unroll
        for (int i = 0; i < 8; ++i) v[i] = __builtin_nontemporal_load((const f32x4*)(W + (size_t)(k0 + 64 * h + 8 * i + kr) * N + n0 + n4));
#pragma unroll
        for (int i = 0; i < 8; ++i) { const int kk = 64 * h + 8 * i + kr; LAS float* s = scr + kk * 32; const int x = TSWZ(kk);
            s[(n4 + 0) ^ x] = v[i][0]; s[(n4 + 1) ^ x] = v[i][1]; s[(n4 + 2) ^ x] = v[i][2]; s[(n4 + 3) ^ x] = v[i][3]; } }
    LDS_WAIT(); asm volatile("" ::: "memory");
    const int c = lane & 7;
#pragma unroll 1
    for (int j = 0; j < 4; ++j) { const int n = (lane >> 3) + 8 * j; float u[16];
#pragma unroll
        for (int q = 0; q < 16; ++q) { const int kk = 16 * c + q; u[q] = scr[kk * 32 + (n ^ TSWZ(kk))] * sc; }
        u32x4 o; o.x = pk4_fp8(u[0], u[1], u[2], u[3]); o.y = pk4_fp8(u[4], u[5], u[6], u[7]); o.z = pk4_fp8(u[8], u[9], u[10], u[11]); o.w = pk4_fp8(u[12], u[13], u[14], u[15]);
        const int r = drow0 + n;
        *(u32x4*)(WT8 + (size_t)(r >> 8) * 256 * K + (size_t)(k0 >> 7) * 32768 + (r & 255) * 128 + 16 * c) = o; }
    LDS_WAIT(); asm volatile("" ::: "memory");
#undef TSWZ
}
__device__ __forceinline__ void transpose_matrix_items_f8(const float* W, int K, int N, unsigned char* WT8, int gu, LAS float* scr, int item, int lane, float sc, bool readonly = false) {
    const int nblk = N / 32, kb = item / nblk, nb = item % nblk, k0 = 128 * kb, n0 = 32 * nb;
    int drow0 = n0;
    if (gu) { const int f0 = n0 & 1023; drow0 = (f0 >> 7) * 256 + ((n0 >= 1024) ? 128 : 0) + (f0 & 127); }
    transpose_item_f8(W, K, N, WT8, drow0, scr, k0, n0, lane, sc, readonly);
}

__device__ __forceinline__ void p0_prologue(Frame& F) {
    const int gw = F.vcu * NWAVES + F.wave, NGW = F.G * NWAVES;
    const int gt = F.vcu * NTHR + F.tid, NGT = F.G * NTHR;
    {
        LAS float* cond = (LAS float*)F.lds;
        LAS float* part = cond + NB * D;
        for (int i = F.tid; i < NB * D; i += NTHR) { const float c = F.in[1][i]; cond[i] = c * sigmoidf_(c); }
        __syncthreads();
        float* modf = (float*)(F.ws + WS_MODP);
        const float* aw = F.in[2]; const float* ab = F.in[3];
        for (int it = F.vcu; it < DEPTH * 64; it += F.G) {
            const int layer = it >> 6, cb = it & 63, n = cb * 96 + F.lane * 2;
            float a0[4] = {0.f, 0.f, 0.f, 0.f}, a1[4] = {0.f, 0.f, 0.f, 0.f};
            if (F.lane < 48) { const float* wp = aw + ((size_t)layer * D + F.wave * 128) * (6 * D) + n;
#pragma unroll 32
                for (int k = 0; k < 128; ++k) { const f32x2 w = *(const f32x2*)(wp + (size_t)k * (6 * D));
#pragma unroll
                    for (int b = 0; b < 4; ++b) { const float cv = cond[b * D + F.wave * 128 + k]; a0[b] += cv * w.x; a1[b] += cv * w.y; } }
#pragma unroll
                for (int b = 0; b < 4; ++b) *(LAS f32x2*)(part + (F.wave * 4 + b) * 96 + F.lane * 2) = (f32x2){a0[b], a1[b]}; }
            __syncthreads();
            if (F.tid < 4 * 96) { const int b = F.tid / 96, c = F.tid % 96; float sum = ab[(size_t)layer * 6 * D + cb * 96 + c];
#pragma unroll
                for (int w = 0; w < 8; ++w) sum += part[(w * 4 + b) * 96 + c];
                modf[((size_t)layer * NB + b) * (6 * D) + cb * 96 + c] = sum; }
            __syncthreads();
        }
    }
    {
        LAS float* ct = (LAS float*)F.lds;
        for (int m = F.tid; m < 4096; m += NTHR) ct[m] = cospif((float)m * (1.0f / 2048.0f));
        __syncthreads();
        unsigned char* dl = F.ws + WS_DFTL;
        for (int it = gt; it < 8192 * 256; it += NGT) {
            const int row = it >> 8, l0 = (it & 255) * 16, part = row >> 12, lp = row & 4095;
            if (lp >= 2048) continue;
            float v[16];
#pragma unroll
            for (int q = 0; q < 16; ++q) { int m = (lp * (l0 + q)) & 4095; if (part) m = (m - 1024) & 4095; v[q] = ct[m] * 256.0f; }
            *(u32x4*)(dl + (size_t)row * 4096 + l0) = (u32x4){pk4_fp8(v[0], v[1], v[2], v[3]), pk4_fp8(v[4], v[5], v[6], v[7]), pk4_fp8(v[8], v[9], v[10], v[11]), pk4_fp8(v[12], v[13], v[14], v[15])};
        }
        bf16_t* dc = (bf16_t*)(F.ws + WS_SMALL + SM_DFTC);
        for (int it = gt; it < 256 * 512; it += NGT) {
            const int k = it >> 9, col = it & 511, part = col >> 8, c = col & 255;
            int m = (16 * c * k) & 4095; float v;
            if (part) { m = (m - 1024) & 4095; v = -ct[m]; } else v = ct[m];
            dc[it] = f2bf(v * (1.0f / 16.0f));
        }
        float* lbo = (float*)(F.ws + WS_SMALL + SM_LB);
        for (int n = gt; n < D; n += NGT) { const float* hl = F.in[23];
            const float x0 = hl[n], x1 = hl[D + n], x2 = hl[2 * D + n], x3 = hl[3 * D + n], mx = fmaxf(fmaxf(x0, x1), fmaxf(x2, x3));
            const float e0 = __expf(x0 - mx), e1 = __expf(x1 - mx), e2 = __expf(x2 - mx), e3 = __expf(x3 - mx);
            lbo[n] = (e1 + e2 + e3) / (e0 + e1 + e2 + e3); }
        __syncthreads();
    }
    for (int gu_ = F.vcu; gu_ < S5G * 4; gu_ += F.G) {
        const int g = gu_ >> 2, part = gu_ & 3;
        LAS f32x2* apow = (LAS f32x2*)F.lds;
        LAS f32x2* bbar = apow + 2 * 17 * 64;
        LAS f32x2* cm = bbar + 2 * 64 * 16;
        LAS f32x2* coef = cm + 2 * 16 * 64;
        LAS float* Kt = (LAS float*)(coef + 128);
        const float *a_re = F.in[12], *a_im = F.in[13], *ldt = F.in[14], *b_re = F.in[15], *b_im = F.in[16], *c_re = F.in[17], *c_im = F.in[18], *dv = F.in[19];
        if (F.tid < 128) { const int dir = F.tid >> 6, p = F.tid & 63;
            const float lr = a_re[(dir * S5G + g) * S5P + p], li = a_im[(dir * S5G + g) * S5P + p], dt = expf(ldt[dir * S5G + g]);
            const float er = lr * dt, th = li * dt;
            for (int m = 0; m <= 16; ++m) { const float mag = expf(er * (float)m); float s, c; sincosf(th * (float)m, &s, &c); apow[(dir * 17 + m) * 64 + p] = (f32x2){mag * c, mag * s}; }
            const f32x2 a1 = apow[(dir * 17 + 1) * 64 + p]; const float nr = a1.x - 1.f, ni = a1.y, den = lr * lr + li * li;
            coef[dir * 64 + p] = (f32x2){(nr * lr + ni * li) / den, (ni * lr - nr * li) / den};
            ((f32x2*)(F.ws + WS_SMALL + SM_AT))[(dir * S5G + g) * S5P + p] = apow[(dir * 17 + 16) * 64 + p];
        }
        __syncthreads();
        for (int i = F.tid; i < 2048; i += NTHR) { const int dir = i >> 10, p = (i >> 4) & 63, c = i & 15;
            const size_t bi = (((size_t)dir * S5G + g) * S5P + p) * S5C + c; const f32x2 cf = coef[dir * 64 + p]; const float br = b_re[bi], bim = b_im[bi];
            bbar[i] = (f32x2){cf.x * br - cf.y * bim, cf.x * bim + cf.y * br};
            const int c2 = (i >> 6) & 15, p2 = i & 63; const size_t ci = (((size_t)dir * S5G + g) * S5C + c2) * S5P + p2;
            cm[i] = (f32x2){c_re[ci], c_im[ci]}; }
        __syncthreads();
        {
            const int dir = F.tid >> 8, tau = (F.tid >> 4) & 15, co = F.tid & 15; float acc[16];
#pragma unroll
            for (int ci = 0; ci < 16; ++ci) acc[ci] = 0.f;
            for (int p = 0; p < 64; ++p) { const f32x2 cc = cm[(dir * 16 + co) * 64 + p], aa = apow[(dir * 17 + tau) * 64 + p];
                const float zr = cc.x * aa.x - cc.y * aa.y, zi = cc.x * aa.y + cc.y * aa.x;
#pragma unroll
                for (int ci = 0; ci < 16; ++ci) { const f32x2 bb = bbar[(dir * 64 + p) * 16 + ci]; acc[ci] += zr * bb.x - zi * bb.y; } }
#pragma unroll
            for (int ci = 0; ci < 16; ++ci) Kt[((dir * 16 + tau) * 16 + co) * 16 + ci] = acc[ci];
        }
        __syncthreads();
        bf16_t* mst = (bf16_t*)(F.ws + WS_S5M) + (size_t)g * 256 * 256;
        for (int it = part * 64 * 32 + F.tid; it < (part + 1) * 64 * 32; it += NTHR) {
            const int n = it >> 5, k0 = (it & 31) * 8, dir = n >> 7, ri = (n >> 6) & 1, p = n & 63, t = k0 >> 4, c0 = k0 & 15;
            const f32x2 aa = apow[(dir * 17 + (dir ? t : 15 - t)) * 64 + p]; float v[8];
#pragma unroll
            for (int q = 0; q < 8; ++q) { const f32x2 bb = bbar[(dir * 64 + p) * 16 + c0 + q]; v[q] = ri ? (aa.x * bb.y + aa.y * bb.x) : (aa.x * bb.x - aa.y * bb.y); }
            u32x4 o; o.x = cvt_pk_bf16(v[0], v[1]); o.y = cvt_pk_bf16(v[2], v[3]); o.z = cvt_pk_bf16(v[4], v[5]); o.w = cvt_pk_bf16(v[6], v[7]);
            *(u32x4*)(mst + (size_t)n * 256 + k0) = o;
        }
        bf16_t* tout = (bf16_t*)(F.ws + WS_S5T) + (size_t)g * 256 * 512;
        for (int it = part * 64 * 64 + F.tid; it < (part + 1) * 64 * 64; it += NTHR) {
            const int n = it >> 6, k0 = (it & 63) * 8, t = n >> 4, co = n & 15; float v[8];
            if (k0 < 256) { const int s = k0 >> 4, ci0 = k0 & 15, dl_ = t - s;
#pragma unroll
                for (int q = 0; q < 8; ++q) { const int ci = ci0 + q; float x;
                    if (dl_ > 0) x = Kt[((0 * 16 + dl_) * 16 + co) * 16 + ci];
                    else if (dl_ < 0) x = Kt[((1 * 16 - dl_) * 16 + co) * 16 + ci];
                    else x = Kt[((0 * 16 + 0) * 16 + co) * 16 + ci] + Kt[((1 * 16 + 0) * 16 + co) * 16 + ci] + (co == ci ? dv[g * 16 + co] : 0.f);
                    v[q] = x; }
            } else { const int np = k0 - 256, dir = np >> 7, ri = (np >> 6) & 1, p0 = np & 63, m = dir ? 16 - t : t + 1;
#pragma unroll
                for (int q = 0; q < 8; ++q) { const f32x2 cc = cm[(dir * 16 + co) * 64 + p0 + q], aa = apow[(dir * 17 + m) * 64 + p0 + q];
                    v[q] = ri ? -(cc.x * aa.y + cc.y * aa.x) : (cc.x * aa.x - cc.y * aa.y); } }
            u32x4 o; o.x = cvt_pk_bf16(v[0], v[1]); o.y = cvt_pk_bf16(v[2], v[3]); o.z = cvt_pk_bf16(v[4], v[5]); o.w = cvt_pk_bf16(v[6], v[7]);
            *(u32x4*)(tout + (size_t)n * 512 + k0) = o;
        }
        __syncthreads();
    }
    {
        LAS float* scr = (LAS float*)(F.lds + F.wave * 16384);
        bf16_t* wsm = (bf16_t*)(F.ws + WS_WSM);
        constexpr int I_SQ = 16 * 16, I_QKV = 16 * 32, I_HIN = 16 * 80, I_GU = 16 * 32, I_DN = 16 * 16;
        constexpr int O1 = I_SQ, O2 = O1 + I_QKV, O3 = O2 + I_SQ, O4 = O3 + I_SQ, O5 = O4 + I_SQ, O6 = O5 + I_HIN, O7 = O6 + I_SQ;
        constexpr int NSMALL = O7, NGU = DEPTH * NE * I_GU, NDN = DEPTH * NE * I_DN, NITEMS = NSMALL + NGU + NDN;
#ifndef PROBE_KIND
#define PROBE_KIND 0
#endif
        for (int it = gw; it < NSMALL; it += NGW) {
            int r = it;
            {
                if (r < O1) { transpose_matrix_items(F.in[6], D, D, wsm + W_FNET / 2, 0, scr, r, F.lane); continue; }
                if (r < O2) { transpose_matrix_items_f8(F.in[8], D, QKVC, F.ws + WS_WSM + W_QKV, 0, scr, r - O1, F.lane, S8_WGU); continue; }
                if (r < O3) { transpose_matrix_items(F.in[11], D, D, wsm + W_AO / 2, 0, scr, r - O2, F.lane); continue; }
                if (r < O4) { transpose_matrix_items(F.in[20], D, D, wsm + W_GLU / 2, 0, scr, r - O3, F.lane); continue; }
                if (r < O5) { transpose_matrix_items(F.in[21], D, D, wsm + W_SO / 2, 0, scr, r - O4, F.lane); continue; }
                if (r < O6) { transpose_matrix_items_f8(F.in[22], D, 5 * D, F.ws + WS_WSM + W_HIN, 0, scr, r - O5, F.lane, S8_WGU); continue; }
                transpose_matrix_items(F.in[25], D, D, wsm + W_HO / 2, 0, scr, r - O6, F.lane); continue;
            }
        }
        {
            struct TItem { const float* W; unsigned char* WT8; int N, k0, n0, drow0; float sc; };
            auto moe_item = [&](int r) { TItem t; int it, gu;
                if (r < NGU) { const int mi = r / I_GU; it = r % I_GU; t.N = 2 * DEX; t.W = F.in[28] + (size_t)mi * D * 2 * DEX; t.WT8 = F.ws + WS_WGU + (size_t)mi * 2 * DEX * D; gu = 1; t.sc = S8_WGU; }
                else { const int r2 = r - NGU, mi = r2 / I_DN; it = r2 % I_DN; t.N = D; t.W = F.in[30] + (size_t)mi * DEX * D; t.WT8 = F.ws + WS_WDN + (size_t)mi * D * DEX; gu = 0; t.sc = S8_WDN; }
                const int nblk = t.N / 32, kb = it / nblk, nb = it % nblk; t.k0 = 128 * kb; t.n0 = 32 * nb; t.drow0 = t.n0;
                if (gu) { const int f0 = t.n0 & 1023; t.drow0 = (f0 >> 7) * 256 + ((t.n0 >= 1024) ? 128 : 0) + (f0 & 127); }
                return t; };
            const int lane = F.lane, kr = lane >> 3, n4 = (lane & 7) * 4, c = lane & 7;
#define TSWZ(kk) (((kk) & 7) | ((((kk) >> 4) & 3) << 3))
#define TLOAD(v, t, h) do { _Pragma("unroll") for (int i = 0; i < 8; ++i) v[i] = __builtin_nontemporal_load((const f32x4*)(t.W + (size_t)(t.k0 + 64 * (h) + 8 * i + kr) * t.N + t.n0 + n4)); } while (0)
#define TWRITE(v, h) do { _Pragma("unroll") for (int i = 0; i < 8; ++i) { const int kk = 64 * (h) + 8 * i + kr; LAS float* s_ = scr + kk * 32; const int x = TSWZ(kk); \
                s_[(n4 + 0) ^ x] = v[i][0]; s_[(n4 + 1) ^ x] = v[i][1]; s_[(n4 + 2) ^ x] = v[i][2]; s_[(n4 + 3) ^ x] = v[i][3]; } } while (0)
            constexpr int NMOE = (NGU + NDN) / DEPTH * (DEPTH - 1), NGU_E = NGU / DEPTH * (DEPTH - 1);
#define RMAP(rp) ((rp) < NGU_E ? (rp) : (rp) + NGU / DEPTH)
            for (int rep = 0; rep < ((PROBE_KIND == 10) ? 2 : 1); ++rep) {
                int r = gw; TItem cur = moe_item(r < NMOE ? RMAP(r) : 0); f32x4 v0[8], v1[8];
                if (r < NMOE) TLOAD(v0, cur, 0);
                for (; r < NMOE; r += NGW) {
                    TLOAD(v1, cur, 1);
                    TWRITE(v0, 0);
                    TWRITE(v1, 1);
                    const int rn = r + NGW; TItem nxt = moe_item(rn < NMOE ? RMAP(rn) : RMAP(r));
                    if (rn < NMOE) TLOAD(v0, nxt, 0);
                    LDS_WAIT(); asm volatile("" ::: "memory");
#pragma unroll 1
                    for (int j = 0; j < 4; ++j) { const int n = (lane >> 3) + 8 * j; float u[16];
#pragma unroll
                        for (int q = 0; q < 16; ++q) { const int kk = 16 * c + q; u[q] = scr[kk * 32 + (n ^ TSWZ(kk))] * cur.sc; }
                        u32x4 o; o.x = pk4_fp8(u[0], u[1], u[2], u[3]); o.y = pk4_fp8(u[4], u[5], u[6], u[7]); o.z = pk4_fp8(u[8], u[9], u[10], u[11]); o.w = pk4_fp8(u[12], u[13], u[14], u[15]);
                        const int rr = cur.drow0 + n;
                        *(u32x4*)(cur.WT8 + (size_t)(rr >> 8) * 256 * 1024 + (size_t)(cur.k0 >> 7) * 32768 + (rr & 255) * 128 + 16 * c) = o; }
                    LDS_WAIT(); asm volatile("" ::: "memory");
                    cur = nxt;
                }
            }
#undef TSWZ
#undef TLOAD
#undef TWRITE
#undef RMAP
        }
    }
}

constexpr int DEF_GU = NE * 16 * 32, DEF_DN = NE * 16 * 16, NDEF = DEF_GU + DEF_DN;
__device__ __forceinline__ void deferred_fill(Frame& F, int nblocks) {
    unsigned* ctr = (unsigned*)(F.ws + WS_CTL) + 1024;
    LAS float* scr = (LAS float*)(F.lds + F.wave * 16384);
    volatile LAS unsigned* slot = (volatile LAS unsigned*)(F.lds + MISC_OFF) + 16;
    for (int k = 0; nblocks < 0 || k < nblocks; ++k) {
        __syncthreads();
        if (tid_from(F.wave) == 0) slot[0] = atomicAdd(ctr, 8u);
        __syncthreads();
        const unsigned base = __builtin_amdgcn_readfirstlane(slot[0]);
        if (base >= (unsigned)NDEF) break;
        const int q = (int)base + F.wave, lane = lane_now();
        constexpr int L = DEPTH - 1;
        if (q < DEF_GU) { const int mi = L * NE + q / 512, it = q % 512;
            transpose_matrix_items_f8(F.in[28] + (size_t)mi * D * 2 * DEX, D, 2 * DEX, F.ws + WS_WGU + (size_t)mi * 2 * DEX * D, 1, scr, it, lane, S8_WGU); }
        else { const int q2 = q - DEF_GU, mi = L * NE + q2 / 256, it = q2 % 256;
            transpose_matrix_items_f8(F.in[30] + (size_t)mi * DEX * D, DEX, D, F.ws + WS_WDN + (size_t)mi * D * DEX, 0, scr, it, lane, S8_WDN); }
    }
    __syncthreads();
}
__device__ __forceinline__ float modval(const float* modf, const float* ada_b, int layer, int b, int idx, int n) {
    return modf[((size_t)layer * NB + b) * (6 * D) + idx * D + n];
}
__device__ __forceinline__ void rowpass(Frame& F, int layer, int stage) {
    const bool has_post = !(layer == 0 && stage == 0), has_h = layer < DEPTH;
    const int pl = (stage == 0) ? layer - 1 : layer, ps = (stage == 0) ? 1 : 0;
    const int hmode = !has_h ? 0 : (stage == 1 ? 1 : (layer == 0 ? 2 : (layer == 2 ? 3 : 1)));
    const float* xsrc = F.in[0]; _Float16* x16 = (_Float16*)(F.ws + WS_X16);
    const float* modp = (const float*)(F.ws + WS_MODP); const float* ada_b = F.in[3];
    const bf16_t* Yd = (const bf16_t*)(F.ws + WS_Y);
    const unsigned char* YB = F.ws + WS_SCR + SC_DNO;
    int* topi = (int*)(F.ws + WS_ROUTE + RT_TOPI); float* topg = (float*)(F.ws + WS_ROUTE + RT_TOPG); int* destp = (int*)(F.ws + WS_ROUTE + RT_DEST); int* hist = (int*)(F.ws + WS_ROUTE + RT_HIST);
    bf16_t* H = (bf16_t*)(F.ws + WS_H); bf16_t* AOP = (bf16_t*)(F.ws + WS_SCR + SC_AOP);
    LAS float* gv = (LAS float*)F.lds;
    LAS float* pgv = gv + D, *pbv = pgv + D;
    LAS float* scv = pbv + D, *shv = scv + D;
    LAS float* stt = shv + D;
    LAS unsigned char* big = F.lds + 6 * D * 4;
    for (int rb = F.vcu; rb < NTOK / 64; rb += F.G) {
        const int b = rb / (SEQ / 64);
        struct Raw { f32x4 xf[4]; h16x4 xh[4]; u32x2 yd[4]; int yb[4][4]; float gk[4]; };
        int dall = 0, gall = 0;
        if (has_post && ps == 1) { const int q = F.lane & 31, rr = rb * 64 + (q >> 4) * 32 + F.wave * 4 + ((q >> 2) & 3); dall = destp[rr * 4 + (q & 3)]; gall = __float_as_int(topg[rr * 4 + (q & 3)]); }
        auto load_raw = [&](int rnd_, int i_, Raw& R) { const int row_ = rb * 64 + rnd_ * 32 + F.wave * 4 + i_;
#pragma unroll
            for (int j = 0; j < 4; ++j) { if (layer == 0) R.xf[j] = *(const f32x4*)(xsrc + (size_t)row_ * D + 256 * j + 4 * F.lane); else R.xh[j] = *(const h16x4*)(x16 + (size_t)row_ * D + 256 * j + 4 * F.lane); }
            if (has_post) {
                if (ps == 0) {
#pragma unroll
                    for (int j = 0; j < 4; ++j) R.yd[j] = *(const u32x2*)(Yd + (size_t)row_ * D + 256 * j + 4 * F.lane);
                } else {
#pragma unroll
                    for (int k = 0; k < 4; ++k) { const int dr = __builtin_amdgcn_readlane(dall, rnd_ * 16 + i_ * 4 + k); R.gk[k] = __int_as_float(__builtin_amdgcn_readlane(gall, rnd_ * 16 + i_ * 4 + k)) * (1.0f / S8_Y);
#pragma unroll
                        for (int j = 0; j < 4; ++j) R.yb[k][j] = *(const int*)(YB + (size_t)dr * D + 256 * j + 4 * F.lane); }
                } } };
        Raw cur; load_raw(0, 0, cur);
        for (int n = F.tid; n < D; n += NTHR) {
            if (has_post) { gv[n] = modval(modp, ada_b, pl, b, ps ? 5 : 2, n); pgv[n] = F.in[4][(pl * 2 + ps) * D + n]; pbv[n] = F.in[5][(pl * 2 + ps) * D + n]; }
            if (has_h) { scv[n] = 1.f + modval(modp, ada_b, layer, b, stage ? 4 : 1, n); shv[n] = modval(modp, ada_b, layer, b, stage ? 3 : 0, n); }
        }
        __syncthreads();
        for (int rnd = 0; rnd < 2; ++rnd) {
            for (int i = 0; i < 4; ++i) {
                const int lr = rnd * 32 + F.wave * 4 + i, row = rb * 64 + lr;
                Raw nxt; if (!(rnd == 1 && i == 3)) load_raw(i == 3 ? 1 : rnd, i == 3 ? 0 : i + 1, nxt);
                f32x4 v[4];
#pragma unroll
                for (int j = 0; j < 4; ++j) { if (layer == 0) v[j] = cur.xf[j]; else v[j] = __builtin_convertvector(cur.xh[j], f32x4); }
                if (has_post) {
                    f32x4 y[4];
                    if (ps == 0) {
#pragma unroll
                        for (int j = 0; j < 4; ++j) { const u32x2 w = cur.yd[j]; y[j] = (f32x4){bflo(w.x), bfhi(w.x), bflo(w.y), bfhi(w.y)}; }
                    } else {
#pragma unroll
                        for (int j = 0; j < 4; ++j) y[j] = (f32x4){0.f, 0.f, 0.f, 0.f};
#pragma unroll
                        for (int k = 0; k < 4; ++k) { const float gk = cur.gk[k];
#pragma unroll
                            for (int j = 0; j < 4; ++j) { const int w = cur.yb[k][j];
                                const f32x2 lo = __builtin_amdgcn_cvt_pk_f32_fp8(w, false), hi = __builtin_amdgcn_cvt_pk_f32_fp8(w, true);
                                y[j][0] += gk * lo.x; y[j][1] += gk * lo.y; y[j][2] += gk * hi.x; y[j][3] += gk * hi.y; } }
                    }
                    float s = 0.f;
#pragma unroll
                    for (int j = 0; j < 4; ++j) { const f32x4 gg = *(const LAS f32x4*)(gv + 256 * j + 4 * F.lane); v[j] = DN_ALPHA * v[j] + gg * y[j]; s += (v[j][0] + v[j][1]) + (v[j][2] + v[j][3]); }
                    const float mean = wave_sum(s) * (1.f / D); float q = 0.f;
#pragma unroll
                    for (int j = 0; j < 4; ++j) { v[j] = v[j] - mean; q += (v[j][0] * v[j][0] + v[j][1] * v[j][1]) + (v[j][2] * v[j][2] + v[j][3] * v[j][3]); }
                    const float rstd = 1.f / sqrtf(wave_sum(q) * (1.f / D) + LN_EPS);
#pragma unroll
                    for (int j = 0; j < 4; ++j) { const f32x4 pg = *(const LAS f32x4*)(pgv + 256 * j + 4 * F.lane), pb = *(const LAS f32x4*)(pbv + 256 * j + 4 * F.lane);
                        v[j] = v[j] * rstd * pg + pb;
                        if (has_h) { const h16x4 hx = __builtin_convertvector(v[j], h16x4); *(h16x4*)(x16 + (size_t)row * D + 256 * j + 4 * F.lane) = hx; v[j] = __builtin_convertvector(hx, f32x4); }
                        else *(f32x4*)(F.out + (size_t)row * D + 256 * j + 4 * F.lane) = v[j]; }
                }
                if (has_h) {
                    float s = 0.f;
#pragma unroll
                    for (int j = 0; j < 4; ++j) s += (v[j][0] + v[j][1]) + (v[j][2] + v[j][3]);
                    const float mean = wave_sum(s) * (1.f / D); float q = 0.f;
#pragma unroll
                    for (int j = 0; j < 4; ++j) { v[j] = v[j] - mean; q += (v[j][0] * v[j][0] + v[j][1] * v[j][1]) + (v[j][2] * v[j][2] + v[j][3] * v[j][3]); }
                    const float rstd = 1.f / sqrtf(wave_sum(q) * (1.f / D) + LN_EPS);
                    if (F.lane == 0) { stt[lr * 2] = mean; stt[lr * 2 + 1] = rstd; }
#pragma unroll
                    for (int j = 0; j < 4; ++j) { const f32x4 sc = *(const LAS f32x4*)(scv + 256 * j + 4 * F.lane), sh = *(const LAS f32x4*)(shv + 256 * j + 4 * F.lane);
                        const f32x4 h = v[j] * rstd * sc + sh; const u32x2 w = {cvt_pk_bf16(h[0], h[1]), cvt_pk_bf16(h[2], h[3])};
                        if (hmode == 1) *(unsigned*)((unsigned char*)H + (size_t)row * D + 256 * j + 4 * F.lane) = pk4_fp8(h[0] * S8_H, h[1] * S8_H, h[2] * S8_H, h[3] * S8_H);
                        else if (hmode == 2) *(LAS unsigned*)(big + (size_t)(lr & 31) * 1028 + 256 * j + 4 * F.lane) = pk4_fp8(h[0] * S8_H, h[1] * S8_H, h[2] * S8_H, h[3] * S8_H);
                        else *(LAS u32x2*)(big + (size_t)(lr & 31) * 2064 + (256 * j + 4 * F.lane) * 2) = w;
                    }
                }
                cur = nxt;
            }
            if (hmode == 3) {
                __syncthreads();
                const int j0 = ((rb * 64 + rnd * 32) & (SEQ - 1)) >> 4;
                for (int q = F.tid; q < 4096; q += NTHR) { const int g = q >> 6, jj = (q >> 5) & 1, t = (q >> 1) & 15, c8 = (q & 1) * 8;
                    *(u32x4*)(AOP + ((size_t)(g * 1024 + b * 256 + j0 + jj)) * 512 + t * 16 + c8) = *(const LAS u32x4*)(big + (size_t)(16 * jj + t) * 2064 + (g * 16 + c8) * 2); }
                __syncthreads();
            }
            if (hmode == 2) {
                __syncthreads();
                const int l0 = (rb * 64 + rnd * 32) & (SEQ - 1);
                for (int it = F.tid; it < 2048; it += NTHR) { const int ch = it >> 1, lg = it & 1; unsigned wq[4];
#pragma unroll
                    for (int q = 0; q < 4; ++q) { const LAS unsigned char* pz = big + (size_t)(lg * 16 + 4 * q) * 1028 + ch;
                        wq[q] = (unsigned)pz[0] | ((unsigned)pz[1028] << 8) | ((unsigned)pz[2056] << 16) | ((unsigned)pz[3084] << 24); }
                    *(u32x4*)((unsigned char*)H + ((size_t)b * D + ch) * SEQ + l0 + lg * 16) = (u32x4){wq[0], wq[1], wq[2], wq[3]}; }
                __syncthreads();
            }
        }
        if (has_h && stage == 1) {
            VM_WAIT(); __syncthreads();
            __builtin_amdgcn_fence(__ATOMIC_ACQUIRE, "agent"); VM_WAIT();
            constexpr int HP = 68;
            LAS float* hsT = (LAS float*)big;
            LAS float* wt = hsT + 64 * HP;
            LAS float* lg = wt + 64 * 32;
            LAS int* hh = (LAS int*)(lg + 64 * 33);
            LAS float* red = (LAS float*)(hh + 32);
            const float* wr = F.in[26] + (size_t)layer * D * NE; const float* br = F.in[27] + layer * NE;
            if (F.tid < 32) hh[F.tid] = 0;
            const int kq = F.tid >> 7, rg = (F.tid & 127) >> 3, eg = F.tid & 7;
            const int r = F.tid >> 3, ks = (F.tid & 7) * 8, kk = F.tid >> 3, e4 = (F.tid & 7) * 4;
            const float mean = stt[r * 2], rstd = stt[r * 2 + 1];
            const _Float16* xp = x16 + (size_t)(rb * 64 + r) * D + ks; const float* wp = wr + (size_t)kk * NE + e4;
            f32x4 acc[4] = {(f32x4){0.f, 0.f, 0.f, 0.f}, (f32x4){0.f, 0.f, 0.f, 0.f}, (f32x4){0.f, 0.f, 0.f, 0.f}, (f32x4){0.f, 0.f, 0.f, 0.f}};
            h16x8 xh = *(const h16x8*)xp; f32x4 wv = *(const f32x4*)wp;
            for (int k0 = 0; k0 < D; k0 += 64) {
                { const f32x4 sa = *(const LAS f32x4*)(scv + k0 + ks), sb = *(const LAS f32x4*)(scv + k0 + ks + 4), ha = *(const LAS f32x4*)(shv + k0 + ks), hb = *(const LAS f32x4*)(shv + k0 + ks + 4);
                    const f32x4 xa = __builtin_convertvector(__builtin_shufflevector(xh, xh, 0, 1, 2, 3), f32x4), xb = __builtin_convertvector(__builtin_shufflevector(xh, xh, 4, 5, 6, 7), f32x4);
                    const f32x4 va = (xa - mean) * rstd * sa + ha, vb = (xb - mean) * rstd * sb + hb;
#pragma unroll
                    for (int q = 0; q < 4; ++q) { hsT[(ks + q) * HP + r] = va[q]; hsT[(ks + 4 + q) * HP + r] = vb[q]; }
                    *(LAS f32x4*)(wt + kk * 32 + e4) = wv; }
                if (k0 + 64 < D) { xh = *(const h16x8*)(xp + k0 + 64); wv = *(const f32x4*)(wp + (size_t)(k0 + 64) * NE); }
                __syncthreads();
#pragma unroll 4
                for (int k = 16 * kq; k < 16 * kq + 16; ++k) { const f32x4 h4 = *(const LAS f32x4*)(hsT + k * HP + 4 * rg), w4 = *(const LAS f32x4*)(wt + k * 32 + 4 * eg);
#pragma unroll
                    for (int a = 0; a < 4; ++a) acc[a] += h4[a] * w4; }
                __syncthreads();
            }
#pragma unroll
            for (int a = 0; a < 4; ++a) *(LAS f32x4*)(red + (kq * 64 + 4 * rg + a) * 32 + 4 * eg) = acc[a];
            __syncthreads();
            { const int row = F.tid >> 3, e0 = (F.tid & 7) * 4;
                f32x4 sum = *(const LAS f32x4*)(red + row * 32 + e0) + *(const LAS f32x4*)(red + (64 + row) * 32 + e0) + *(const LAS f32x4*)(red + (128 + row) * 32 + e0) + *(const LAS f32x4*)(red + (192 + row) * 32 + e0);
#pragma unroll
                for (int q = 0; q < 4; ++q) lg[row * 33 + e0 + q] = sum[q] + br[e0 + q]; }
            __syncthreads();
            if (F.tid < 64) { const int tok = rb * 64 + F.tid; float vals[4]; int idx[4]; unsigned taken = 0u;
#pragma unroll
                for (int k = 0; k < 4; ++k) { float best = -3.0e38f; int bi = 0;
                    for (int e = 0; e < NE; ++e) { const float x = lg[F.tid * 33 + e]; if (!((taken >> e) & 1u) && x > best) { best = x; bi = e; } }
                    taken |= 1u << bi; vals[k] = best; idx[k] = bi; }
                float den = 0.f, ex[4];
#pragma unroll
                for (int k = 0; k < 4; ++k) { ex[k] = __expf(vals[k] - vals[0]); den += ex[k]; }
#pragma unroll
                for (int k = 0; k < 4; ++k) { topi[tok * 4 + k] = idx[k]; topg[tok * 4 + k] = ex[k] / den; atomicAdd((int*)&hh[idx[k]], 1); }
            }
            __syncthreads();
            if (F.tid < 32) hist[rb * 32 + F.tid] = hh[F.tid];
        }
        __syncthreads();
    }
}

__device__ __forceinline__ void moe_place(Frame& F) {
    const int* topi = (const int*)(F.ws + WS_ROUTE + RT_TOPI); int* destp = (int*)(F.ws + WS_ROUTE + RT_DEST); const int* hist = (const int*)(F.ws + WS_ROUTE + RT_HIST);
    int* tile = (int*)(F.ws + WS_SMALL + SM_TILE);
    unsigned short* rowtok = (unsigned short*)(F.ws + WS_ROUTE + RT_ROWTOK);
    LAS int* tot = (LAS int*)F.lds; LAS int* pre = tot + 32; LAS int* pst = pre + 32; LAS int* es = pst + 32; LAS int* dst = es + 256;
    for (int rb = F.vcu; rb < NTOK / 64; rb += F.G) {
        if (F.tid < 64) tot[F.tid] = 0;
        __syncthreads();
        { const int e = F.tid & 31, part = F.tid >> 5; int sa = 0, sp = 0;
            for (int q = 0; q < 16; ++q) { const int bb = part * 16 + q; const int hv = hist[bb * 32 + e]; sa += hv; if (bb < rb) sp += hv; }
            atomicAdd((int*)&tot[e], sa); atomicAdd((int*)&pre[e], sp); }
        if (F.tid < 256) es[F.tid] = topi[rb * 256 + F.tid];
        __syncthreads();
        if (F.tid == 0) { int run = 0; for (int e = 0; e < NE; ++e) { pst[e] = run; run += (tot[e] + 255) & ~255; }
            if (rb == 0) tile[0] = run >> 8; }
        __syncthreads();
        if (rb == 0 && F.tid < NE) { const int e = F.tid, t0 = pst[e] >> 8, n = (tot[e] + 255) >> 8; for (int q = 0; q < n; ++q) tile[1 + t0 + q] = e; }
        LAS int* wcn = dst + 256;
        int myrank = 0; const int me = (F.tid < 256) ? es[F.tid] : -1;
        if (F.tid < 256) { for (int x = 0; x < NE; ++x) { const unsigned long long m = __ballot(me == x); if (me == x) myrank = __popcll(m & ((1ull << F.lane) - 1ull)); if (F.lane == 0) wcn[F.wave * 32 + x] = __popcll(m); } }
        __syncthreads();
        if (F.tid < 256) { int base = 0; for (int w2 = 0; w2 < F.wave; ++w2) base += wcn[w2 * 32 + me];
            const int d = pst[me] + pre[me] + base + myrank; dst[F.tid] = d; destp[rb * 256 + F.tid] = d; }
        __syncthreads();
        if (F.tid < 256) rowtok[dst[F.tid]] = (unsigned short)(rb * 64 + (F.tid >> 2));
        if (rb < NE) { const int e = rb, r0 = pst[e] + tot[e], r1 = pst[e] + ((tot[e] + 255) & ~255);
            for (int r = r0 + F.tid; r < r1; r += NTHR) rowtok[r] = 0; }
        __syncthreads();
    }
}

__device__ __forceinline__ int load_tile_table(Frame& F) {
    const int* tile = (const int*)(F.ws + WS_SMALL + SM_TILE);
    const int ntiles = __builtin_amdgcn_readfirstlane(tile[0]);
    LAS int* tl = (LAS int*)(F.lds + TILE_LDS_OFF);
    if (F.tid < 320) tl[F.tid] = tile[1 + F.tid];
    __syncthreads();
    return ntiles;
}
__device__ __forceinline__ void qk_norm_rope(Frame& F) {
    LAS float* cs = (LAS float*)F.lds;
    LAS float* sn = cs + 2048;
    for (int i = F.tid; i < 2048; i += NTHR) { const int pos = i >> 5, j = i & 31; const float inv = powf(10000.0f, -(float)(2 * j) / 64.0f); float s, c; sincosf((float)pos * inv, &s, &c); cs[i] = c; sn[i] = s; }
    __syncthreads();
    bf16_t* QKV = (bf16_t*)(F.ws + WS_SCR + SC_QKV);
    const float* qg = F.in[9]; const float* kg = F.in[10];
    const int gw = F.vcu * NWAVES + F.wave, NGW = F.G * NWAVES;
    const int hs = F.lane >> 5, i = F.lane & 31;
    const float gq1 = qg[hs * 64 + i], gq2 = qg[hs * 64 + 32 + i], gk1 = kg[hs * 64 + i], gk2 = kg[hs * 64 + 32 + i];
    for (int tok = gw; tok < NTOK; tok += NGW) {
        const int l = tok & (SEQ - 1), pos = hs ? (l & 63) : (l >> 6);
        bf16_t* p = QKV + (size_t)tok * QKVC + hs * 64 + i;
        float x1[12], x2[12];
#pragma unroll
        for (int hd = 0; hd < 12; ++hd) { x1[hd] = bf2f(p[hd * 128]); x2[hd] = bf2f(p[hd * 128 + 32]); }
        const float c = cs[pos * 32 + i], s = sn[pos * 32 + i];
#pragma unroll
        for (int hd = 0; hd < 12; ++hd) {
            const float ss = wave_sum(x1[hd] * x1[hd] + x2[hd] * x2[hd]), r = __builtin_amdgcn_rsqf(ss * (1.f / 128.f) + RMS_EPS);
            const float y1 = x1[hd] * r * (hd < 8 ? gq1 : gk1), y2 = x2[hd] * r * (hd < 8 ? gq2 : gk2);
            p[hd * 128] = f2bf(y1 * c - y2 * s); p[hd * 128 + 32] = f2bf(y2 * c + y1 * s); }
    }
}
__device__ __forceinline__ void attn_phase(Frame& F) {
    const bf16_t* QKV = (const bf16_t*)(F.ws + WS_SCR + SC_QKV); bf16_t* O = (bf16_t*)(F.ws + WS_SCR + SC_O);
    for (int id0 = F.vcu; id0 < 512; id0 += F.G) {
        const int bk = id0 >> 5, j = id0 & 31, b = bk >> 2, kvh = bk & 3, h = kvh * 2 + (j >> 4), qb = j & 15;
        const bf16_t* Qb = QKV + ((size_t)b * SEQ + qb * 256) * QKVC + h * 128;
        const bf16_t* Kh = QKV + ((size_t)b * SEQ) * QKVC + 1024 + kvh * 128;
        const bf16_t* Vh = QKV + ((size_t)b * SEQ) * QKVC + 1536 + kvh * 128;
        bf16_t* Ob = O + ((size_t)b * SEQ + qb * 256) * D + h * 128;
        att::attn_dense_body(Qb, Kh, Vh, Ob, SEQ, F.ldsg, F.wave);
    }
}

__device__ __forceinline__ void s5_scan_unit(Frame& F, int g, int b) {
    const float* S = (const float*)(F.ws + WS_SCR + SC_SST); bf16_t* AOP = (bf16_t*)(F.ws + WS_SCR + SC_AOP);
    const f32x2* aT = (const f32x2*)(F.ws + WS_SMALL + SM_AT);
    if (F.tid < 128) {
        const int p = F.tid & 63, dir = F.tid >> 6;
        const f32x2 a = aT[(dir * S5G + g) * S5P + p];
        const size_t rowbase = (size_t)g * 1024 + b * 256; const int n = dir * 128 + p;
        float er = 0.f, ei = 0.f;
        for (int jj = 0; jj < S5NCH; jj += 32) {
            float sr[32], si[32];
#pragma unroll
            for (int q = 0; q < 32; ++q) { const int j = dir ? (S5NCH - 1 - (jj + q)) : (jj + q); sr[q] = S[(rowbase + j) * 256 + n]; si[q] = S[(rowbase + j) * 256 + n + 64]; }
#pragma unroll
            for (int q = 0; q < 32; ++q) { const int j = dir ? (S5NCH - 1 - (jj + q)) : (jj + q);
                bf16_t* o = AOP + (rowbase + j) * 512 + 256 + n; o[0] = f2bf(er); o[64] = f2bf(ei);
                const float nr = a.x * er - a.y * ei + sr[q], ni = a.x * ei + a.y * er + si[q]; er = nr; ei = ni; }
        }
    }
}

namespace hg {
constexpr int PQ = 272, PK = 144;
constexpr int IMG_QD = 0, IMG_KLT = 64 * PQ, IMG_ATT = IMG_KLT + 128 * PK, IMG_DEC = IMG_ATT + 64 * PK, IMG_BYTES = IMG_DEC + 512, IMG_PIECES = IMG_BYTES / 16;
__device__ __forceinline__ bf16x8 ldsv(LAS unsigned char* base, int off) { return *(const LAS bf16x8*)(base + off); }
__device__ __forceinline__ unsigned char* img_ptr(unsigned char* ws, int b, int hh, int dir, int n) { return ws + WS_HGIMG + (size_t)((((b * 8 + hh) * 2 + dir) * 64) + n) * IMG_BYTES; }

__device__ __forceinline__ void hgrn_prep(Frame& F) {
    constexpr int KD = 0, IMG = KD + 64 * PQ, BUFB = IMG + IMG_BYTES;
    static_assert(2 * BUFB <= RING_BYTES, "LDS map");
    const bf16_t* P = (const bf16_t*)(F.ws + WS_SCR + SC_P);
    const float* lbp = (const float*)(F.ws + WS_SMALL + SM_LB);
    LAS unsigned char* L = F.lds;
    const int tid = F.tid, lane = F.lane, w = F.wave, fr = lane & 15, fq = lane >> 4;
    const int d0 = 16 * w + 2 * (lane & 7), t0 = (lane >> 3) * 8;
    unsigned rq[8], rf[8];
#define HG_LOAD(item_) do { const int n_ = (item_) & 63, dir_ = ((item_) >> 6) & 1, hh_ = ((item_) >> 7) & 7, b_ = (item_) >> 10; \
        _Pragma("unroll") for (int i_ = 0; i_ < 8; ++i_) { const int tau = n_ * 64 + t0 + i_; const size_t l_ = dir_ ? (size_t)(SEQ - 1 - tau) : (size_t)tau; \
            const bf16_t* row_ = P + ((size_t)b_ * SEQ + l_) * 5120 + hh_ * 128 + d0; rq[i_] = *(const unsigned*)(row_); rf[i_] = *(const unsigned*)(row_ + 1024 * (1 + dir_)); } } while (0)
    int item = F.vcu, par = 0;
    if (item < 4096) HG_LOAD(item);
    for (; item < 4096; item += F.G) {
        const int n = item & 63, dir = (item >> 6) & 1, hh = (item >> 7) & 7, b = item >> 10;
        const float lb0 = lbp[hh * 128 + d0], lb1 = lbp[hh * 128 + d0 + 1], om0 = 1.f - lb0, om1 = 1.f - lb1;
        LAS unsigned char* Lb = L + par * BUFB;
        unsigned cq[8], cf[8];
#pragma unroll
        for (int i = 0; i < 8; ++i) { cq[i] = rq[i]; cf[i] = rf[i]; }
        if (item + F.G < 4096) HG_LOAD(item + F.G);
        float cs0[8], cs1[8], k0[8], k1[8]; float c0 = 1.f, c1 = 1.f;
#pragma unroll
        for (int i = 0; i < 8; ++i) { const unsigned fw = cf[i];
            const float s0 = sigmoidf_(bflo(fw)), s1 = sigmoidf_(bfhi(fw));
            c0 *= lb0 + om0 * s0; c1 *= lb1 + om1 * s1; cs0[i] = c0; cs1[i] = c1; k0[i] = om0 * (1.f - s0); k1[i] = om1 * (1.f - s1); }
        float inc0 = c0, inc1 = c1;
#pragma unroll
        for (int sh = 8; sh < 64; sh <<= 1) { const float u0 = __shfl_up(inc0, sh), u1 = __shfl_up(inc1, sh); if (lane >= sh) { inc0 *= u0; inc1 *= u1; } }
        float off0 = __shfl_up(inc0, 8), off1 = __shfl_up(inc1, 8); if (lane < 8) { off0 = 1.f; off1 = 1.f; }
        const float tot0 = __shfl(inc0, 56 + (lane & 7)), tot1 = __shfl(inc1, 56 + (lane & 7));
        float kl0[8], kl1[8]; const float et0 = tot0, et1 = tot1;
        const float ri0 = __builtin_amdgcn_rcpf(off0 * cs0[7]), ri1 = __builtin_amdgcn_rcpf(off1 * cs1[7]); float suf0 = 1.f, suf1 = 1.f;
#pragma unroll
        for (int i = 7; i >= 0; --i) { const int t = t0 + i;
            const unsigned qw = cq[i]; const float q0 = bflo(qw), q1 = bfhi(qw);
            const float e0 = off0 * cs0[i], e1 = off1 * cs1[i], r0 = ri0 * suf0, r1 = ri1 * suf1; suf0 *= 1.f - k0[i]; suf1 *= 1.f - k1[i];
            *(LAS unsigned*)(Lb + IMG + IMG_QD + t * PQ + d0 * 2) = cvt_pk_bf16(siluf_(q0) * e0, siluf_(q1) * e1);
            *(LAS unsigned*)(Lb + KD + t * PQ + d0 * 2) = cvt_pk_bf16(k0[i] * r0, k1[i] * r1);
            kl0[i] = k0[i] * r0 * et0; kl1[i] = k1[i] * r1 * et1; }
        *(LAS u32x4*)(Lb + IMG + IMG_KLT + d0 * PK + t0 * 2) = (u32x4){cvt_pk_bf16(kl0[0], kl0[1]), cvt_pk_bf16(kl0[2], kl0[3]), cvt_pk_bf16(kl0[4], kl0[5]), cvt_pk_bf16(kl0[6], kl0[7])};
        *(LAS u32x4*)(Lb + IMG + IMG_KLT + (d0 + 1) * PK + t0 * 2) = (u32x4){cvt_pk_bf16(kl1[0], kl1[1]), cvt_pk_bf16(kl1[2], kl1[3]), cvt_pk_bf16(kl1[4], kl1[5]), cvt_pk_bf16(kl1[6], kl1[7])};
        if (lane < 8) *(LAS f32x2*)(Lb + IMG + IMG_DEC + d0 * 4) = (f32x2){et0, et1};
        __syncthreads();
        { const int a = w >> 1;
#pragma unroll
            for (int bi = 0; bi < 2; ++bi) { const int bt_ = (w & 1) * 2 + bi; f32x4 acc = {0.f, 0.f, 0.f, 0.f};
#pragma unroll
                for (int ks = 0; ks < 4; ++ks) { const bf16x8 X = ldsv(Lb, KD + (16 * bt_ + fr) * PQ + (ks * 32 + 8 * fq) * 2), Y = ldsv(Lb, IMG + IMG_QD + (16 * a + fr) * PQ + (ks * 32 + 8 * fq) * 2);
                    acc = __builtin_amdgcn_mfma_f32_16x16x32_bf16(X, Y, acc, 0, 0, 0); }
                const int t = 16 * a + fr, s0 = 16 * bt_ + 4 * fq;
                const float v0 = (s0 + 0 <= t) ? acc[0] : 0.f, v1 = (s0 + 1 <= t) ? acc[1] : 0.f, v2 = (s0 + 2 <= t) ? acc[2] : 0.f, v3 = (s0 + 3 <= t) ? acc[3] : 0.f;
                *(LAS u32x2*)(Lb + IMG + IMG_ATT + t * PK + s0 * 2) = (u32x2){cvt_pk_bf16(v0, v1), cvt_pk_bf16(v2, v3)}; } }
        __syncthreads();
        { unsigned char* g = img_ptr(F.ws, b, hh, dir, n);
#pragma unroll
            for (int it = 0; it < 6; ++it) { const int pc = it * 512 + tid; if (pc < IMG_PIECES) *(u32x4*)(g + pc * 16) = *(const LAS u32x4*)(Lb + IMG + pc * 16); } }
        par ^= 1;
    }
    __syncthreads();
#undef HG_LOAD
}

__device__ __forceinline__ void hgrn_rec(Frame& F) {
    constexpr int IMG0 = 0, IMG1 = IMG_BYTES, VT = 2 * IMG_BYTES, ST = VT + 2 * 32 * PK;
    const bf16_t* P = (const bf16_t*)(F.ws + WS_SCR + SC_P); float* OFB = (float*)(F.ws + WS_SCR + SC_OFB);
    LAS unsigned char* L = F.lds;
    const int tid = F.tid, lane = F.lane, w = F.wave, fr = lane & 15, fq = lane >> 4;
    for (int unit = F.vcu; unit < 256; unit += F.G) {
        const int vs = unit & 3, dir = (unit >> 2) & 1, hh = (unit >> 3) & 7, b = unit >> 6;
        const size_t tok0 = (size_t)b * SEQ; const int cv = 3072 + hh * 128 + vs * 32;
        for (int i = tid; i < 2 * 32 * PQ / 4; i += NTHR) ((LAS unsigned*)(L + ST))[i] = 0u;
        f32x4 sacc[2] = {(f32x4){0.f, 0.f, 0.f, 0.f}, (f32x4){0.f, 0.f, 0.f, 0.f}};
        u32x4 rv = {0u, 0u, 0u, 0u};
#define HG_DMA(n_, buf_) do { const unsigned char* g_ = img_ptr(F.ws, b, hh, dir, (n_)); _Pragma("unroll") for (int it = 0; it < 6; ++it) { const int pc = it * 512 + tid; \
            if (pc < IMG_PIECES) __builtin_amdgcn_global_load_lds((const unsigned*)(g_ + (size_t)pc * 16), (LAS unsigned*)(L + (buf_) + (it * 512 + w * 64) * 16), 16, 0, 0); } } while (0)
#define HG_LOADV(n_) do { if (tid < 256) { const int t_ = tid >> 2, v8 = (tid & 3) * 8; const int tau = (n_) * 64 + t_; const size_t l_ = dir ? (size_t)(SEQ - 1 - tau) : (size_t)tau; rv = *(const u32x4*)(P + (tok0 + l_) * 5120 + cv + v8); } } while (0)
        HG_DMA(0, IMG0); HG_LOADV(0);
        for (int n = 0; n < HGNCH; ++n) {
            const int cur = n & 1, nxt = cur ^ 1; LAS unsigned char* I = L + (cur ? IMG1 : IMG0); LAS unsigned char* V = L + VT + cur * 32 * PK;
            VM_WAIT();
            if (tid < 256) { const int s = tid >> 2, v8 = (tid & 3) * 8; const unsigned wv[4] = {rv.x, rv.y, rv.z, rv.w};
#pragma unroll
                for (int q = 0; q < 4; ++q) { *(LAS unsigned short*)(V + (v8 + 2 * q) * PK + s * 2) = (unsigned short)(wv[q] & 0xffffu); *(LAS unsigned short*)(V + (v8 + 2 * q + 1) * PK + s * 2) = (unsigned short)(wv[q] >> 16); } }
            __syncthreads();
            if (n + 1 < HGNCH) { if (nxt) HG_DMA(n + 1, IMG1); else HG_DMA(n + 1, IMG0); HG_LOADV(n + 1); }
            { const int a = w >> 1, cvt = w & 1; f32x4 acc = {0.f, 0.f, 0.f, 0.f};
#pragma unroll
                for (int ks = 0; ks < 2; ++ks) { const bf16x8 X = ldsv(V, (16 * cvt + fr) * PK + (ks * 32 + 8 * fq) * 2), Y = ldsv(I, IMG_ATT + (16 * a + fr) * PK + (ks * 32 + 8 * fq) * 2);
                    acc = __builtin_amdgcn_mfma_f32_16x16x32_bf16(X, Y, acc, 0, 0, 0); }
#pragma unroll
                for (int ks = 0; ks < 4; ++ks) { const bf16x8 X = ldsv(L, ST + cur * 32 * PQ + (16 * cvt + fr) * PQ + (ks * 32 + 8 * fq) * 2), Y = ldsv(I, IMG_QD + (16 * a + fr) * PQ + (ks * 32 + 8 * fq) * 2);
                    acc = __builtin_amdgcn_mfma_f32_16x16x32_bf16(X, Y, acc, 0, 0, 0); }
                { const int tau = n * 64 + 16 * a + fr; const size_t l_ = dir ? (size_t)(SEQ - 1 - tau) : (size_t)tau;
                    *(f32x4*)(OFB + ((size_t)dir * NTOK + tok0 + l_) * D + hh * 128 + vs * 32 + 16 * cvt + 4 * fq) = acc; }
#pragma unroll
                for (int i = 0; i < 2; ++i) { const int e = (w >> 1) * 2 + i; f32x4 a2 = {0.f, 0.f, 0.f, 0.f};
#pragma unroll
                    for (int ks = 0; ks < 2; ++ks) { const bf16x8 X = ldsv(I, IMG_KLT + (16 * e + fr) * PK + (ks * 32 + 8 * fq) * 2), Y = ldsv(V, (16 * cvt + fr) * PK + (ks * 32 + 8 * fq) * 2);
                        a2 = __builtin_amdgcn_mfma_f32_16x16x32_bf16(X, Y, a2, 0, 0, 0); }
                    const f32x4 dc = *(const LAS f32x4*)(I + IMG_DEC + (16 * e + 4 * fq) * 4);
                    sacc[i] = dc * sacc[i] + a2;
                    *(LAS u32x2*)(L + ST + nxt * 32 * PQ + (16 * cvt + fr) * PQ + (16 * e + 4 * fq) * 2) = (u32x2){cvt_pk_bf16(sacc[i][0], sacc[i][1]), cvt_pk_bf16(sacc[i][2], sacc[i][3])}; } }
        }
        VM_WAIT(); __syncthreads();
#undef HG_DMA
#undef HG_LOADV
    }
}
__device__ __forceinline__ void hgrn_combine(Frame& F) {
    const float* OFB = (const float*)(F.ws + WS_SCR + SC_OFB); const bf16_t* P = (const bf16_t*)(F.ws + WS_SCR + SC_P); bf16_t* HA = (bf16_t*)(F.ws + WS_SCR + SC_HA);
    const float* ng = F.in[24];
    const int gw = F.vcu * NWAVES + F.wave, NGW = F.G * NWAVES;
    for (int row0 = gw; row0 < NTOK; row0 += 2 * NGW) {
        f32x4 a[2][4], bq[2][4]; u32x2 gw_[2][4];
#pragma unroll
        for (int rr = 0; rr < 2; ++rr) { const int row = row0 + rr * NGW;
#pragma unroll
            for (int j = 0; j < 4; ++j) { const int col = 256 * j + 4 * F.lane; a[rr][j] = *(const f32x4*)(OFB + (size_t)row * D + col); bq[rr][j] = *(const f32x4*)(OFB + ((size_t)NTOK + row) * D + col); gw_[rr][j] = *(const u32x2*)(P + (size_t)row * 5120 + 4096 + col); } }
#pragma unroll
        for (int rr = 0; rr < 2; ++rr) { const int row = row0 + rr * NGW;
#pragma unroll
            for (int j = 0; j < 4; ++j) { const int col = 256 * j + 4 * F.lane; const f32x4 o = a[rr][j] + bq[rr][j];
                float ss = (o[0] * o[0] + o[1] * o[1]) + (o[2] * o[2] + o[3] * o[3]);
                ss = half_wave_sum(ss);
                const float r = __builtin_amdgcn_rsqf(ss * (1.f / 128.f) + RMS_EPS);
                const f32x4 gn = *(const f32x4*)(ng + col);
                const float g0 = bflo(gw_[rr][j].x), g1 = bfhi(gw_[rr][j].x), g2 = bflo(gw_[rr][j].y), g3 = bfhi(gw_[rr][j].y);
                const float r0 = o[0] * r * gn[0] * siluf_(g0), r1 = o[1] * r * gn[1] * siluf_(g1), r2 = o[2] * r * gn[2] * siluf_(g2), r3 = o[3] * r * gn[3] * siluf_(g3);
                *(u32x2*)(HA + (size_t)row * D + col) = (u32x2){cvt_pk_bf16(r0, r1), cvt_pk_bf16(r2, r3)}; } }
    }
}
}
#ifndef PROBE_KIND
#define PROBE_KIND 0
#endif
constexpr int probe_reps(int id) {
    const int k = (id >= 1 && id <= 64) ? (id - 1) % 16 : -1, layer = (id >= 1 && id <= 64) ? (id - 1) / 16 : -1;
    return (PROBE_KIND == 1 && (k == 8 || k == 9)) ? 2 : (PROBE_KIND == 2 && id == 0) ? 2 : (PROBE_KIND == 3 && layer == 3 && (k == 2 || k == 3)) ? 2 : (PROBE_KIND == 4 && layer == 1 && k == 3) ? 2 :
           (PROBE_KIND == 5 && layer == 0 && k == 1) ? 2 : (PROBE_KIND == 6 && k == 7) ? 2 : (PROBE_KIND == 8 && layer == 2 && k >= 1 && k <= 5) ? 2 : (PROBE_KIND == 9 && layer == 3 && k == 1) ? 2 : (PROBE_KIND == 11 && layer == 3 && k == 2) ? 2 : (PROBE_KIND == 17 && layer == 3 && k == 3) ? 2 : (PROBE_KIND == 18 && layer == 3 && k == 4) ? 2 : (PROBE_KIND == 19 && layer == 1 && k == 2) ? 2 : (PROBE_KIND == 20 && layer == 2 && k == 2) ? 2 : (PROBE_KIND == 21 && layer == 0 && k == 0) ? 2 : 1;
}
#define IN(id) (lo <= (id) && (id) < hi)
#define SEAM(id) do { if ((id) + 1 < hi) { xcd_barrier(bar); if (PROBE_KIND == 7) xcd_barrier(bar); } } while (0)
#define RUN(id, ...) do { if (IN(id)) { _Pragma("unroll") for (int rep_ = 0; rep_ < probe_reps(id); ++rep_) { F.lane = lane_now(); F.tid = F.wave * 64 + F.lane; __VA_ARGS__; SEAM(id); } } } while (0)
constexpr int FILL_PER_SLOT = 3;
template <int layer> __device__ __forceinline__ void layer_body(Frame& F, const int lo, const int hi, const XcdBarrier& bar) {
    unsigned char* const ws = F.ws; const char* wsm = (const char*)(ws + WS_WSM);
        constexpr int pb = 1 + 16 * layer;
        RUN(pb, rowpass(F, layer, 0));
        if constexpr (layer == 0) {
            RUN(pb + 1, {
                pg8::Gemm g{(const char*)(ws + WS_DFTL), (const char*)(ws + WS_H), SEQ / 2, SEQ / 2, SEQ / 2};
                {
                    const unsigned char* hT = ws + WS_H; bf16_t* C1 = (bf16_t*)(ws + WS_SCR + SC_C1);
                    for (int rowi = F.vcu * NWAVES + F.wave; rowi < NB * D; rowi += F.G * NWAVES) { float sgn = 0.f;
                        _Pragma("unroll") for (int q = 0; q < 4; ++q) { const u32x4 w4 = *(const u32x4*)(hT + (size_t)rowi * SEQ + F.lane * 64 + q * 16);
                            _Pragma("unroll") for (int d = 0; d < 4; ++d) { const int w = (int)w4[d]; const f32x2 lo = __builtin_amdgcn_cvt_pk_f32_fp8(w, false), hi = __builtin_amdgcn_cvt_pk_f32_fp8(w, true); sgn += (lo.x - lo.y) + (hi.x - hi.y); } }
                        sgn = wave_sum(sgn) * (1.0f / (S8_H * 64.0f));
                        if (F.lane == 0) { const int b = rowi >> 10, ch = rowi & 1023; bf16_t* o = C1 + (((size_t)b * SEQ + 2048) * 4 + (ch >> 8)) * 512 + (ch & 255); o[0] = f2bf(sgn); o[256] = f2bf(0.f); } } }
                pg8::Order<MapF1> S; S.init(16, 4, NB, F.G, F.vcu, MapF1{});
                EpiBf16 E{(bf16_t*)(ws + WS_SCR + SC_C1), 2048, 1.0f / (256.0f * S8_H * 64.0f)};
                pg8::gemm_phase<EpiBf16, pg8::Order<MapF1>, true>(F.lds, F.wave, g, S, E); });
            RUN(pb + 2, {
                pg8::Gemm g{(const char*)(ws + WS_SCR + SC_C1), (const char*)(ws + WS_SMALL + SM_DFTC), 512, 512, 512};
                pg8::Order<MapF2h> S; S.init(4 * 33, 1, 1, F.G, F.vcu, MapF2h{});
                EpiF2 E{(bf16_t*)(ws + WS_SCR + SC_MIX)};
                pg8::gemm_phase(F.lds, F.wave, g, S, E); });
            RUN(pb + 3, {
                pg8::Gemm g{(const char*)(ws + WS_SCR + SC_MIX), wsm + W_FNET, D, D, D};
                pg8::Order<MapPlain> S; S.init(64, 4, 1, F.G, F.vcu, MapPlain{D, D, D});
                EpiBf16B E{(bf16_t*)(ws + WS_Y), D, 1.f, F.in[7]};
                pg8::gemm_phase(F.lds, F.wave, g, S, E); });
        }
        if constexpr (layer == 1) {
            RUN(pb + 1, {
                LAS unsigned* cs2 = (LAS unsigned*)(F.lds + pg8::BIAS_LDS_OFF);
                for (int i = F.tid; i < 2048; i += NTHR) { const int pos = i >> 5, j = i & 31; const float inv = powf(10000.0f, -(float)(2 * j) / 64.0f); float sn_, cs_; sincosf((float)pos * inv, &sn_, &cs_); cs2[i] = cvt_pk_bf16(cs_, sn_); }
                __syncthreads();
                pg8::Gemm g{(const char*)(ws + WS_H), wsm + W_QKV, D / 2, 64, D / 2, 128, 32768};
                pg8::Order<MapPlain> S; S.init(64, 8, 1, F.G, F.vcu, MapPlain{D / 2, D / 2, QKVC});
                EpiQKV E{(bf16_t*)(ws + WS_SCR + SC_QKV), 1.0f / (S8_H * S8_WGU), F.in[9], F.in[10], cs2};
                pg8::gemm_phase<EpiQKV, pg8::Order<MapPlain>, true>(F.lds, F.wave, g, S, E); });
            RUN(pb + 3, attn_phase(F));
            RUN(pb + 4, {
                pg8::Gemm g{(const char*)(ws + WS_SCR + SC_O), wsm + W_AO, D, D, D};
                pg8::Order<MapPlain> S; S.init(64, 4, 1, F.G, F.vcu, MapPlain{D, D, D});
                EpiBf16 E{(bf16_t*)(ws + WS_Y), D};
                pg8::gemm_phase(F.lds, F.wave, g, S, E); });
        }
        if constexpr (layer == 2) {
            RUN(pb + 1, {
                pg8::Gemm g{(const char*)(ws + WS_SCR + SC_AOP), (const char*)(ws + WS_S5M), 512, 256, 256};
                pg8::Order<MapS5> S; S.init(4, 1, S5G, F.G, F.vcu, MapS5{256});
                EpiF32 E{(float*)(ws + WS_SCR + SC_SST), 256, nullptr};
                pg8::gemm_phase(F.lds, F.wave, g, S, E);
                VM_WAIT(); __syncthreads(); __builtin_amdgcn_fence(__ATOMIC_ACQUIRE, "agent"); VM_WAIT();
                { pg8::Unit uu; for (int i = 0; S.next(i, uu); ++i) s5_scan_unit(F, uu.z, uu.pm); } });
            RUN(pb + 3, {
                pg8::Gemm g{(const char*)(ws + WS_SCR + SC_AOP), (const char*)(ws + WS_S5T), 512, 512, 512};
                pg8::Order<MapS5> S; S.init(4, 1, S5G, F.G, F.vcu, MapS5{512});
                EpiS5Out E{(bf16_t*)(ws + WS_SCR + SC_YBF)};
                pg8::gemm_phase(F.lds, F.wave, g, S, E); });
            RUN(pb + 4, {
                pg8::Gemm g{(const char*)(ws + WS_SCR + SC_YBF), wsm + W_GLU, D, D, D};
                pg8::Order<MapPlain> S; S.init(64, 4, 1, F.G, F.vcu, MapPlain{D, D, D});
                EpiGlu E{(const bf16_t*)(ws + WS_SCR + SC_YBF), (bf16_t*)(ws + WS_SCR + SC_Z)};
                pg8::gemm_phase(F.lds, F.wave, g, S, E); });
            RUN(pb + 5, {
                pg8::Gemm g{(const char*)(ws + WS_SCR + SC_Z), wsm + W_SO, D, D, D};
                pg8::Order<MapPlain> S; S.init(64, 4, 1, F.G, F.vcu, MapPlain{D, D, D});
                EpiBf16 E{(bf16_t*)(ws + WS_Y), D};
                pg8::gemm_phase(F.lds, F.wave, g, S, E); });
        }
        if constexpr (layer == 3) {
            RUN(pb + 1, {
                pg8::Gemm g{(const char*)(ws + WS_H), wsm + W_HIN, D / 2, 64, D / 2, 128, 32768};
                pg8::Order<MapPlain> S; S.init(64, 20, 1, F.G, F.vcu, MapPlain{D / 2, D / 2, 5 * D});
                EpiBf16 E{(bf16_t*)(ws + WS_SCR + SC_P), 5 * D, 1.0f / (S8_H * S8_WGU)};
                pg8::gemm_phase<EpiBf16, pg8::Order<MapPlain>, true>(F.lds, F.wave, g, S, E); });
            RUN(pb + 2, hg::hgrn_prep(F));
            RUN(pb + 3, hg::hgrn_rec(F));
            RUN(pb + 4, hg::hgrn_combine(F));
            RUN(pb + 5, {
                pg8::Gemm g{(const char*)(ws + WS_SCR + SC_HA), wsm + W_HO, D, D, D};
                pg8::Order<MapPlain> S; S.init(64, 4, 1, F.G, F.vcu, MapPlain{D, D, D});
                EpiBf16 E{(bf16_t*)(ws + WS_Y), D};
                pg8::gemm_phase(F.lds, F.wave, g, S, E); });
        }
        RUN(pb + 6, rowpass(F, layer, 1));
        RUN(pb + 7, { moe_place(F); if (layer == DEPTH - 1) deferred_fill(F, -1); });
        RUN(pb + 8, {
            const int ntiles = load_tile_table(F); const LAS int* tile = (const LAS int*)(F.lds + TILE_LDS_OFF) - 1;
            pg8::Gemm g{(const char*)(ws + WS_H), (const char*)(ws + WS_WGU), D / 2, 64, D / 2, 128, 32768};
            pg8::Order<MapMoe> S; S.init(ntiles, 8, 1, F.G, F.vcu, MapMoe{tile + 1, (size_t)layer * NE * 2 * DEX * D, 2 * DEX, 0});
            LAS unsigned short* tbl = (LAS unsigned short*)(F.lds + ROWTBL_LDS_OFF);
            { const unsigned short* rowtok = (const unsigned short*)(ws + WS_ROUTE + RT_ROWTOK);
                int pms[ROWTBL_MAXU];
                _Pragma("unroll") for (int i = 0; i < ROWTBL_MAXU; ++i) { pg8::Unit uu; pms[i] = S.next(i, uu) ? uu.pm : -1; }
                if (F.tid < 256) { unsigned short vals[ROWTBL_MAXU];
                    _Pragma("unroll") for (int i = 0; i < ROWTBL_MAXU; ++i) vals[i] = (pms[i] >= 0) ? rowtok[pms[i] * 256 + F.tid] : (unsigned short)0;
                    _Pragma("unroll") for (int i = 0; i < ROWTBL_MAXU; ++i) tbl[i * 256 + F.tid] = vals[i]; }
                __syncthreads(); }
            EpiMoeGU E{ws + WS_SCR + SC_ACT, F.in[29] + (size_t)layer * NE * 2 * DEX};
            pg8::gemm_phase<EpiMoeGU, pg8::Order<MapMoe>, true, true>(F.lds, F.wave, g, S, E, tbl);
            if (layer < DEPTH - 1) { const int total = ntiles * 8, maxu = (total + F.G - 1) / F.G, mine = (F.vcu < total) ? (total - F.vcu + F.G - 1) / F.G : 0; deferred_fill(F, (maxu - mine) * FILL_PER_SLOT); }
            if (PROBE_KIND >= 13 && PROBE_KIND <= 15) { xcd_barrier(bar); EpiNull E0; S.mp.probe = PROBE_KIND - 13; pg8::gemm_phase<EpiNull, pg8::Order<MapMoe>, true, true>(F.lds, F.wave, g, S, E0, tbl); } });
        RUN(pb + 9, {
            const int ntiles = load_tile_table(F); const LAS int* tile = (const LAS int*)(F.lds + TILE_LDS_OFF) - 1;
            pg8::Gemm g{(const char*)(ws + WS_SCR + SC_ACT), (const char*)(ws + WS_WDN), 64, 64, DEX / 2, 32768, 32768};
            pg8::Order<MapMoe> S; S.init(ntiles, 4, 1, F.G, F.vcu, MapMoe{tile + 1, (size_t)layer * NE * D * DEX, D});
            EpiMoeDown E{ws + WS_SCR + SC_DNO, F.in[31] + (size_t)layer * NE * D};
            pg8::gemm_phase<EpiMoeDown, pg8::Order<MapMoe>, true>(F.lds, F.wave, g, S, E);
            if (layer < DEPTH - 1) { const int total = ntiles * 4, maxu = (total + F.G - 1) / F.G, mine = (F.vcu < total) ? (total - F.vcu + F.G - 1) / F.G : 0; deferred_fill(F, (maxu - mine) * FILL_PER_SLOT); }
            if (PROBE_KIND >= 13 && PROBE_KIND <= 15) { xcd_barrier(bar); EpiNull E0; S.mp.probe = PROBE_KIND - 13; pg8::gemm_phase<EpiNull, pg8::Order<MapMoe>, true>(F.lds, F.wave, g, S, E0); } });
}
constexpr int PH_END = 66;
__global__ void __launch_bounds__(NTHR, 2) fwd_kernel(Args args) {
    extern __shared__ __attribute__((aligned(16))) unsigned char lds_raw[];
    Frame F;
    F.lds = (LAS unsigned char*)lds_raw; F.ldsg = (char*)lds_raw;
    F.tid = threadIdx.x; F.lane = F.tid & 63; F.wave = __builtin_amdgcn_readfirstlane(F.tid >> 6);
    F.G = gridDim.x; { const int bx = blockIdx.x; F.vcu = (F.G % 8 == 0) ? (bx % 8) * (F.G / 8) + bx / 8 : bx; }
    F.in = args.in; F.out = args.out; F.ws = args.ws;
    volatile LAS unsigned* MISC = (volatile LAS unsigned*)(F.lds + MISC_OFF);
    for (int u = F.tid; u < (LDS_BYTES - LDSCTL_OFF) / 4; u += NTHR) ((LAS unsigned*)(F.lds + LDSCTL_OFF))[u] = 0u;
    __syncthreads();
    const int lo = args.ph_lo, hi = args.ph_hi;
    XcdBarrier bar; bar.bar = (unsigned*)(F.ws + WS_CTL) + 4096; bar.x = 0; bar.st = MISC + 8; bar.wave = F.wave;
    if (hi - lo > 1) bar = xcd_barrier_post((unsigned*)(F.ws + WS_CTL) + 4096, MISC + 8, F.wave);
    unsigned char* const ws = F.ws;
    const char* wsm = (const char*)(ws + WS_WSM);

    RUN(0, p0_prologue(F));

    layer_body<0>(F, lo, hi, bar); layer_body<1>(F, lo, hi, bar); layer_body<2>(F, lo, hi, bar); layer_body<3>(F, lo, hi, bar);
    if (IN(65)) { F.lane = lane_now(); F.tid = F.wave * 64 + F.lane; rowpass(F, DEPTH, 0); }
}

#ifndef MK_ONE_LAUNCH
#define MK_ONE_LAUNCH 1
#endif
extern "C" void kernel_launch(void* const* d_in, const int* in_sizes, int n_in, void* d_out, int out_size, void* d_ws, size_t ws_size, hipStream_t stream) {
    static int grid = 0;
    if (grid == 0) {
        if (n_in != 32 || out_size != NTOK * D || ws_size < WS_END) { fprintf(stderr, "kernel_launch: unexpected shapes (n_in %d out %d ws %zu, need ws >= %zu)\n", n_in, out_size, ws_size, (size_t)WS_END); grid = -1; return; }
        int dev = 0, cus = 0, per_cu = 0;
        if (hipGetDevice(&dev) != hipSuccess || hipDeviceGetAttribute(&cus, hipDeviceAttributeMultiprocessorCount, dev) != hipSuccess) { grid = -1; return; }
        if (hipFuncSetAttribute((const void*)fwd_kernel, hipFuncAttributeMaxDynamicSharedMemorySize, LDS_BYTES) != hipSuccess) { fprintf(stderr, "kernel_launch: hipFuncSetAttribute failed\n"); grid = -1; return; }
        if (hipOccupancyMaxActiveBlocksPerMultiprocessor(&per_cu, (const void*)fwd_kernel, NTHR, LDS_BYTES) != hipSuccess || per_cu < 1)
            fprintf(stderr, "kernel_launch: occupancy query reports %d blocks per CU\n", per_cu);
        (void)hipGetLastError();
        grid = cus;
    }
    if (grid < 0) return;
    (void)hipMemsetAsync((char*)d_ws + WS_CTL, 0, CTL_ZERO_BYTES, stream);
    Args a{};
    for (int i = 0; i < 32; ++i) a.in[i] = (const float*)d_in[i];
    a.out = (float*)d_out; a.ws = (unsigned char*)d_ws;
#if MK_ONE_LAUNCH
    a.ph_lo = 0; a.ph_hi = PH_END;
    hipLaunchKernelGGL(fwd_kernel, dim3(grid), dim3(NTHR), LDS_BYTES, stream, a);
#else
    static const int nmix[4] = {3, 4, 5, 5};
    int ids[80], n = 0; ids[n++] = 0;
    for (int l = 0; l < DEPTH; ++l) { const int pb = 1 + 16 * l; ids[n++] = pb; for (int k = 1; k <= nmix[l]; ++k) ids[n++] = pb + k; for (int k = 6; k <= 9; ++k) ids[n++] = pb + k; }
    ids[n++] = 65;
    for (int i = 0; i < n; ++i) { a.ph_lo = ids[i]; a.ph_hi = ids[i] + 1; hipLaunchKernelGGL(fwd_kernel, dim3(grid), dim3(NTHR), LDS_BYTES, stream, a); }
#endif
    const hipError_t le = hipPeekAtLastError();
    if (le != hipSuccess) fprintf(stderr, "kernel_launch: launch failed: %s\n", hipGetErrorName(le));
}
```

```cpp
#include <hip/hip_runtime.h>
#include <cstdio>
#include <cstdint>

#ifndef PROBE_KIND
#define PROBE_KIND 0
#endif
#define LAS __attribute__((address_space(3)))
#define GAS __attribute__((address_space(1)))
typedef unsigned short bf16_t;
typedef short bf16x8 __attribute__((ext_vector_type(8)));
typedef short s16x4 __attribute__((ext_vector_type(4)));
typedef float f32x2 __attribute__((ext_vector_type(2)));
typedef float f32x4 __attribute__((ext_vector_type(4)));
typedef float f32x8 __attribute__((ext_vector_type(8)));
typedef float f32x16 __attribute__((ext_vector_type(16)));
typedef unsigned u32x2 __attribute__((ext_vector_type(2)));
typedef unsigned u32x4 __attribute__((ext_vector_type(4)));

constexpr int D = 1024, NB = 4, SEQ = 4096, NTOK = NB * SEQ, DEPTH = 4;
constexpr int HQ = 8, HK = 4, DH = 128, QKVC = (HQ + 2 * HK) * DH;
constexpr int S5G = 64, S5C = 16, S5P = 64, S5T = 16, S5NCH = SEQ / S5T;
constexpr int HGH = 8, HGD = 128, HGC = 64, HGNCH = SEQ / HGC;
constexpr int NE = 32, TOPK = 4, DEX = 1024;
constexpr int CAP = NTOK * TOPK + NE * 256;
constexpr float LN_EPS = 1e-5f, RMS_EPS = 1e-6f;
constexpr float DN_ALPHA = 1.6817928305074290f;
constexpr int NWAVES = 8, NTHR = 512;
constexpr int ADA_PARTS = 2, ADA_KP = D / ADA_PARTS;

constexpr size_t MiB = 1u << 20;
constexpr size_t WS_CTL = 0, CTL_ZERO_BYTES = 64 * 1024;
constexpr size_t WS_MODP = 1 * MiB;
constexpr size_t WS_SMALL = 4 * MiB;
constexpr size_t   SM_LB = 0;
constexpr size_t   SM_AT = 8192;
constexpr size_t   SM_TILE = 131072;
constexpr size_t   SM_DFTC = 262144;
constexpr size_t WS_ROUTE = 5 * MiB;
constexpr size_t   RT_TOPI = 0, RT_TOPG = 262144, RT_DEST = 524288, RT_HIST = 786432, RT_ROWTOK = 851968;
constexpr size_t WS_WSM = 6 * MiB;
constexpr size_t   W_FNET = 0, W_QKV = 2 * MiB, W_AO = 6 * MiB, W_GLU = 8 * MiB, W_SO = 10 * MiB, W_HIN = 12 * MiB, W_HO = 22 * MiB;
constexpr size_t WS_S5M = 30 * MiB;
constexpr size_t WS_S5T = 38 * MiB;
constexpr size_t WS_DFTL = 54 * MiB;
constexpr size_t WS_WGU = 118 * MiB;
constexpr size_t WS_HGIMG = 374 * MiB;
constexpr size_t WS_WDN = 630 * MiB;
constexpr size_t WS_H = 886 * MiB;
constexpr size_t WS_Y = 918 * MiB;
constexpr size_t WS_SCR = 982 * MiB;
constexpr size_t   SC_DNO = 0, SC_BUF = 144 * MiB, SC_ACT = 216 * MiB;
constexpr size_t   SC_C1 = 0, SC_MIX = 64 * MiB;
constexpr size_t   SC_QKV = 0, SC_O = 64 * MiB;
constexpr size_t   SC_AOP = 144 * MiB, SC_SST = 208 * MiB, SC_YBF = 272 * MiB, SC_Z = 0;
constexpr size_t   SC_P = 0, SC_OFB = 160 * MiB, SC_HA = 288 * MiB;
constexpr size_t WS_X16 = 1302 * MiB;
constexpr size_t WS_END = 1334 * MiB;

typedef _Float16 h16x4 __attribute__((ext_vector_type(4)));
typedef _Float16 h16x8 __attribute__((ext_vector_type(8)));
constexpr int RING_BYTES = 131072, LDSCTL_OFF = RING_BYTES, MISC_OFF = LDSCTL_OFF + 320, LDS_BYTES = 147456;

#define RLX_AGENT __ATOMIC_RELAXED, __HIP_MEMORY_SCOPE_AGENT
#define LDS_WAIT() asm volatile("s_waitcnt lgkmcnt(0)" ::: "memory")
#define VM_WAIT() asm volatile("s_waitcnt vmcnt(0)" ::: "memory")
__device__ __forceinline__ unsigned cvt_pk_bf16(float lo, float hi) { unsigned r; asm volatile("v_cvt_pk_bf16_f32 %0, %1, %2" : "=v"(r) : "v"(lo), "v"(hi)); return r; }
__device__ __forceinline__ float bf2f(unsigned short b) { return __uint_as_float(((unsigned)b) << 16); }
__device__ __forceinline__ float bflo(unsigned w) { return __uint_as_float(w << 16); }
__device__ __forceinline__ float bfhi(unsigned w) { return __uint_as_float(w & 0xffff0000u); }
__device__ __forceinline__ unsigned short f2bf(float f) { unsigned u = __float_as_uint(f); return (unsigned short)((u + 0x7fffu + ((u >> 16) & 1u)) >> 16); }
__device__ __forceinline__ float wave_sum(float v) {
    v += __uint_as_float(__builtin_amdgcn_update_dpp(0, __float_as_uint(v), 0xB1, 0xF, 0xF, true));
    v += __uint_as_float(__builtin_amdgcn_update_dpp(0, __float_as_uint(v), 0x4E, 0xF, 0xF, true));
    v += __uint_as_float(__builtin_amdgcn_update_dpp(0, __float_as_uint(v), 0x141, 0xF, 0xF, true));
    v += __uint_as_float(__builtin_amdgcn_update_dpp(0, __float_as_uint(v), 0x140, 0xF, 0xF, true));
    { const auto r = __builtin_amdgcn_permlane16_swap(__float_as_uint(v), __float_as_uint(v), false, false); const float a = __uint_as_float(r[0]), b = __uint_as_float(r[1]); v = a + b; }
    { const auto r = __builtin_amdgcn_permlane32_swap(__float_as_uint(v), __float_as_uint(v), false, false); const float a = __uint_as_float(r[0]), b = __uint_as_float(r[1]); v = a + b; }
    return v;
}
__device__ __forceinline__ float half_wave_sum(float v) {
    v += __uint_as_float(__builtin_amdgcn_update_dpp(0, __float_as_uint(v), 0xB1, 0xF, 0xF, true));
    v += __uint_as_float(__builtin_amdgcn_update_dpp(0, __float_as_uint(v), 0x4E, 0xF, 0xF, true));
    v += __uint_as_float(__builtin_amdgcn_update_dpp(0, __float_as_uint(v), 0x141, 0xF, 0xF, true));
    v += __uint_as_float(__builtin_amdgcn_update_dpp(0, __float_as_uint(v), 0x140, 0xF, 0xF, true));
    { const auto r = __builtin_amdgcn_permlane16_swap(__float_as_uint(v), __float_as_uint(v), false, false); const float a = __uint_as_float(r[0]), b = __uint_as_float(r[1]); v = a + b; }
    return v;
}
__device__ __forceinline__ float frcp(float x) { return __builtin_amdgcn_rcpf(x); }
__device__ __forceinline__ float sigmoidf_(float x) { return frcp(1.f + __builtin_amdgcn_exp2f(x * -1.4426950408889634f)); }
__device__ __forceinline__ float siluf_(float x) { return x * sigmoidf_(x); }
__device__ __forceinline__ int lane_now() { int l; asm volatile("v_mbcnt_lo_u32_b32 %0, -1, 0\n\tv_mbcnt_hi_u32_b32 %0, -1, %0" : "=v"(l)); return l; }
__device__ __forceinline__ int tid_from(int wave) { return wave * 64 + lane_now(); }
#ifndef Q8_MODE
#define Q8_MODE 0
#endif
__device__ __forceinline__ float q8(float x, float s) { const int p = __builtin_amdgcn_cvt_pk_fp8_f32(x * s, x * s, 0, false); return __builtin_amdgcn_cvt_f32_fp8(p, 0) * (1.0f / s); }
constexpr float S8_H = 16.f, S8_WGU = 256.f, S8_ACT = 4.f, S8_WDN = 512.f, S8_Y = 32.f;
__device__ __forceinline__ float sat8(float a) { return __builtin_amdgcn_fmed3f(a, -448.f, 448.f); }
__device__ __forceinline__ unsigned pk4_fp8(float a, float b, float c, float d) { int w = __builtin_amdgcn_cvt_pk_fp8_f32(sat8(a), sat8(b), 0, false); w = __builtin_amdgcn_cvt_pk_fp8_f32(sat8(c), sat8(d), w, true); return (unsigned)w; }
namespace pg8 {
constexpr int BIAS_LDS_OFF = 131072 + 1024;
constexpr int BM = 256, BK = 64, HALF = 128, HTB = HALF * BK * 2, STAGE_BYTES = 8 * HTB, NXCD = 8, WGM = 8;
__host__ __device__ __forceinline__ int lds_byte(int r, int c) { const int st = (r >> 4) * 2 + (c >> 5), rr = r & 15, cc = c & 31, ob = rr * 64 + cc * 2; return st * 1024 + (ob ^ (((ob >> 9) & 1) << 5)); }
__host__ __device__ __forceinline__ void stage_rc(int b, int& R, int& C) { const int st = b / 1024, sb = b % 1024, swz = sb ^ (((sb >> 9) & 1) << 5); R = (st >> 1) * 16 + swz / 64; C = (st & 1) * 32 + (swz % 64) / 2; }
__host__ __device__ __forceinline__ int perm32(int rho) { const int n = rho >> 4, i = rho & 15; return 8 * (i >> 2) + 4 * n + (i & 3); }

struct Unit { int pm, pn, z; size_t aoff, boff, ooff; };
struct Gemm { const char* A; const char* Bt; int lda, ldb, K; int kstepA = 128, kstepB = 128; };

template <class Map> struct Order {
    int nM, nN, per, total, G, c; Map mp;
    __device__ void init(int nM_, int nN_, int nz, int G_, int c_, const Map& m) { nM = nM_; nN = nN_; per = nM * nN; total = per * nz; G = G_; c = c_; mp = m; }
    __device__ bool next(int i, Unit& u) const {
        const long L = (long)i * G + c; if (L >= total) return false;
        int id = (int)L; { const int q = total / NXCD, r = total % NXCD, xcd = id % NXCD, off = id / NXCD; id = (xcd < r ? xcd * (q + 1) : r * (q + 1) + (xcd - r) * q) + off; }
        const int z = id / per, w = id - z * per;
        const int nig = WGM * nN, gid = w / nig, fm = gid * WGM, gsz = (nM - fm) < WGM ? (nM - fm) : WGM;
        u.pm = fm + ((w % nig) % gsz); u.pn = (w % nig) / gsz; u.z = z; mp(u); return true;
    }
};

typedef int v4i_t __attribute__((ext_vector_type(4)));
typedef int v8i_t __attribute__((ext_vector_type(8)));
template <class Epi, class Sched, bool FP8 = false, bool AIND = false>
__device__ __forceinline__ void gemm_phase(LAS unsigned char* lds, const int wave, const Gemm g, const Sched& S, const Epi& E, const LAS unsigned short* tbl = nullptr) {
    const int wid = wave, lane = lane_now(), tid = wid * 64 + lane, wr = wid >> 2, wc = wid & 3, fr = lane & 15, fq = lane >> 4;
    const int K = g.K, nt = K / BK;
    unsigned voffA[2], voffB[2];
#pragma unroll
    for (int i = 0; i < 2; ++i) { int R, C; stage_rc(tid * 16 + i * 8192, R, C); const int Rb = Epi::PERM ? ((R & ~31) + perm32(R & 31)) : R;
        voffA[i] = (unsigned)(R * g.lda + C) * 2u; voffB[i] = (unsigned)(Rb * g.ldb + C) * 2u; }
    const size_t kstepA = (size_t)g.kstepA, kstepB = (size_t)g.kstepB;
    int aR[2], aC[2];
#pragma unroll
    for (int i = 0; i < 2; ++i) stage_rc(tid * 16 + i * 8192, aR[i], aC[i]);
    unsigned voA[2][2], vnA[2][2];
#define PG8_AOFFS(dst, ui_) do { _Pragma("unroll") for (int h_ = 0; h_ < 2; ++h_) _Pragma("unroll") for (int i_ = 0; i_ < 2; ++i_) dst[h_][i_] = (unsigned)tbl[(ui_) * 256 + h_ * 128 + aR[i_]] * 1024u + (unsigned)aC[i_] * 2u; } while (0)
#define PG8_STAGEA(bufoff, ptr, h, nx) do { if constexpr (AIND) { const unsigned vv_[2] = {(nx) ? vnA[h][0] : voA[h][0], (nx) ? vnA[h][1] : voA[h][1]}; PG8_STAGE(bufoff, ptr, vv_); } else PG8_STAGE(bufoff, (ptr) + (h) * hstepA, voffA); } while (0)
    const size_t hstepA = (size_t)HALF * g.lda * 2, hstepB = (size_t)HALF * g.ldb * 2;
    const unsigned ldsw = (unsigned)wid * 1024u;
    const int aoff = lds_byte(wr * 64 + fr, fq * 8), boff = lds_byte(wc * 32 + fr, fq * 8);
#define PG8_SA(b, h) (((b) * 2 + (h)) * HTB)
#define PG8_SB(b, h) ((4 + (b) * 2 + (h)) * HTB)
#define PG8_STAGE(bufoff, gbase, voff) do { _Pragma("unroll") for (int _i = 0; _i < 2; ++_i) \
        __builtin_amdgcn_global_load_lds((const unsigned*)((const char*)(gbase) + (voff)[_i]), (LAS unsigned*)(lds + (bufoff) + ldsw + _i * 8192), 16, 0, 0); } while (0)
#define PG8_LD8(base_) __builtin_shufflevector(*(const LAS v4i_t*)(base_), *(const LAS v4i_t*)((base_) + 1024), 0, 1, 2, 3, 4, 5, 6, 7)
#define PG8_LDA(dst, b, h) do { _Pragma("unroll") for (int m = 0; m < 4; ++m) dst[m] = PG8_LD8(lds + PG8_SA(b, h) + aoff + m * 2048); } while (0)
#define PG8_LDB(dst, b, h) do { _Pragma("unroll") for (int n = 0; n < 2; ++n) dst[n] = PG8_LD8(lds + PG8_SB(b, h) + boff + n * 2048); } while (0)
#define PG8_HALF(v, k) __builtin_bit_cast(bf16x8, (k) ? __builtin_shufflevector(v, v, 4, 5, 6, 7) : __builtin_shufflevector(v, v, 0, 1, 2, 3))
#define PG8_MMA(ai, bj, At, Bt) do { __builtin_amdgcn_s_setprio(1); \
        if constexpr (FP8) { _Pragma("unroll") for (int m = 0; m < 4; ++m) _Pragma("unroll") for (int n = 0; n < 2; ++n) \
            asm volatile("v_mfma_f32_16x16x128_f8f6f4 %0, %1, %2, %0" : "+v"(acc[ai][bj][m][n]) : "v"(Bt[n]), "v"(At[m])); } \
        else { _Pragma("unroll") for (int m = 0; m < 4; ++m) _Pragma("unroll") for (int n = 0; n < 2; ++n) _Pragma("unroll") for (int k = 0; k < 2; ++k) \
            acc[ai][bj][m][n] = __builtin_amdgcn_mfma_f32_16x16x32_bf16(PG8_HALF(Bt[n], k), PG8_HALF(At[m], k), acc[ai][bj][m][n], 0, 0, 0); } \
        __builtin_amdgcn_s_setprio(0); } while (0)
#define PG8_WAIT_V(n) asm volatile("s_waitcnt vmcnt(" #n ")" ::: "memory")
#define PG8_WAIT_L(n) asm volatile("s_waitcnt lgkmcnt(" #n ")" ::: "memory")
#define PG8_BAR __builtin_amdgcn_s_barrier()
#define PG8_SCHED __builtin_amdgcn_sched_barrier(0)
    Unit cur, nxt; int ui = 0;
    if (!S.next(0, cur)) return;
    f32x4 acc[2][2][4][2];
#pragma unroll
    for (int a = 0; a < 2; ++a)
#pragma unroll
        for (int b = 0; b < 2; ++b)
#pragma unroll
            for (int m = 0; m < 4; ++m)
#pragma unroll
                for (int n = 0; n < 2; ++n) acc[a][b][m][n] = (f32x4){0.f, 0.f, 0.f, 0.f};
    v8i_t At[4], B0[2], B1[2];
    const char* cA = g.A + cur.aoff; const char* cB = g.Bt + cur.boff;
    if constexpr (AIND) { PG8_AOFFS(voA, 0); }
    PG8_STAGE(PG8_SB(0, 0), cB, voffB); PG8_STAGE(PG8_SB(0, 1), cB + hstepB, voffB); PG8_STAGEA(PG8_SA(0, 0), cA, 0, false); PG8_STAGEA(PG8_SA(0, 1), cA, 1, false);
    if (wr == 1) PG8_BAR;
    PG8_WAIT_V(2); PG8_BAR;
    PG8_STAGE(PG8_SB(1, 0), cB + kstepB, voffB); PG8_STAGEA(PG8_SA(1, 0), cA + kstepA, 0, false); PG8_STAGE(PG8_SB(1, 1), cB + hstepB + kstepB, voffB);
    PG8_WAIT_V(6); PG8_BAR;
    for (;;) {
        const bool has_next = S.next(ui + 1, nxt);
        const char* nA = has_next ? g.A + nxt.aoff : cA; const char* nB = has_next ? g.Bt + nxt.boff : cB;
        if constexpr (AIND) { if (has_next) { PG8_AOFFS(vnA, ui + 1); } else { _Pragma("unroll") for (int h_ = 0; h_ < 2; ++h_) _Pragma("unroll") for (int i_ = 0; i_ < 2; ++i_) vnA[h_][i_] = voA[h_][i_]; } }
#pragma nounroll
        for (int t = 0; t < nt; t += 2) {
            const bool last = (t == nt - 2);
            const char* a1 = cA + (size_t)(t + 1) * kstepA;
            const char* a2 = last ? nA : cA + (size_t)(t + 2) * kstepA; const char* b2 = last ? nB : cB + (size_t)(t + 2) * kstepB;
            const char* a3 = a2 + kstepA; const char* b3 = b2 + kstepB;
            if constexpr (Epi::BIAS_LDS) { if (last) __builtin_amdgcn_global_load_lds((const unsigned*)E.bias_ptr(cur, lane), (LAS unsigned*)(lds + BIAS_LDS_OFF + wid * 1024), 16, 0, 0); }
            PG8_LDB(B0, 0, 0); PG8_LDB(B1, 0, 1); PG8_SCHED; PG8_LDA(At, 0, 0); PG8_STAGEA(PG8_SA(1, 1), a1, 1, false);
            PG8_WAIT_V(8); PG8_WAIT_L(0); PG8_BAR; PG8_MMA(0, 0, At, B0); PG8_MMA(0, 1, At, B1); PG8_BAR; PG8_SCHED;
            PG8_LDA(At, 0, 1); PG8_STAGE(PG8_SB(0, 0), b2, voffB); PG8_STAGE(PG8_SB(0, 1), b2 + hstepB, voffB); PG8_STAGEA(PG8_SA(0, 0), a2, 0, last);
            PG8_WAIT_V(8); PG8_WAIT_L(0); PG8_BAR; PG8_MMA(1, 0, At, B0); PG8_MMA(1, 1, At, B1); PG8_BAR; PG8_SCHED;
            PG8_LDB(B0, 1, 0); PG8_LDB(B1, 1, 1); PG8_SCHED; PG8_LDA(At, 1, 0); PG8_STAGEA(PG8_SA(0, 1), a2, 1, last);
            PG8_WAIT_V(8); PG8_WAIT_L(0); PG8_BAR; PG8_MMA(0, 0, At, B0); PG8_MMA(0, 1, At, B1); PG8_BAR; PG8_SCHED;
            PG8_LDA(At, 1, 1); PG8_STAGE(PG8_SB(1, 0), b3, voffB); PG8_STAGE(PG8_SB(1, 1), b3 + hstepB, voffB); PG8_STAGEA(PG8_SA(1, 0), a3, 0, last);
            PG8_WAIT_V(8); PG8_WAIT_L(0); PG8_BAR; PG8_MMA(1, 0, At, B0); PG8_MMA(1, 1, At, B1); PG8_BAR; PG8_SCHED;
        }
        if (wr == 0) PG8_BAR;
        if constexpr (FP8) asm volatile("s_nop 15\n\ts_nop 15" ::: "memory");
        { const int t2_ = lane_now(), fr_ = t2_ & 15, fq_ = (t2_ >> 4) & 3; const LAS float* bl_ = (const LAS float*)(lds + BIAS_LDS_OFF + wid * 1024); E(acc, cur, wr, wc, fr_, fq_, bl_);
#if defined(PROBE_KIND)
          if (PROBE_KIND == 12) { asm volatile("" ::: "memory"); E(acc, cur, wr, wc, fr_, fq_, bl_); }
#endif
        }
        if (!has_next) break;
#pragma unroll
        for (int a = 0; a < 2; ++a)
#pragma unroll
            for (int b = 0; b < 2; ++b)
#pragma unroll
                for (int m = 0; m < 4; ++m)
#pragma unroll
                    for (int n = 0; n < 2; ++n) acc[a][b][m][n] = (f32x4){0.f, 0.f, 0.f, 0.f};
        cur = nxt; cA = nA; cB = nB; ++ui;
        if constexpr (AIND) { _Pragma("unroll") for (int h_ = 0; h_ < 2; ++h_) _Pragma("unroll") for (int i_ = 0; i_ < 2; ++i_) voA[h_][i_] = vnA[h_][i_]; }
        if (wr == 1) PG8_BAR;
    }
    PG8_WAIT_V(0);
    PG8_BAR;
#undef PG8_SA
#undef PG8_SB
#undef PG8_STAGE
#undef PG8_STAGEA
#undef PG8_AOFFS
#undef PG8_LDA
#undef PG8_LD8
#undef PG8_HALF
#undef PG8_LDB
#undef PG8_MMA
#undef PG8_WAIT_V
#undef PG8_WAIT_L
#undef PG8_BAR
#undef PG8_SCHED
}

__device__ __forceinline__ u32x4 pack8(const f32x4& v0, const f32x4& v1) { u32x4 w; w.x = cvt_pk_bf16(v0[0], v0[1]); w.y = cvt_pk_bf16(v0[2], v0[3]); w.z = cvt_pk_bf16(v1[0], v1[1]); w.w = cvt_pk_bf16(v1[2], v1[3]); return w; }
}
using pg8::Unit;
typedef f32x4 AccT[2][2][4][2];

template <bool HAS_BIAS> struct EpiBf16T {
    static constexpr bool PERM = true, BIAS_LDS = HAS_BIAS;
    bf16_t* O; int ldc; float scale = 1.f; const float* bias = nullptr;
    __device__ __forceinline__ const float* bias_ptr(const Unit& u, int lane) const { return bias + u.pn * 256 + 4 * lane; }
    __device__ __forceinline__ void operator()(const AccT& acc, const Unit& u, int wr, int wc, int fr, int fq, const LAS float* bl) const {
        bf16_t* base = O + u.ooff + (size_t)(wr * 64 + fr) * ldc + wc * 32 + 8 * fq;
        f32x4 b0[2], b1[2];
#pragma unroll
        for (int bj = 0; bj < 2; ++bj) { b0[bj] = HAS_BIAS ? *(const LAS f32x4*)(bl + bj * 128 + wc * 32 + 8 * fq) : (f32x4){0.f, 0.f, 0.f, 0.f}; b1[bj] = HAS_BIAS ? *(const LAS f32x4*)(bl + bj * 128 + wc * 32 + 8 * fq + 4) : (f32x4){0.f, 0.f, 0.f, 0.f}; }
#pragma unroll
        for (int ai = 0; ai < 2; ++ai)
#pragma unroll
            for (int m = 0; m < 4; ++m) { bf16_t* rowp = base + (size_t)(ai * 128 + m * 16) * ldc;
#pragma unroll
                for (int bj = 0; bj < 2; ++bj) *(u32x4*)(rowp + bj * 128) = pg8::pack8(acc[ai][bj][m][0] * scale + b0[bj], acc[ai][bj][m][1] * scale + b1[bj]); }
    }
};
typedef EpiBf16T<false> EpiBf16;
typedef EpiBf16T<true> EpiBf16B;
template <bool HAS_BIAS> struct EpiF32T {
    static constexpr bool PERM = false, BIAS_LDS = HAS_BIAS;
    float* C; int ldc; const float* bias;
    __device__ __forceinline__ const float* bias_ptr(const Unit& u, int lane) const { return bias + u.pn * 256 + 4 * lane; }
    __device__ __forceinline__ void operator()(const AccT& acc, const Unit& u, int wr, int wc, int fr, int fq, const LAS float* bl) const {
        const int col0 = wc * 32 + 4 * fq;
        f32x4 bv[2][2];
#pragma unroll
        for (int bj = 0; bj < 2; ++bj)
#pragma unroll
            for (int n = 0; n < 2; ++n) bv[bj][n] = HAS_BIAS ? *(const LAS f32x4*)(bl + col0 + bj * 128 + n * 16) : (f32x4){0.f, 0.f, 0.f, 0.f};
        float* base = C + u.ooff + (size_t)(wr * 64 + fr) * ldc + col0;
#pragma unroll
        for (int ai = 0; ai < 2; ++ai)
#pragma unroll
            for (int m = 0; m < 4; ++m) { float* rowp = base + (size_t)(ai * 128 + m * 16) * ldc;
#pragma unroll
                for (int bj = 0; bj < 2; ++bj)
#pragma unroll
                    for (int n = 0; n < 2; ++n) *(f32x4*)(rowp + bj * 128 + n * 16) = acc[ai][bj][m][n] + bv[bj][n]; }
    }
};
typedef EpiF32T<false> EpiF32;
typedef EpiF32T<true> EpiF32B;
__device__ __forceinline__ float gelu_tanh(float x) {
    const float u = 0.7978845608028654f * (x + 0.044715f * x * x * x);
    const float t = 1.f - 2.f * frcp(1.f + __builtin_amdgcn_exp2f(u * 2.8853900817779268f));
    return 0.5f * x * (1.f + t);
}
struct EpiS5Out {
    static constexpr bool PERM = true, BIAS_LDS = false;
    bf16_t* O;
    __device__ __forceinline__ void operator()(const AccT& acc, const Unit& u, int wr, int wc, int fr, int fq, const LAS float* bl) const {
        const int g = u.z, b = u.pm;
#pragma unroll
        for (int ai = 0; ai < 2; ++ai)
#pragma unroll
            for (int m = 0; m < 4; ++m) { const int j = ai * 128 + wr * 64 + m * 16 + fr;
#pragma unroll
                for (int bj = 0; bj < 2; ++bj) { const int col = bj * 128 + wc * 32 + 8 * fq, t = col >> 4, c8 = col & 15;
                    f32x4 v0 = acc[ai][bj][m][0], v1 = acc[ai][bj][m][1];
#pragma unroll
                    for (int i = 0; i < 4; ++i) { v0[i] = gelu_tanh(v0[i]); v1[i] = gelu_tanh(v1[i]); }
                    *(u32x4*)(O + ((size_t)(b * SEQ + j * 16 + t)) * D + g * 16 + c8) = pg8::pack8(v0, v1); } }
    }
};
struct EpiGlu {
    static constexpr bool PERM = true, BIAS_LDS = false;
    const bf16_t* Yb; bf16_t* Z;
    __device__ __forceinline__ void operator()(const AccT& acc, const Unit& u, int wr, int wc, int fr, int fq, const LAS float* bl) const {
        const size_t base = u.ooff + (size_t)(wr * 64 + fr) * D + wc * 32 + 8 * fq;
#pragma unroll
        for (int ai = 0; ai < 2; ++ai)
#pragma unroll
            for (int m = 0; m < 4; ++m) {
#pragma unroll
                for (int bj = 0; bj < 2; ++bj) { const size_t off = base + (size_t)(ai * 128 + m * 16) * D + bj * 128;
                    const u32x4 yw = *(const u32x4*)(Yb + off);
                    f32x4 v0 = acc[ai][bj][m][0], v1 = acc[ai][bj][m][1];
                    v0[0] = bflo(yw.x) * sigmoidf_(v0[0]); v0[1] = bfhi(yw.x) * sigmoidf_(v0[1]); v0[2] = bflo(yw.y) * sigmoidf_(v0[2]); v0[3] = bfhi(yw.y) * sigmoidf_(v0[3]);
                    v1[0] = bflo(yw.z) * sigmoidf_(v1[0]); v1[1] = bfhi(yw.z) * sigmoidf_(v1[1]); v1[2] = bflo(yw.w) * sigmoidf_(v1[2]); v1[3] = bfhi(yw.w) * sigmoidf_(v1[3]);
                    *(u32x4*)(Z + off) = pg8::pack8(v0, v1); } }
    }
};
struct EpiMoeGU {
    static constexpr bool PERM = true, BIAS_LDS = true;
    __device__ __forceinline__ const float* bias_ptr(const Unit& u, int lane) const { return bgu + (size_t)u.z * 2048 + u.pn * 128 + (lane < 32 ? 4 * lane : 1024 + 4 * (lane - 32)); }
    unsigned char* ACT; const float* bgu;
    __device__ __forceinline__ void operator()(const AccT& acc, const Unit& u, int wr, int wc, int fr, int fq, const LAS float* bl) const {
        const int f0 = u.pn * 128 + wc * 32 + 8 * fq;
        const LAS float* bg = bl + wc * 32 + 8 * fq;
        const f32x4 bg0 = *(const LAS f32x4*)bg, bg1 = *(const LAS f32x4*)(bg + 4), bu0 = *(const LAS f32x4*)(bg + 128) + 1.f, bu1 = *(const LAS f32x4*)(bg + 132) + 1.f;
        unsigned char* base = ACT + (size_t)u.pm * 262144 + (size_t)u.pn * 32768 + (wr * 64 + fr) * 128 + wc * 32 + 8 * fq;
        constexpr float SC = 1.0f / (S8_H * S8_WGU), C1 = -1.702f * 1.4426950408889634f, Q = 1.0f / S8_ACT;
#define GU1(G, U) do { const float ga_ = fminf((G), 7.f), up1_ = __builtin_amdgcn_fmed3f((U), -6.f, 8.f), e_ = __builtin_amdgcn_exp2f(ga_ * C1); (G) = (ga_ * up1_) * frcp(__builtin_fmaf(e_, Q, Q)); } while (0)
#pragma unroll
        for (int ai = 0; ai < 2; ++ai)
#pragma unroll
            for (int m = 0; m < 4; ++m) {
                f32x4 g0 = acc[ai][0][m][0] * SC + bg0, g1 = acc[ai][0][m][1] * SC + bg1, u0 = acc[ai][1][m][0] * SC + bu0, u1 = acc[ai][1][m][1] * SC + bu1;
#pragma unroll
                for (int i = 0; i < 4; ++i) { GU1(g0[i], u0[i]); GU1(g1[i], u1[i]); }
                int w0 = __builtin_amdgcn_cvt_pk_fp8_f32(g0[0], g0[1], 0, false); w0 = __builtin_amdgcn_cvt_pk_fp8_f32(g0[2], g0[3], w0, true);
                int w1 = __builtin_amdgcn_cvt_pk_fp8_f32(g1[0], g1[1], 0, false); w1 = __builtin_amdgcn_cvt_pk_fp8_f32(g1[2], g1[3], w1, true);
                *(u32x2*)(base + (ai * 128 + m * 16) * 128) = (u32x2){(unsigned)w0, (unsigned)w1}; }
#undef GU1
    }
};
struct EpiMoeDown {
    static constexpr bool PERM = true, BIAS_LDS = true;
    __device__ __forceinline__ const float* bias_ptr(const Unit& u, int lane) const { return bdn + (size_t)u.z * 1024 + u.pn * 256 + 4 * lane; }
    unsigned char* YB; const float* bdn;
    __device__ __forceinline__ void operator()(const AccT& acc, const Unit& u, int wr, int wc, int fr, int fq, const LAS float* bl) const {
        const int c0 = u.pn * 256 + wc * 32 + 8 * fq;
        const LAS float* bp = bl + wc * 32 + 8 * fq;
        f32x4 b0[2], b1[2];
#pragma unroll
        for (int bj = 0; bj < 2; ++bj) { b0[bj] = *(const LAS f32x4*)(bp + bj * 128) * S8_Y; b1[bj] = *(const LAS f32x4*)(bp + bj * 128 + 4) * S8_Y; }
        unsigned char* base = YB + (size_t)(u.pm * 256 + wr * 64 + fr) * D + c0;
        constexpr float SC = S8_Y / (S8_ACT * S8_WDN);
#pragma unroll
        for (int ai = 0; ai < 2; ++ai)
#pragma unroll
            for (int m = 0; m < 4; ++m) { unsigned char* rowp = base + (size_t)(ai * 128 + m * 16) * D;
#pragma unroll
                for (int bj = 0; bj < 2; ++bj) { const f32x4 v0 = acc[ai][bj][m][0] * SC + b0[bj], v1 = acc[ai][bj][m][1] * SC + b1[bj];
                    *(u32x2*)(rowp + bj * 128) = (u32x2){pk4_fp8(v0[0], v0[1], v0[2], v0[3]), pk4_fp8(v1[0], v1[1], v1[2], v1[3])}; } }
    }
};

struct EpiQKV {
    static constexpr bool PERM = true, BIAS_LDS = false;
    bf16_t* O; float scale; const float* qg; const float* kg; const LAS unsigned* cs2;
    __device__ __forceinline__ void operator()(const AccT& acc, const Unit& u, int wr, int wc, int fr, int fq, const LAS float* bl) const {
        bf16_t* base = O + u.ooff + (size_t)(wr * 64 + fr) * QKVC + wc * 32 + 8 * fq;
#pragma unroll
        for (int ai = 0; ai < 2; ++ai)
#pragma unroll
            for (int m = 0; m < 4; ++m) { bf16_t* rowp = base + (size_t)(ai * 128 + m * 16) * QKVC;
#pragma unroll
                for (int bj = 0; bj < 2; ++bj) *(u32x4*)(rowp + bj * 128) = pg8::pack8(acc[ai][bj][m][0] * scale, acc[ai][bj][m][1] * scale); }
        if (u.pn >= 6) return;
        asm volatile("s_waitcnt vmcnt(0)" ::: "memory");
        __builtin_amdgcn_s_barrier();
        __builtin_amdgcn_fence(__ATOMIC_ACQUIRE, "agent"); asm volatile("s_waitcnt vmcnt(0)" ::: "memory");
        const int lane = lane_now(), w = wr * 4 + wc, hd = lane >> 5, lp = lane & 31, hs = lp >> 4, i2 = (lp & 15) * 2;
        const float* gn = (u.pn < 4) ? qg : kg;
        const float ga0 = gn[hs * 64 + i2], ga1 = gn[hs * 64 + i2 + 1], gb0 = gn[hs * 64 + 32 + i2], gb1 = gn[hs * 64 + 32 + i2 + 1];
        bf16_t* tp = O + u.ooff + (size_t)(32 * w) * QKVC + hd * 128 + hs * 64 + i2;
        const int row0 = u.pm * 256 + 32 * w;
#pragma unroll 1
        for (int rb8 = 0; rb8 < 32; rb8 += 8) { unsigned xa[8], xb[8];
#pragma unroll
            for (int q = 0; q < 8; ++q) { const bf16_t* p = tp + (size_t)(rb8 + q) * QKVC; xa[q] = *(const unsigned*)p; xb[q] = *(const unsigned*)(p + 32); }
#pragma unroll
            for (int q = 0; q < 8; ++q) { const int l = (row0 + rb8 + q) & (SEQ - 1), pos = hs ? (l & 63) : (l >> 6);
                const float a0 = bflo(xa[q]), a1 = bfhi(xa[q]), b0 = bflo(xb[q]), b1 = bfhi(xb[q]);
                const float ss = half_wave_sum((a0 * a0 + a1 * a1) + (b0 * b0 + b1 * b1)), r = __builtin_amdgcn_rsqf(ss * (1.f / 128.f) + RMS_EPS);
                const unsigned c0 = cs2[pos * 32 + i2], c1 = cs2[pos * 32 + i2 + 1];
                const float ya0 = a0 * r * ga0, ya1 = a1 * r * ga1, yb0 = b0 * r * gb0, yb1 = b1 * r * gb1;
                bf16_t* p = tp + (size_t)(rb8 + q) * QKVC;
                *(unsigned*)p = cvt_pk_bf16(ya0 * bflo(c0) - yb0 * bfhi(c0), ya1 * bflo(c1) - yb1 * bfhi(c1));
                *(unsigned*)(p + 32) = cvt_pk_bf16(yb0 * bflo(c0) + ya0 * bfhi(c0), yb1 * bflo(c1) + ya1 * bfhi(c1)); } }
    }
};

struct EpiNull {
    static constexpr bool PERM = true, BIAS_LDS = false;
    __device__ __forceinline__ void operator()(const AccT& acc, const Unit& u, int wr, int wc, int fr, int fq, const LAS float* bl) const {}
};

struct MapPlain {
    int lda, ldb, ldc;
    __device__ __forceinline__ void operator()(Unit& u) const { u.aoff = (size_t)u.pm * 256 * lda * 2; u.boff = (size_t)u.pn * 256 * ldb * 2; u.ooff = (size_t)u.pm * 256 * ldc + u.pn * 256; }
};
struct MapF1 {
    __device__ __forceinline__ void operator()(Unit& u) const { u.aoff = ((size_t)(u.pm >> 3) * 4096 + (u.pm & 7) * 256) * SEQ; u.boff = ((size_t)u.z * D + u.pn * 256) * SEQ;
        u.ooff = (((size_t)u.z * SEQ + (u.pm & 7) * 256) * 4 + u.pn) * 512 + (u.pm >> 3) * 256; }
};
struct MapF2h {
    __device__ __forceinline__ void operator()(Unit& u) const { const int b = u.pm / 33, t = u.pm - b * 33; const size_t row0 = (size_t)b * 16384 + 256 * t; u.aoff = row0 * 512 * 2; u.boff = 0; u.ooff = row0 * 256; u.z = t; }
};
struct EpiF2 {
    static constexpr bool PERM = true, BIAS_LDS = false;
    bf16_t* O;
    __device__ __forceinline__ const float* bias_ptr(const Unit& u, int lane) const { return nullptr; }
    __device__ __forceinline__ void operator()(const AccT& acc, const Unit& u, int wr, int wc, int fr, int fq, const LAS float* bl) const {
        const int c0 = wc * 32 + 8 * fq;
#pragma unroll
        for (int ai = 0; ai < 2; ++ai)
#pragma unroll
            for (int m = 0; m < 4; ++m) { const int r = ai * 128 + wr * 64 + m * 16 + fr, lq = u.z * 64 + (r >> 2);
                if (lq <= 2048) { bf16_t* rowp = O + u.ooff + (size_t)r * 256; bf16_t* mir = rowp + (size_t)(4096 - 2 * lq) * 1024; const bool hasm = lq > 0 && lq < 2048;
#pragma unroll
                    for (int bj = 0; bj < 2; ++bj) { const int cb = bj * 128 + c0; const u32x4 w = pg8::pack8(acc[ai][bj][m][0], acc[ai][bj][m][1]);
                        *(u32x4*)(rowp + cb) = w;
                        if (hasm) { unsigned short* mp = (unsigned short*)mir;
                            mp[(256 - cb) & 255] = (unsigned short)(w.x & 0xffffu);
                            mp[249 - cb] = (unsigned short)(w.w >> 16);
                            *(unsigned*)(mp + 250 - cb) = (w.w & 0xffffu) | (w.z & 0xffff0000u);
                            *(unsigned*)(mp + 252 - cb) = (w.z & 0xffffu) | (w.y & 0xffff0000u);
                            *(unsigned*)(mp + 254 - cb) = (w.y & 0xffffu) | (w.x & 0xffff0000u); } } } }
    }
};
struct MapS5 {
    int ldb;
    __device__ __forceinline__ void operator()(Unit& u) const { u.aoff = ((size_t)u.z * 1024 + u.pm * 256) * 512 * 2; u.boff = (size_t)u.z * 256 * ldb * 2; u.ooff = ((size_t)u.z * 1024 + u.pm * 256) * 256; }
};
struct MapMoe {
    const LAS int* tile_e; size_t wbase; int nrows; int a_tiled = 1; int probe = 0;
    __device__ __forceinline__ void operator()(Unit& u) const { const int e = __builtin_amdgcn_readfirstlane(tile_e[u.pm]); u.z = e; u.aoff = a_tiled ? (size_t)u.pm * 256 * 1024 : 0; u.boff = wbase + ((size_t)e * nrows + u.pn * 256) * 1024; u.ooff = 0;
        if (probe == 1) u.boff = wbase; }
};
constexpr int TILE_LDS_OFF = 131072 + 1024 + 8192;
constexpr int ROWTBL_LDS_OFF = TILE_LDS_OFF + 1280, ROWTBL_MAXU = 10;
static_assert(ROWTBL_LDS_OFF + ROWTBL_MAXU * 512 <= LDS_BYTES, "LDS map");
namespace att {
constexpr int NW = 8, QBLK = 32, KVBLK = 64;
constexpr float SCALE = 0.088388347648318440f;
constexpr float THR = 8.f;
constexpr int LDQ = QKVC, LDK = QKVC, LDO = D;
constexpr size_t SHM_V = KVBLK * DH * 2, SHM_K = KVBLK * DH * 2, SHM_ATTN = 2 * SHM_V + 2 * SHM_K + NW * 64 * 4;
#define KSWZ(row, colB) ((row) * 256 + ((colB) ^ (((row) & 7) << 4)))
#define SBAR() __builtin_amdgcn_sched_barrier(0)
__device__ __forceinline__ int crow(int r, int hi) { return (r & 3) + 8 * (r >> 2) + 4 * hi; }
__device__ __forceinline__ void partialSM(f32x16& p0, f32x16& p1, float& m_reg, float& mn, float& alpha) {
  constexpr float C = SCALE * 1.4426950408889634f;
  float pmax = p0[0]; for (int r = 1; r < 16; ++r) pmax = fmaxf(pmax, p0[r]); for (int r = 0; r < 16; ++r) pmax = fmaxf(pmax, p1[r]);
  { auto rr = __builtin_amdgcn_permlane32_swap(__float_as_uint(pmax), __float_as_uint(pmax), false, false);
    pmax = fmaxf(__uint_as_float(rr[0]), __uint_as_float(rr[1])); }
  if (__builtin_expect(__all(pmax - m_reg <= THR / SCALE), 1)) { mn = m_reg; alpha = 1.f; }
  else { mn = fmaxf(m_reg, pmax); alpha = __builtin_amdgcn_exp2f((m_reg - mn) * C); m_reg = mn; }
  float mnC = -mn * C;
  for (int r = 0; r < 16; ++r) p0[r] = fmaf(p0[r], C, mnC); for (int r = 0; r < 16; ++r) p1[r] = fmaf(p1[r], C, mnC);
  for (int r = 0; r < 16; ++r) p0[r] = __builtin_amdgcn_exp2f(p0[r]);
}
__device__ __forceinline__ void finishSM(f32x16& p0, f32x16& p1, float alpha, float& l_reg, bf16x8& pa0, bf16x8& pa1, bf16x8& pa2, bf16x8& pa3) {
  for (int r = 0; r < 16; ++r) p1[r] = __builtin_amdgcn_exp2f(p1[r]);
  float ps = 0; for (int r = 0; r < 16; ++r) ps += p0[r]; for (int r = 0; r < 16; ++r) ps += p1[r];
  { auto rr = __builtin_amdgcn_permlane32_swap(__float_as_uint(ps), __float_as_uint(ps), false, false);
    ps = __uint_as_float(rr[0]) + __uint_as_float(rr[1]); }
  l_reg = l_reg * alpha + ps;
#define PK4(P, BASE, OUT) do { unsigned a0 = cvt_pk_bf16(P[BASE + 0], P[BASE + 1]), a1 = cvt_pk_bf16(P[BASE + 2], P[BASE + 3]);   \
    unsigned b0 = cvt_pk_bf16(P[BASE + 4], P[BASE + 5]), b1 = cvt_pk_bf16(P[BASE + 6], P[BASE + 7]);                              \
    auto r0 = __builtin_amdgcn_permlane32_swap(a0, b0, false, false); auto r1 = __builtin_amdgcn_permlane32_swap(a1, b1, false, false); \
    u32x4 w = {r0[0], r1[0], r0[1], r1[1]}; OUT = *reinterpret_cast<bf16x8*>(&w); } while (0)
  PK4(p0, 0, pa0); PK4(p0, 8, pa1); PK4(p1, 0, pa2); PK4(p1, 8, pa3);
#undef PK4
}
__device__ __forceinline__ void qkt(f32x16& p0, f32x16& p1, const bf16_t* Ks, const bf16x8* qr, int r32, int hi) {
  p0 = f32x16{}; p1 = f32x16{};
  for (int d0 = 0; d0 < 8; ++d0) { int cb = (d0 * 16 + hi * 8) * 2;
    bf16x8 b0 = *reinterpret_cast<const bf16x8*>((const char*)Ks + KSWZ(r32, cb));
    bf16x8 b1 = *reinterpret_cast<const bf16x8*>((const char*)Ks + KSWZ(32 + r32, cb));
    p0 = __builtin_amdgcn_mfma_f32_32x32x16_bf16(b0, qr[d0], p0, 0, 0, 0);
    p1 = __builtin_amdgcn_mfma_f32_32x32x16_bf16(b1, qr[d0], p1, 0, 0, 0); }
}
__device__ __forceinline__ int v_st(int k, int c) { const int kk = (k & ~0xC) | ((k & 4) << 1) | ((k & 8) >> 1); return ((kk >> 3) * 4 + (c >> 5)) * 512 + ((kk & 7) * 32 + (c & 31)) * 2; }
__device__ __forceinline__ int v_rd_base(int lane) { return ((lane & 3) << 3) | (((lane >> 2) & 3) << 6) | (((lane >> 4) & 1) << 5) | (((lane >> 5) & 1) << 8); }
constexpr int v_rd_off(int d0, int ks, int half) { return d0 * 512 + ks * 4096 + half * 2048; }
template <int OFF> __device__ __forceinline__ s16x4 tr_read(int vb) {
  s16x4 r; asm volatile("ds_read_b64_tr_b16 %0, %1 offset:%2" : "=&v"(r) : "v"(vb), "i"(OFF) : "memory"); return r;
}
template <int D0> __device__ __forceinline__ void pv_one(f32x16& od, int vb, bf16x8 pa0, bf16x8 pa1, bf16x8 pa2, bf16x8 pa3) {
  const s16x4 l0 = tr_read<v_rd_off(D0, 0, 0)>(vb), h0 = tr_read<v_rd_off(D0, 0, 1)>(vb), l1 = tr_read<v_rd_off(D0, 1, 0)>(vb), h1 = tr_read<v_rd_off(D0, 1, 1)>(vb);
  const s16x4 l2 = tr_read<v_rd_off(D0, 2, 0)>(vb), h2 = tr_read<v_rd_off(D0, 2, 1)>(vb), l3 = tr_read<v_rd_off(D0, 3, 0)>(vb), h3 = tr_read<v_rd_off(D0, 3, 1)>(vb);
  asm volatile("s_waitcnt lgkmcnt(0)" ::: "memory"); SBAR();
#define PK(L, H) (bf16x8){L[0], L[1], L[2], L[3], H[0], H[1], H[2], H[3]}
  od = __builtin_amdgcn_mfma_f32_32x32x16_bf16(pa0, PK(l0, h0), od, 0, 0, 0);
  od = __builtin_amdgcn_mfma_f32_32x32x16_bf16(pa1, PK(l1, h1), od, 0, 0, 0);
  od = __builtin_amdgcn_mfma_f32_32x32x16_bf16(pa2, PK(l2, h2), od, 0, 0, 0);
  od = __builtin_amdgcn_mfma_f32_32x32x16_bf16(pa3, PK(l3, h3), od, 0, 0, 0);
#undef PK
}
__device__ __forceinline__ void pv_d0(f32x16* o, int vb, bf16x8 pa0, bf16x8 pa1, bf16x8 pa2, bf16x8 pa3) {
  pv_one<0>(o[0], vb, pa0, pa1, pa2, pa3); pv_one<1>(o[1], vb, pa0, pa1, pa2, pa3); pv_one<2>(o[2], vb, pa0, pa1, pa2, pa3); pv_one<3>(o[3], vb, pa0, pa1, pa2, pa3);
}
__device__ __forceinline__ void attn_dense_body(const bf16_t* __restrict__ Qb, const bf16_t* __restrict__ Kh, const bf16_t* __restrict__ Vh,
                                                bf16_t* __restrict__ Ob, int seq, char* lds, const int wave) {
  const int wid = wave, lane = lane_now(), tid = wid * 64 + lane, r32 = lane & 31, hi = lane >> 5;
  bf16_t* V_lds = (bf16_t*)lds; bf16_t* K_lds = (bf16_t*)(lds + 2 * SHM_V);
  float* ws = (float*)(lds + 2 * SHM_V + 2 * SHM_K) + wid * 64; float* li_l = ws; float* al_l = ws + 32;
  float m_reg = -1e30f, l_reg = 0; f32x16 o[4] = {}; bf16x8 qr[8];
  const bf16_t* Qw = Qb + (long)(wid * QBLK + r32) * LDQ + hi * 8;
#pragma unroll
  for (int d0 = 0; d0 < 8; ++d0) qr[d0] = *reinterpret_cast<const bf16x8*>(Qw + d0 * 16);
  const int sr = tid >> 4, sc = (tid & 15) * 8, vst0 = v_st(sr, sc), vst1 = v_st(32 + sr, sc);
  const int vb0 = (int)(uintptr_t)V_lds + v_rd_base(lane);
  const unsigned goff = (unsigned)(sr * LDK + sc) * 2u;
  struct { bf16x8 vs0, vs1, ks0, ks1; } sr_[2];
#define SLOAD(i, k0) do { const char* kb_ = (const char*)Kh + (size_t)(k0) * (LDK * 2); \
    sr_[i].ks0 = *reinterpret_cast<const bf16x8*>(kb_ + goff); sr_[i].ks1 = *reinterpret_cast<const bf16x8*>(kb_ + goff + 32 * LDK * 2); \
    sr_[i].vs0 = *reinterpret_cast<const bf16x8*>(kb_ + goff + 1024); sr_[i].vs1 = *reinterpret_cast<const bf16x8*>(kb_ + goff + 32 * LDK * 2 + 1024); } while (0)
#define SWRITE(b, i) do { *(bf16x8*)((char*)V_lds + (b) * SHM_V + vst0) = sr_[i].vs0;          \
    *(bf16x8*)((char*)V_lds + (b) * SHM_V + vst1) = sr_[i].vs1; int kc = sc * 2;               \
    *(bf16x8*)((char*)K_lds + (b) * SHM_K + KSWZ(sr, kc)) = sr_[i].ks0;                       \
    *(bf16x8*)((char*)K_lds + (b) * SHM_K + KSWZ(32 + sr, kc)) = sr_[i].ks1; } while (0)
#define SWAIT() asm volatile("s_waitcnt vmcnt(4)" ::: "memory")
#define RESC(a) do { if (__any((a) < 1.f)) { if (hi == 0) al_l[r32] = (a); asm volatile("s_waitcnt lgkmcnt(0)" ::: "memory"); \
    for (int d = 0; d < 4; ++d) for (int r = 0; r < 16; ++r) o[d][r] *= al_l[crow(r, hi)]; } } while (0)
  f32x16 pA0, pA1, pB0, pB1; float mnA, mnB, alA, alB; bf16x8 pa0, pa1, pa2, pa3; const int NT = seq / KVBLK;
  constexpr int SE = 0, SO = 1;
  SLOAD(SE, 0); asm volatile("s_waitcnt vmcnt(0)" ::: "memory"); SWRITE(0, SE); __syncthreads();
  qkt(pA0, pA1, K_lds, qr, r32, hi); partialSM(pA0, pA1, m_reg, mnA, alA);
  SLOAD(SO, KVBLK); if (2 < NT) SLOAD(SE, 2 * KVBLK);
  SWAIT(); SWRITE(1, SO); __syncthreads();
  for (int j = 1; j + 1 < NT; j += 2) {
    SBAR(); qkt(pB0, pB1, (bf16_t*)((char*)K_lds + SHM_K), qr, r32, hi);
    finishSM(pA0, pA1, alA, l_reg, pa0, pa1, pa2, pa3); SBAR();
    SLOAD(SO, (j + 2) * KVBLK); SBAR();
    pv_d0(o, vb0, pa0, pa1, pa2, pa3); partialSM(pB0, pB1, m_reg, mnB, alB);
    __syncthreads(); SWAIT(); SWRITE(0, SE);
    RESC(alB); __syncthreads();
    SBAR(); qkt(pA0, pA1, K_lds, qr, r32, hi);
    finishSM(pB0, pB1, alB, l_reg, pa0, pa1, pa2, pa3); SBAR();
    if (j + 3 < NT) SLOAD(SE, (j + 3) * KVBLK); SBAR();
    pv_d0(o, vb0 + (int)SHM_V, pa0, pa1, pa2, pa3); partialSM(pA0, pA1, m_reg, mnA, alA);
    __syncthreads(); SWAIT(); SWRITE(1, SO);
    RESC(alA); __syncthreads();
  }
  SBAR(); qkt(pB0, pB1, (bf16_t*)((char*)K_lds + SHM_K), qr, r32, hi);
  finishSM(pA0, pA1, alA, l_reg, pa0, pa1, pa2, pa3); SBAR();
  pv_d0(o, vb0, pa0, pa1, pa2, pa3); partialSM(pB0, pB1, m_reg, mnB, alB);
  __syncthreads(); RESC(alB);
  finishSM(pB0, pB1, alB, l_reg, pa0, pa1, pa2, pa3); SBAR();
  pv_d0(o, vb0 + (int)SHM_V, pa0, pa1, pa2, pa3);
  if (hi == 0) li_l[r32] = l_reg; asm volatile("s_waitcnt lgkmcnt(0)" ::: "memory");
  float rli[16];
#pragma unroll
  for (int r = 0; r < 16; ++r) rli[r] = __builtin_amdgcn_rcpf(li_l[crow(r, hi)]);
  bf16_t* Ow = Ob + (long)(wid * QBLK) * LDO;
#pragma unroll
  for (int r = 0; r < 16; ++r) { int orow = crow(r, hi);
    for (int d0 = 0; d0 < 4; ++d0) Ow[(long)orow * LDO + d0 * 32 + r32] = f2bf(o[d0][r] * rli[r]); }
  __syncthreads();
#undef SLOAD
#undef SWRITE
#undef SWAIT
#undef RESC
}
#undef KSWZ
#undef SBAR
}
#define XB_TMO      128
#define XB_XCNT(j)  (256  + 64 * (j))
#define XB_XSUB(j)  (1280 + 64 * (j))
#define XB_XGEN(j)  (2304 + 64 * (j))
#define XB_TOP      3328
#define XB_TOPGEN   3392
#define XCD_BAR_WORDS 3456
#define XB_SPIN_CAP (1u << 20)
__device__ __forceinline__ unsigned xb_ld(unsigned* p)              { return __hip_atomic_load(p, __ATOMIC_RELAXED, __HIP_MEMORY_SCOPE_AGENT); }
__device__ __forceinline__ unsigned xb_add(unsigned* p, unsigned v) { return __hip_atomic_fetch_add(p, v, __ATOMIC_RELAXED, __HIP_MEMORY_SCOPE_AGENT); }
__device__ __forceinline__ unsigned xb_xcc_id() { return (unsigned)__builtin_amdgcn_s_getreg((3 << 11) | 20) & 0xFu; }
#define XB_SPIN(cond, bar) do { unsigned _sp = 0; while (cond) { __builtin_amdgcn_s_sleep(1); \
    if ((++_sp & 255u) == 0u) { if (xb_ld(&(bar)[XB_TMO])) break; if (_sp > XB_SPIN_CAP) { atomicAdd(&(bar)[XB_TMO], 1u); break; } } } } while (0)
struct XcdBarrier { unsigned* bar; unsigned x; volatile LAS unsigned* st; int wave; };
__device__ __forceinline__ XcdBarrier xcd_barrier_post(unsigned* bar, volatile LAS unsigned* st, int wave) {
    XcdBarrier b; b.bar = bar; b.x = xb_xcc_id(); b.st = st; b.wave = wave;
    if (tid_from(wave) == 0) (void)xb_add(&bar[XB_XCNT(b.x)], 1u);
    return b;
}
__device__ __forceinline__ void xcd_barrier_complete(unsigned* bar, unsigned x, unsigned& nloc, unsigned& nx) {
    const unsigned G = gridDim.x * gridDim.y * gridDim.z;
    unsigned sum, cnt, mine, sp = 0u;
    for (;;) {
        sum = 0u; cnt = 0u; mine = 0u;
#pragma unroll
        for (unsigned j = 0; j < 16; ++j) { const unsigned c = xb_ld(&bar[XB_XCNT(j)]); sum += c; cnt += (c > 0u) ? 1u : 0u; mine = (j == x) ? c : mine; }
        if (sum == G) break;
        __builtin_amdgcn_s_sleep(1);
        if ((++sp & 255u) == 0u) { if (xb_ld(&bar[XB_TMO])) break; if (sp > XB_SPIN_CAP) { atomicAdd(&bar[XB_TMO], 1u); break; } }
    }
    nloc = mine > 0u ? mine : 1u; nx = cnt > 0u ? cnt : 1u;
}
__device__ __forceinline__ void xcd_barrier(const XcdBarrier& b) {
    asm volatile("s_waitcnt vmcnt(0)" ::: "memory");
    __syncthreads();
    if (tid_from(b.wave) == 0) {
        unsigned* bar = b.bar;
        __builtin_amdgcn_s_waitcnt(0);
        unsigned nloc = b.st[0], nx = b.st[1];
        if (nloc == 0u) { xcd_barrier_complete(bar, b.x, nloc, nx); b.st[0] = nloc; b.st[1] = nx; }
        const unsigned old = xb_add(&bar[XB_XSUB(b.x)], 1u);
        const unsigned gen = old / nloc;
        if (old + 1u == (gen + 1u) * nloc) {
            __builtin_amdgcn_fence(__ATOMIC_RELEASE, "agent");
            asm volatile("s_waitcnt vmcnt(0)" ::: "memory");
            const unsigned og = xb_add(&bar[XB_TOP], 1u);
            const unsigned tg = og / nx;
            if (og + 1u == (tg + 1u) * nx) xb_add(&bar[XB_TOPGEN], 1u);
            else XB_SPIN(xb_ld(&bar[XB_TOPGEN]) == tg, bar);
            __builtin_amdgcn_fence(__ATOMIC_ACQUIRE, "agent");
            xb_add(&bar[XB_XGEN(b.x)], 1u);
            asm volatile("s_waitcnt vmcnt(0)" ::: "memory");
        } else {
            XB_SPIN(xb_ld(&bar[XB_XGEN(b.x)]) == gen, bar);
            __builtin_amdgcn_fence(__ATOMIC_ACQUIRE, "agent");
            asm volatile("s_waitcnt vmcnt(0)" ::: "memory");
        }
    }
    __syncthreads();
}

struct Frame {
    LAS unsigned char* lds; char* ldsg;
    int tid, lane, wave, vcu, G;
    const float* const* in; float* out; unsigned char* ws;
};
struct Args { const float* in[32]; float* out; unsigned char* ws; int ph_lo, ph_hi; };
__device__ __forceinline__ void transpose_item64(const float* __restrict__ W, int K, int N, bf16_t* __restrict__ WT, int drow0, LAS float* scr, int k0, int n0, int lane, float qs = 0.f) {
    const int kr = lane >> 4, n4 = (lane & 15) * 4;
#pragma unroll 4
    for (int i = 0; i < 16; ++i) { const int kk = 4 * i + kr; const f32x4 v = *(const f32x4*)(W + (size_t)(k0 + kk) * N + n0 + n4);
        LAS float* s = scr + kk * 64;
        s[(n4 + 0) ^ kk] = v[0]; s[(n4 + 1) ^ kk] = v[1]; s[(n4 + 2) ^ kk] = v[2]; s[(n4 + 3) ^ kk] = v[3]; }
    LDS_WAIT(); asm volatile("" ::: "memory");
    const int c = lane & 7;
#pragma unroll
    for (int j = 0; j < 8; ++j) { const int n = (lane >> 3) + 8 * j; float v[8];
#pragma unroll
        for (int q = 0; q < 8; ++q) { const int kk = 8 * c + q; v[q] = scr[kk * 64 + (n ^ kk)]; if (qs != 0.f) v[q] = q8(v[q], qs); }
        u32x4 o; o.x = cvt_pk_bf16(v[0], v[1]); o.y = cvt_pk_bf16(v[2], v[3]); o.z = cvt_pk_bf16(v[4], v[5]); o.w = cvt_pk_bf16(v[6], v[7]);
        *(u32x4*)(WT + (size_t)(drow0 + n) * K + k0 + 8 * c) = o; }
    LDS_WAIT(); asm volatile("" ::: "memory");
}
__device__ __forceinline__ void transpose_matrix_items(const float* W, int K, int N, bf16_t* WT, int gu, LAS float* scr, int item, int lane, float qs = 0.f) {
    const int nblk = N / 64, kb = item / nblk, nb = item % nblk, k0 = 64 * kb, n0 = 64 * nb;
    int drow0 = n0;
    if (gu) { const int f0 = n0 & 1023; drow0 = (f0 >> 7) * 256 + ((n0 >= 1024) ? 128 : 0) + (f0 & 127); }
    transpose_item64(W, K, N, WT, drow0, scr, k0, n0, lane, qs);
}

__device__ __forceinline__ void transpose_item_f8(const float* __restrict__ W, int K, int N, unsigned char* __restrict__ WT8, int drow0, LAS float* scr, int k0, int n0, int lane, float sc, bool readonly = false) {
    const int kr = lane >> 3, n4 = (lane & 7) * 4;
    if (readonly) { f32x4 a = {0.f, 0.f, 0.f, 0.f};
        const int item = (k0 >> 7) * (N / 32) + (n0 >> 5), nb256 = N / 256, kq = item / nb256, nq = item % nb256;
#pragma unroll
        for (int i = 0; i < 16; ++i) a += *(const f32x4*)(W + (size_t)(16 * kq + i) * N + 256 * nq + 4 * lane);
        asm volatile("" :: "v"(a)); return; }
#define TSWZ(kk) (((kk) & 7) | ((((kk) >> 4) & 3) << 3))
#pragma unroll
    for (int h = 0; h < 2; ++h) { f32x4 v[8];
#pragma unroll
        for (int i = 0; i < 8; ++i) v[i] = __builtin_nontemporal_load((const f32x4*)(W + (size_t)(k0 + 64 * h + 8 * i + kr) * N + n0 + n4));
#pragma unroll
        for (int i = 0; i < 8; ++i) { const int kk = 64 * h + 8 * i + kr; LAS float* s = scr + kk * 32; const int x = TSWZ(kk);
            s[(n4 + 0) ^ x] = v[i][0]; s[(n4 + 1) ^ x] = v[i][1]; s[(n4 + 2) ^ x] = v[i][2]; s[(n4 + 3) ^ x] = v[i][3]; } }
    LDS_WAIT(); asm volatile("" ::: "memory");
    const int c = lane & 7;
#pragma unroll 1
    for (int j = 0; j < 4; ++j) { const int n = (lane >> 3) + 8 * j; float u[16];
#pragma unroll
        for (int q = 0; q < 16; ++q) { const int kk = 16 * c + q; u[q] = scr[kk * 32 + (n ^ TSWZ(kk))] * sc; }
        u32x4 o; o.x = pk4_fp8(u[0], u[1], u[2], u[3]); o.y = pk4_fp8(u[4], u[5], u[6], u[7]); o.z = pk4_fp8(u[8], u[9], u[10], u[11]); o.w = pk4_fp8(u[12], u[13], u[14], u[15]);
        const int r = drow0 + n;
        *(u32x4*)(WT8 + (size_t)(r >> 8) * 256 * K + (size_t)(k0 >> 7) * 32768 + (r & 255) * 128 + 16 * c) = o; }
    LDS_WAIT(); asm volatile("" ::: "memory");
#undef TSWZ
}
__device__ __forceinline__ void transpose_matrix_items_f8(const float* W, int K, int N, unsigned char* WT8, int gu, LAS float* scr, int item, int lane, float sc, bool readonly = false) {
    const int nblk = N / 32, kb = item / nblk, nb = item % nblk, k0 = 128 * kb, n0 = 32 * nb;
    int drow0 = n0;
    if (gu) { const int f0 = n0 & 1023; drow0 = (f0 >> 7) * 256 + ((n0 >= 1024) ? 128 : 0) + (f0 & 127); }
    transpose_item_f8(W, K, N, WT8, drow0, scr, k0, n0, lane, sc, readonly);
}

__device__ __forceinline__ void p0_prologue(Frame& F) {
    const int gw = F.vcu * NWAVES + F.wave, NGW = F.G * NWAVES;
    const int gt = F.vcu * NTHR + F.tid, NGT = F.G * NTHR;
    {
        LAS float* cond = (LAS float*)F.lds;
        LAS float* part = cond + NB * D;
        for (int i = F.tid; i < NB * D; i += NTHR) { const float c = F.in[1][i]; cond[i] = c * sigmoidf_(c); }
        __syncthreads();
        float* modf = (float*)(F.ws + WS_MODP);
        const float* aw = F.in[2]; const float* ab = F.in[3];
        for (int it = F.vcu; it < DEPTH * 64; it += F.G) {
            const int layer = it >> 6, cb = it & 63, n = cb * 96 + F.lane * 2;
            float a0[4] = {0.f, 0.f, 0.f, 0.f}, a1[4] = {0.f, 0.f, 0.f, 0.f};
            if (F.lane < 48) { const float* wp = aw + ((size_t)layer * D + F.wave * 128) * (6 * D) + n;
#pragma unroll 32
                for (int k = 0; k < 128; ++k) { const f32x2 w = *(const f32x2*)(wp + (size_t)k * (6 * D));
#pragma unroll
                    for (int b = 0; b < 4; ++b) { const float cv = cond[b * D + F.wave * 128 + k]; a0[b] += cv * w.x; a1[b] += cv * w.y; } }
#pragma unroll
                for (int b = 0; b < 4; ++b) *(LAS f32x2*)(part + (F.wave * 4 + b) * 96 + F.lane * 2) = (f32x2){a0[b], a1[b]}; }
            __syncthreads();
            if (F.tid < 4 * 96) { const int b = F.tid / 96, c = F.tid % 96; float sum = ab[(size_t)layer * 6 * D + cb * 96 + c];
#pragma unroll
                for (int w = 0; w < 8; ++w) sum += part[(w * 4 + b) * 96 + c];
                modf[((size_t)layer * NB + b) * (6 * D) + cb * 96 + c] = sum; }
            __syncthreads();
        }
    }
    {
        LAS float* ct = (LAS float*)F.lds;
        for (int m = F.tid; m < 4096; m += NTHR) ct[m] = cospif((float)m * (1.0f / 2048.0f));
        __syncthreads();
        unsigned char* dl = F.ws + WS_DFTL;
        for (int it = gt; it < 8192 * 256; it += NGT) {
            const int row = it >> 8, l0 = (it & 255) * 16, part = row >> 12, lp = row & 4095;
            if (lp >= 2048) continue;
            float v[16];
#pragma unroll
            for (int q = 0; q < 16; ++q) { int m = (lp * (l0 + q)) & 4095; if (part) m = (m - 1024) & 4095; v[q] = ct[m] * 256.0f; }
            *(u32x4*)(dl + (size_t)row * 4096 + l0) = (u32x4){pk4_fp8(v[0], v[1], v[2], v[3]), pk4_fp8(v[4], v[5], v[6], v[7]), pk4_fp8(v[8], v[9], v[10], v[11]), pk4_fp8(v[12], v[13], v[14], v[15])};
        }
        bf16_t* dc = (bf16_t*)(F.ws + WS_SMALL + SM_DFTC);
        for (int it = gt; it < 256 * 512; it += NGT) {
            const int k = it >> 9, col = it & 511, part = col >> 8, c = col & 255;
            int m = (16 * c * k) & 4095; float v;
            if (part) { m = (m - 1024) & 4095; v = -ct[m]; } else v = ct[m];
            dc[it] = f2bf(v * (1.0f / 16.0f));
        }
        float* lbo = (float*)(F.ws + WS_SMALL + SM_LB);
        for (int n = gt; n < D; n += NGT) { const float* hl = F.in[23];
            const float x0 = hl[n], x1 = hl[D + n], x2 = hl[2 * D + n], x3 = hl[3 * D + n], mx = fmaxf(fmaxf(x0, x1), fmaxf(x2, x3));
            const float e0 = __expf(x0 - mx), e1 = __expf(x1 - mx), e2 = __expf(x2 - mx), e3 = __expf(x3 - mx);
            lbo[n] = (e1 + e2 + e3) / (e0 + e1 + e2 + e3); }
        __syncthreads();
    }
    for (int gu_ = F.vcu; gu_ < S5G * 4; gu_ += F.G) {
        const int g = gu_ >> 2, part = gu_ & 3;
        LAS f32x2* apow = (LAS f32x2*)F.lds;
        LAS f32x2* bbar = apow + 2 * 17 * 64;
        LAS f32x2* cm = bbar + 2 * 64 * 16;
        LAS f32x2* coef = cm + 2 * 16 * 64;
        LAS float* Kt = (LAS float*)(coef + 128);
        const float *a_re = F.in[12], *a_im = F.in[13], *ldt = F.in[14], *b_re = F.in[15], *b_im = F.in[16], *c_re = F.in[17], *c_im = F.in[18], *dv = F.in[19];
        if (F.tid < 128) { const int dir = F.tid >> 6, p = F.tid & 63;
            const float lr = a_re[(dir * S5G + g) * S5P + p], li = a_im[(dir * S5G + g) * S5P + p], dt = expf(ldt[dir * S5G + g]);
            const float er = lr * dt, th = li * dt;
            for (int m = 0; m <= 16; ++m) { const float mag = expf(er * (float)m); float s, c; sincosf(th * (float)m, &s, &c); apow[(dir * 17 + m) * 64 + p] = (f32x2){mag * c, mag * s}; }
            const f32x2 a1 = apow[(dir * 17 + 1) * 64 + p]; const float nr = a1.x - 1.f, ni = a1.y, den = lr * lr + li * li;
            coef[dir * 64 + p] = (f32x2){(nr * lr + ni * li) / den, (ni * lr - nr * li) / den};
            ((f32x2*)(F.ws + WS_SMALL + SM_AT))[(dir * S5G + g) * S5P + p] = apow[(dir * 17 + 16) * 64 + p];
        }
        __syncthreads();
        for (int i = F.tid; i < 2048; i += NTHR) { const int dir = i >> 10, p = (i >> 4) & 63, c = i & 15;
            const size_t bi = (((size_t)dir * S5G + g) * S5P + p) * S5C + c; const f32x2 cf = coef[dir * 64 + p]; const float br = b_re[bi], bim = b_im[bi];
            bbar[i] = (f32x2){cf.x * br - cf.y * bim, cf.x * bim + cf.y * br};
            const int c2 = (i >> 6) & 15, p2 = i & 63; const size_t ci = (((size_t)dir * S5G + g) * S5C + c2) * S5P + p2;
            cm[i] = (f32x2){c_re[ci], c_im[ci]}; }
        __syncthreads();
        {
            const int dir = F.tid >> 8, tau = (F.tid >> 4) & 15, co = F.tid & 15; float acc[16];
#pragma unroll
            for (int ci = 0; ci < 16; ++ci) acc[ci] = 0.f;
            for (int p = 0; p < 64; ++p) { const f32x2 cc = cm[(dir * 16 + co) * 64 + p], aa = apow[(dir * 17 + tau) * 64 + p];
                const float zr = cc.x * aa.x - cc.y * aa.y, zi = cc.x * aa.y + cc.y * aa.x;
#pragma unroll
                for (int ci = 0; ci < 16; ++ci) { const f32x2 bb = bbar[(dir * 64 + p) * 16 + ci]; acc[ci] += zr * bb.x - zi * bb.y; } }
#pragma unroll
            for (int ci = 0; ci < 16; ++ci) Kt[((dir * 16 + tau) * 16 + co) * 16 + ci] = acc[ci];
        }
        __syncthreads();
        bf16_t* mst = (bf16_t*)(F.ws + WS_S5M) + (size_t)g * 256 * 256;
        for (int it = part * 64 * 32 + F.tid; it < (part + 1) * 64 * 32; it += NTHR) {
            const int n = it >> 5, k0 = (it & 31) * 8, dir = n >> 7, ri = (n >> 6) & 1, p = n & 63, t = k0 >> 4, c0 = k0 & 15;
            const f32x2 aa = apow[(dir * 17 + (dir ? t : 15 - t)) * 64 + p]; float v[8];
#pragma unroll
            for (int q = 0; q < 8; ++q) { const f32x2 bb = bbar[(dir * 64 + p) * 16 + c0 + q]; v[q] = ri ? (aa.x * bb.y + aa.y * bb.x) : (aa.x * bb.x - aa.y * bb.y); }
            u32x4 o; o.x = cvt_pk_bf16(v[0], v[1]); o.y = cvt_pk_bf16(v[2], v[3]); o.z = cvt_pk_bf16(v[4], v[5]); o.w = cvt_pk_bf16(v[6], v[7]);
            *(u32x4*)(mst + (size_t)n * 256 + k0) = o;
        }
        bf16_t* tout = (bf16_t*)(F.ws + WS_S5T) + (size_t)g * 256 * 512;
        for (int it = part * 64 * 64 + F.tid; it < (part + 1) * 64 * 64; it += NTHR) {
            const int n = it >> 6, k0 = (it & 63) * 8, t = n >> 4, co = n & 15; float v[8];
            if (k0 < 256) { const int s = k0 >> 4, ci0 = k0 & 15, dl_ = t - s;
#pragma unroll
                for (int q = 0; q < 8; ++q) { const int ci = ci0 + q; float x;
                    if (dl_ > 0) x = Kt[((0 * 16 + dl_) * 16 + co) * 16 + ci];
                    else if (dl_ < 0) x = Kt[((1 * 16 - dl_) * 16 + co) * 16 + ci];
                    else x = Kt[((0 * 16 + 0) * 16 + co) * 16 + ci] + Kt[((1 * 16 + 0) * 16 + co) * 16 + ci] + (co == ci ? dv[g * 16 + co] : 0.f);
                    v[q] = x; }
            } else { const int np = k0 - 256, dir = np >> 7, ri = (np >> 6) & 1, p0 = np & 63, m = dir ? 16 - t : t + 1;
#pragma unroll
                for (int q = 0; q < 8; ++q) { const f32x2 cc = cm[(dir * 16 + co) * 64 + p0 + q], aa = apow[(dir * 17 + m) * 64 + p0 + q];
                    v[q] = ri ? -(cc.x * aa.y + cc.y * aa.x) : (cc.x * aa.x - cc.y * aa.y); } }
            u32x4 o; o.x = cvt_pk_bf16(v[0], v[1]); o.y = cvt_pk_bf16(v[2], v[3]); o.z = cvt_pk_bf16(v[4], v[5]); o.w = cvt_pk_bf16(v[6], v[7]);
            *(u32x4*)(tout + (size_t)n * 512 + k0) = o;
        }
        __syncthreads();
    }
    {
        LAS float* scr = (LAS float*)(F.lds + F.wave * 16384);
        bf16_t* wsm = (bf16_t*)(F.ws + WS_WSM);
        constexpr int I_SQ = 16 * 16, I_QKV = 16 * 32, I_HIN = 16 * 80, I_GU = 16 * 32, I_DN = 16 * 16;
        constexpr int O1 = I_SQ, O2 = O1 + I_QKV, O3 = O2 + I_SQ, O4 = O3 + I_SQ, O5 = O4 + I_SQ, O6 = O5 + I_HIN, O7 = O6 + I_SQ;
        constexpr int NSMALL = O7, NGU = DEPTH * NE * I_GU, NDN = DEPTH * NE * I_DN, NITEMS = NSMALL + NGU + NDN;
#ifndef PROBE_KIND
#define PROBE_KIND 0
#endif
        for (int it = gw; it < NSMALL; it += NGW) {
            int r = it;
            {
                if (r < O1) { transpose_matrix_items(F.in[6], D, D, wsm + W_FNET / 2, 0, scr, r, F.lane); continue; }
                if (r < O2) { transpose_matrix_items_f8(F.in[8], D, QKVC, F.ws + WS_WSM + W_QKV, 0, scr, r - O1, F.lane, S8_WGU); continue; }
                if (r < O3) { transpose_matrix_items(F.in[11], D, D, wsm + W_AO / 2, 0, scr, r - O2, F.lane); continue; }
                if (r < O4) { transpose_matrix_items(F.in[20], D, D, wsm + W_GLU / 2, 0, scr, r - O3, F.lane); continue; }
                if (r < O5) { transpose_matrix_items(F.in[21], D, D, wsm + W_SO / 2, 0, scr, r - O4, F.lane); continue; }
                if (r < O6) { transpose_matrix_items_f8(F.in[22], D, 5 * D, F.ws + WS_WSM + W_HIN, 0, scr, r - O5, F.lane, S8_WGU); continue; }
                transpose_matrix_items(F.in[25], D, D, wsm + W_HO / 2, 0, scr, r - O6, F.lane); continue;
            }
        }
        {
            struct TItem { const float* W; unsigned char* WT8; int N, k0, n0, drow0; float sc; };
            auto moe_item = [&](int r) { TItem t; int it, gu;
                if (r < NGU) { const int mi = r / I_GU; it = r % I_GU; t.N = 2 * DEX; t.W = F.in[28] + (size_t)mi * D * 2 * DEX; t.WT8 = F.ws + WS_WGU + (size_t)mi * 2 * DEX * D; gu = 1; t.sc = S8_WGU; }
                else { const int r2 = r - NGU, mi = r2 / I_DN; it = r2 % I_DN; t.N = D; t.W = F.in[30] + (size_t)mi * DEX * D; t.WT8 = F.ws + WS_WDN + (size_t)mi * D * DEX; gu = 0; t.sc = S8_WDN; }
                const int nblk = t.N / 32, kb = it / nblk, nb = it % nblk; t.k0 = 128 * kb; t.n0 = 32 * nb; t.drow0 = t.n0;
                if (gu) { const int f0 = t.n0 & 1023; t.drow0 = (f0 >> 7) * 256 + ((t.n0 >= 1024) ? 128 : 0) + (f0 & 127); }
                return t; };
            const int lane = F.lane, kr = lane >> 3, n4 = (lane & 7) * 4, c = lane & 7;
#define TSWZ(kk) (((kk) & 7) | ((((kk) >> 4) & 3) << 3))
#define TLOAD(v, t, h) do { _Pragma("unroll") for (int i = 0; i < 8; ++i) v[i] = __builtin_nontemporal_load((const f32x4*)(t.W + (size_t)(t.k0 + 64 * (h) + 8 * i + kr) * t.N + t.n0 + n4)); } while (0)
#define TWRITE(v, h) do { _Pragma("unroll") for (int i = 0; i < 8; ++i) { const int kk = 64 * (h) + 8 * i + kr; LAS float* s_ = scr + kk * 32; const int x = TSWZ(kk); \
                s_[(n4 + 0) ^ x] = v[i][0]; s_[(n4 + 1) ^ x] = v[i][1]; s_[(n4 + 2) ^ x] = v[i][2]; s_[(n4 + 3) ^ x] = v[i][3]; } } while (0)
            constexpr int NMOE = (NGU + NDN) / DEPTH * (DEPTH - 1), NGU_E = NGU / DEPTH * (DEPTH - 1);
#define RMAP(rp) ((rp) < NGU_E ? (rp) : (rp) + NGU / DEPTH)
            for (int rep = 0; rep < ((PROBE_KIND == 10) ? 2 : 1); ++rep) {
                int r = gw; TItem cur = moe_item(r < NMOE ? RMAP(r) : 0); f32x4 v0[8], v1[8];
                if (r < NMOE) TLOAD(v0, cur, 0);
                for (; r < NMOE; r += NGW) {
                    TLOAD(v1, cur, 1);
                    TWRITE(v0, 0);
                    TWRITE(v1, 1);
                    const int rn = r + NGW; TItem nxt = moe_item(rn < NMOE ? RMAP(rn) : RMAP(r));
                    if (rn < NMOE) TLOAD(v0, nxt, 0);
                    LDS_WAIT(); asm volatile("" ::: "memory");
#pragma unroll 1
                    for (int j = 0; j < 4; ++j) { const int n = (lane >> 3) + 8 * j; float u[16];
#pragma unroll
                        for (int q = 0; q < 16; ++q) { const int kk = 16 * c + q; u[q] = scr[kk * 32 + (n ^ TSWZ(kk))] * cur.sc; }
                        u32x4 o; o.x = pk4_fp8(u[0], u[1], u[2], u[3]); o.y = pk4_fp8(u[4], u[5], u[6], u[7]); o.z = pk4_fp8(u[8], u[9], u[10], u[11]); o.w = pk4_fp8(u[12], u[13], u[14], u[15]);
                        const int rr = cur.drow0 + n;
                        *(u32x4*)(cur.WT8 + (size_t)(rr >> 8) * 256 * 1024 + (size_t)(cur.k0 >> 7) * 32768 + (rr & 255) * 128 + 16 * c) = o; }
                    LDS_WAIT(); asm volatile("" ::: "memory");
                    cur = nxt;
                }
            }
#undef TSWZ
#undef TLOAD
#undef TWRITE
#undef RMAP
        }
    }
}

constexpr int DEF_GU = NE * 16 * 32, DEF_DN = NE * 16 * 16, NDEF = DEF_GU + DEF_DN;
__device__ __forceinline__ void deferred_fill(Frame& F, int nblocks) {
    unsigned* ctr = (unsigned*)(F.ws + WS_CTL) + 1024;
    LAS float* scr = (LAS float*)(F.lds + F.wave * 16384);
    volatile LAS unsigned* slot = (volatile LAS unsigned*)(F.lds + MISC_OFF) + 16;
    for (int k = 0; nblocks < 0 || k < nblocks; ++k) {
        __syncthreads();
        if (tid_from(F.wave) == 0) slot[0] = atomicAdd(ctr, 8u);
        __syncthreads();
        const unsigned base = __builtin_amdgcn_readfirstlane(slot[0]);
        if (base >= (unsigned)NDEF) break;
        const int q = (int)base + F.wave, lane = lane_now();
        constexpr int L = DEPTH - 1;
        if (q < DEF_GU) { const int mi = L * NE + q / 512, it = q % 512;
            transpose_matrix_items_f8(F.in[28] + (size_t)mi * D * 2 * DEX, D, 2 * DEX, F.ws + WS_WGU + (size_t)mi * 2 * DEX * D, 1, scr, it, lane, S8_WGU); }
        else { const int q2 = q - DEF_GU, mi = L * NE + q2 / 256, it = q2 % 256;
            transpose_matrix_items_f8(F.in[30] + (size_t)mi * DEX * D, DEX, D, F.ws + WS_WDN + (size_t)mi * D * DEX, 0, scr, it, lane, S8_WDN); }
    }
    __syncthreads();
}
__device__ __forceinline__ float modval(const float* modf, const float* ada_b, int layer, int b, int idx, int n) {
    return modf[((size_t)layer * NB + b) * (6 * D) + idx * D + n];
}
__device__ __forceinline__ void rowpass(Frame& F, int layer, int stage) {
    const bool has_post = !(layer == 0 && stage == 0), has_h = layer < DEPTH;
    const int pl = (stage == 0) ? layer - 1 : layer, ps = (stage == 0) ? 1 : 0;
    const int hmode = !has_h ? 0 : (stage == 1 ? 1 : (layer == 0 ? 2 : (layer == 2 ? 3 : 1)));
    const float* xsrc = F.in[0]; _Float16* x16 = (_Float16*)(F.ws + WS_X16);
    const float* modp = (const float*)(F.ws + WS_MODP); const float* ada_b = F.in[3];
    const bf16_t* Yd = (const bf16_t*)(F.ws + WS_Y);
    const unsigned char* YB = F.ws + WS_SCR + SC_DNO;
    int* topi = (int*)(F.ws + WS_ROUTE + RT_TOPI); float* topg = (float*)(F.ws + WS_ROUTE + RT_TOPG); int* destp = (int*)(F.ws + WS_ROUTE + RT_DEST); int* hist = (int*)(F.ws + WS_ROUTE + RT_HIST);
    bf16_t* H = (bf16_t*)(F.ws + WS_H); bf16_t* AOP = (bf16_t*)(F.ws + WS_SCR + SC_AOP);
    LAS float* gv = (LAS float*)F.lds;
    LAS float* pgv = gv + D, *pbv = pgv + D;
    LAS float* scv = pbv + D, *shv = scv + D;
    LAS float* stt = shv + D;
    LAS unsigned char* big = F.lds + 6 * D * 4;
    for (int rb = F.vcu; rb < NTOK / 64; rb += F.G) {
        const int b = rb / (SEQ / 64);
        struct Raw { f32x4 xf[4]; h16x4 xh[4]; u32x2 yd[4]; int yb[4][4]; float gk[4]; };
        int dall = 0, gall = 0;
        if (has_post && ps == 1) { const int q = F.lane & 31, rr = rb * 64 + (q >> 4) * 32 + F.wave * 4 + ((q >> 2) & 3); dall = destp[rr * 4 + (q & 3)]; gall = __float_as_int(topg[rr * 4 + (q & 3)]); }
        auto load_raw = [&](int rnd_, int i_, Raw& R) { const int row_ = rb * 64 + rnd_ * 32 + F.wave * 4 + i_;
#pragma unroll
            for (int j = 0; j < 4; ++j) { if (layer == 0) R.xf[j] = *(const f32x4*)(xsrc + (size_t)row_ * D + 256 * j + 4 * F.lane); else R.xh[j] = *(const h16x4*)(x16 + (size_t)row_ * D + 256 * j + 4 * F.lane); }
            if (has_post) {
                if (ps == 0) {
#pragma unroll
                    for (int j = 0; j < 4; ++j) R.yd[j] = *(const u32x2*)(Yd + (size_t)row_ * D + 256 * j + 4 * F.lane);
                } else {
#pragma unroll
                    for (int k = 0; k < 4; ++k) { const int dr = __builtin_amdgcn_readlane(dall, rnd_ * 16 + i_ * 4 + k); R.gk[k] = __int_as_float(__builtin_amdgcn_readlane(gall, rnd_ * 16 + i_ * 4 + k)) * (1.0f / S8_Y);
#pragma unroll
                        for (int j = 0; j < 4; ++j) R.yb[k][j] = *(const int*)(YB + (size_t)dr * D + 256 * j + 4 * F.lane); }
                } } };
        Raw cur; load_raw(0, 0, cur);
        for (int n = F.tid; n < D; n += NTHR) {
            if (has_post) { gv[n] = modval(modp, ada_b, pl, b, ps ? 5 : 2, n); pgv[n] = F.in[4][(pl * 2 + ps) * D + n]; pbv[n] = F.in[5][(pl * 2 + ps) * D + n]; }
            if (has_h) { scv[n] = 1.f + modval(modp, ada_b, layer, b, stage ? 4 : 1, n); shv[n] = modval(modp, ada_b, layer, b, stage ? 3 : 0, n); }
        }
        __syncthreads();
        for (int rnd = 0; rnd < 2; ++rnd) {
            for (int i = 0; i < 4; ++i) {
                const int lr = rnd * 32 + F.wave * 4 + i, row = rb * 64 + lr;
                Raw nxt; if (!(rnd == 1 && i == 3)) load_raw(i == 3 ? 1 : rnd, i == 3 ? 0 : i + 1, nxt);
                f32x4 v[4];
#pragma unroll
                for (int j = 0; j < 4; ++j) { if (layer == 0) v[j] = cur.xf[j]; else v[j] = __builtin_convertvector(cur.xh[j], f32x4); }
                if (has_post) {
                    f32x4 y[4];
                    if (ps == 0) {
#pragma unroll
                        for (int j = 0; j < 4; ++j) { const u32x2 w = cur.yd[j]; y[j] = (f32x4){bflo(w.x), bfhi(w.x), bflo(w.y), bfhi(w.y)}; }
                    } else {
#pragma unroll
                        for (int j = 0; j < 4; ++j) y[j] = (f32x4){0.f, 0.f, 0.f, 0.f};
#pragma unroll
                        for (int k = 0; k < 4; ++k) { const float gk = cur.gk[k];
#pragma unroll
                            for (int j = 0; j < 4; ++j) { const int w = cur.yb[k][j];
                                const f32x2 lo = __builtin_amdgcn_cvt_pk_f32_fp8(w, false), hi = __builtin_amdgcn_cvt_pk_f32_fp8(w, true);
                                y[j][0] += gk * lo.x; y[j][1] += gk * lo.y; y[j][2] += gk * hi.x; y[j][3] += gk * hi.y; } }
                    }
                    float s = 0.f;
#pragma unroll
                    for (int j = 0; j < 4; ++j) { const f32x4 gg = *(const LAS f32x4*)(gv + 256 * j + 4 * F.lane); v[j] = DN_ALPHA * v[j] + gg * y[j]; s += (v[j][0] + v[j][1]) + (v[j][2] + v[j][3]); }
                    const float mean = wave_sum(s) * (1.f / D); float q = 0.f;
#pragma unroll
                    for (int j = 0; j < 4; ++j) { v[j] = v[j] - mean; q += (v[j][0] * v[j][0] + v[j][1] * v[j][1]) + (v[j][2] * v[j][2] + v[j][3] * v[j][3]); }
                    const float rstd = 1.f / sqrtf(wave_sum(q) * (1.f / D) + LN_EPS);
#pragma unroll
                    for (int j = 0; j < 4; ++j) { const f32x4 pg = *(const LAS f32x4*)(pgv + 256 * j + 4 * F.lane), pb = *(const LAS f32x4*)(pbv + 256 * j + 4 * F.lane);
                        v[j] = v[j] * rstd * pg + pb;
                        if (has_h) { const h16x4 hx = __builtin_convertvector(v[j], h16x4); *(h16x4*)(x16 + (size_t)row * D + 256 * j + 4 * F.lane) = hx; v[j] = __builtin_convertvector(hx, f32x4); }
                        else *(f32x4*)(F.out + (size_t)row * D + 256 * j + 4 * F.lane) = v[j]; }
                }
                if (has_h) {
                    float s = 0.f;
#pragma unroll
                    for (int j = 0; j < 4; ++j) s += (v[j][0] + v[j][1]) + (v[j][2] + v[j][3]);
                    const float mean = wave_sum(s) * (1.f / D); float q = 0.f;
#pragma unroll
                    for (int j = 0; j < 4; ++j) { v[j] = v[j] - mean; q += (v[j][0] * v[j][0] + v[j][1] * v[j][1]) + (v[j][2] * v[j][2] + v[j][3] * v[j][3]); }
                    const float rstd = 1.f / sqrtf(wave_sum(q) * (1.f / D) + LN_EPS);
                    if (F.lane == 0) { stt[lr * 2] = mean; stt[lr * 2 + 1] = rstd; }
#pragma unroll
                    for (int j = 0; j < 4; ++j) { const f32x4 sc = *(const LAS f32x4*)(scv + 256 * j + 4 * F.lane), sh = *(const LAS f32x4*)(shv + 256 * j + 4 * F.lane);
                        const f32x4 h = v[j] * rstd * sc + sh; const u32x2 w = {cvt_pk_bf16(h[0], h[1]), cvt_pk_bf16(h[2], h[3])};
                        if (hmode == 1) *(unsigned*)((unsigned char*)H + (size_t)row * D + 256 * j + 4 * F.lane) = pk4_fp8(h[0] * S8_H, h[1] * S8_H, h[2] * S8_H, h[3] * S8_H);
                        else if (hmode == 2) *(LAS unsigned*)(big + (size_t)(lr & 31) * 1028 + 256 * j + 4 * F.lane) = pk4_fp8(h[0] * S8_H, h[1] * S8_H, h[2] * S8_H, h[3] * S8_H);
                        else *(LAS u32x2*)(big + (size_t)(lr & 31) * 2064 + (256 * j + 4 * F.lane) * 2) = w;
                    }
                }
                cur = nxt;
            }
            if (hmode == 3) {
                __syncthreads();
                const int j0 = ((rb * 64 + rnd * 32) & (SEQ - 1)) >> 4;
                for (int q = F.tid; q < 4096; q += NTHR) { const int g = q >> 6, jj = (q >> 5) & 1, t = (q >> 1) & 15, c8 = (q & 1) * 8;
                    *(u32x4*)(AOP + ((size_t)(g * 1024 + b * 256 + j0 + jj)) * 512 + t * 16 + c8) = *(const LAS u32x4*)(big + (size_t)(16 * jj + t) * 2064 + (g * 16 + c8) * 2); }
                __syncthreads();
            }
            if (hmode == 2) {
                __syncthreads();
                const int l0 = (rb * 64 + rnd * 32) & (SEQ - 1);
                for (int it = F.tid; it < 2048; it += NTHR) { const int ch = it >> 1, lg = it & 1; unsigned wq[4];
#pragma unroll
                    for (int q = 0; q < 4; ++q) { const LAS unsigned char* pz = big + (size_t)(lg * 16 + 4 * q) * 1028 + ch;
                        wq[q] = (unsigned)pz[0] | ((unsigned)pz[1028] << 8) | ((unsigned)pz[2056] << 16) | ((unsigned)pz[3084] << 24); }
                    *(u32x4*)((unsigned char*)H + ((size_t)b * D + ch) * SEQ + l0 + lg * 16) = (u32x4){wq[0], wq[1], wq[2], wq[3]}; }
                __syncthreads();
            }
        }
        if (has_h && stage == 1) {
            VM_WAIT(); __syncthreads();
            __builtin_amdgcn_fence(__ATOMIC_ACQUIRE, "agent"); VM_WAIT();
            constexpr int HP = 68;
            LAS float* hsT = (LAS float*)big;
            LAS float* wt = hsT + 64 * HP;
            LAS float* lg = wt + 64 * 32;
            LAS int* hh = (LAS int*)(lg + 64 * 33);
            LAS float* red = (LAS float*)(hh + 32);
            const float* wr = F.in[26] + (size_t)layer * D * NE; const float* br = F.in[27] + layer * NE;
            if (F.tid < 32) hh[F.tid] = 0;
            const int kq = F.tid >> 7, rg = (F.tid & 127) >> 3, eg = F.tid & 7;
            const int r = F.tid >> 3, ks = (F.tid & 7) * 8, kk = F.tid >> 3, e4 = (F.tid & 7) * 4;
            const float mean = stt[r * 2], rstd = stt[r * 2 + 1];
            const _Float16* xp = x16 + (size_t)(rb * 64 + r) * D + ks; const float* wp = wr + (size_t)kk * NE + e4;
            f32x4 acc[4] = {(f32x4){0.f, 0.f, 0.f, 0.f}, (f32x4){0.f, 0.f, 0.f, 0.f}, (f32x4){0.f, 0.f, 0.f, 0.f}, (f32x4){0.f, 0.f, 0.f, 0.f}};
            h16x8 xh = *(const h16x8*)xp; f32x4 wv = *(const f32x4*)wp;
            for (int k0 = 0; k0 < D; k0 += 64) {
                { const f32x4 sa = *(const LAS f32x4*)(scv + k0 + ks), sb = *(const LAS f32x4*)(scv + k0 + ks + 4), ha = *(const LAS f32x4*)(shv + k0 + ks), hb = *(const LAS f32x4*)(shv + k0 + ks + 4);
                    const f32x4 xa = __builtin_convertvector(__builtin_shufflevector(xh, xh, 0, 1, 2, 3), f32x4), xb = __builtin_convertvector(__builtin_shufflevector(xh, xh, 4, 5, 6, 7), f32x4);
                    const f32x4 va = (xa - mean) * rstd * sa + ha, vb = (xb - mean) * rstd * sb + hb;
#pragma unroll
                    for (int q = 0; q < 4; ++q) { hsT[(ks + q) * HP + r] = va[q]; hsT[(ks + 4 + q) * HP + r] = vb[q]; }
                    *(LAS f32x4*)(wt + kk * 32 + e4) = wv; }
                if (k0 + 64 < D) { xh = *(const h16x8*)(xp + k0 + 64); wv = *(const f32x4*)(wp + (size_t)(k0 + 64) * NE); }
                __syncthreads();
#pragma unroll 4
                for (int k = 16 * kq; k < 16 * kq + 16; ++k) { const f32x4 h4 = *(const LAS f32x4*)(hsT + k * HP + 4 * rg), w4 = *(const LAS f32x4*)(wt + k * 32 + 4 * eg);
#pragma unroll
                    for (int a = 0; a < 4; ++a) acc[a] += h4[a] * w4; }
                __syncthreads();
            }
#pragma unroll
            for (int a = 0; a < 4; ++a) *(LAS f32x4*)(red + (kq * 64 + 4 * rg + a) * 32 + 4 * eg) = acc[a];
            __syncthreads();
            { const int row = F.tid >> 3, e0 = (F.tid & 7) * 4;
                f32x4 sum = *(const LAS f32x4*)(red + row * 32 + e0) + *(const LAS f32x4*)(red + (64 + row) * 32 + e0) + *(const LAS f32x4*)(red + (128 + row) * 32 + e0) + *(const LAS f32x4*)(red + (192 + row) * 32 + e0);
#pragma unroll
                for (int q = 0; q < 4; ++q) lg[row * 33 + e0 + q] = sum[q] + br[e0 + q]; }
            __syncthreads();
            if (F.tid < 64) { const int tok = rb * 64 + F.tid; float vals[4]; int idx[4]; unsigned taken = 0u;
#pragma unroll
                for (int k = 0; k < 4; ++k) { float best = -3.0e38f; int bi = 0;
                    for (int e = 0; e < NE; ++e) { const float x = lg[F.tid * 33 + e]; if (!((taken >> e) & 1u) && x > best) { best = x; bi = e; } }
                    taken |= 1u << bi; vals[k] = best; idx[k] = bi; }
                float den = 0.f, ex[4];
#pragma unroll
                for (int k = 0; k < 4; ++k) { ex[k] = __expf(vals[k] - vals[0]); den += ex[k]; }
#pragma unroll
                for (int k = 0; k < 4; ++k) { topi[tok * 4 + k] = idx[k]; topg[tok * 4 + k] = ex[k] / den; atomicAdd((int*)&hh[idx[k]], 1); }
            }
            __syncthreads();
            if (F.tid < 32) hist[rb * 32 + F.tid] = hh[F.tid];
        }
        __syncthreads();
    }
}

__device__ __forceinline__ void moe_place(Frame& F) {
    const int* topi = (const int*)(F.ws + WS_ROUTE + RT_TOPI); int* destp = (int*)(F.ws + WS_ROUTE + RT_DEST); const int* hist = (const int*)(F.ws + WS_ROUTE + RT_HIST);
    int* tile = (int*)(F.ws + WS_SMALL + SM_TILE);
    unsigned short* rowtok = (unsigned short*)(F.ws + WS_ROUTE + RT_ROWTOK);
    LAS int* tot = (LAS int*)F.lds; LAS int* pre = tot + 32; LAS int* pst = pre + 32; LAS int* es = pst + 32; LAS int* dst = es + 256;
    for (int rb = F.vcu; rb < NTOK / 64; rb += F.G) {
        if (F.tid < 64) tot[F.tid] = 0;
        __syncthreads();
        { const int e = F.tid & 31, part = F.tid >> 5; int sa = 0, sp = 0;
            for (int q = 0; q < 16; ++q) { const int bb = part * 16 + q; const int hv = hist[bb * 32 + e]; sa += hv; if (bb < rb) sp += hv; }
            atomicAdd((int*)&tot[e], sa); atomicAdd((int*)&pre[e], sp); }
        if (F.tid < 256) es[F.tid] = topi[rb * 256 + F.tid];
        __syncthreads();
        if (F.tid == 0) { int run = 0; for (int e = 0; e < NE; ++e) { pst[e] = run; run += (tot[e] + 255) & ~255; }
            if (rb == 0) tile[0] = run >> 8; }
        __syncthreads();
        if (rb == 0 && F.tid < NE) { const int e = F.tid, t0 = pst[e] >> 8, n = (tot[e] + 255) >> 8; for (int q = 0; q < n; ++q) tile[1 + t0 + q] = e; }
        LAS int* wcn = dst + 256;
        int myrank = 0; const int me = (F.tid < 256) ? es[F.tid] : -1;
        if (F.tid < 256) { for (int x = 0; x < NE; ++x) { const unsigned long long m = __ballot(me == x); if (me == x) myrank = __popcll(m & ((1ull << F.lane) - 1ull)); if (F.lane == 0) wcn[F.wave * 32 + x] = __popcll(m); } }
        __syncthreads();
        if (F.tid < 256) { int base = 0; for (int w2 = 0; w2 < F.wave; ++w2) base += wcn[w2 * 32 + me];
            const int d = pst[me] + pre[me] + base + myrank; dst[F.tid] = d; destp[rb * 256 + F.tid] = d; }
        __syncthreads();
        if (F.tid < 256) rowtok[dst[F.tid]] = (unsigned short)(rb * 64 + (F.tid >> 2));
        if (rb < NE) { const int e = rb, r0 = pst[e] + tot[e], r1 = pst[e] + ((tot[e] + 255) & ~255);
            for (int r = r0 + F.tid; r < r1; r += NTHR) rowtok[r] = 0; }
        __syncthreads();
    }
}

__device__ __forceinline__ int load_tile_table(Frame& F) {
    const int* tile = (const int*)(F.ws + WS_SMALL + SM_TILE);
    const int ntiles = __builtin_amdgcn_readfirstlane(tile[0]);
    LAS int* tl = (LAS int*)(F.lds + TILE_LDS_OFF);
    if (F.tid < 320) tl[F.tid] = tile[1 + F.tid];
    __syncthreads();
    return ntiles;
}
__device__ __forceinline__ void qk_norm_rope(Frame& F) {
    LAS float* cs = (LAS float*)F.lds;
    LAS float* sn = cs + 2048;
    for (int i = F.tid; i < 2048; i += NTHR) { const int pos = i >> 5, j = i & 31; const float inv = powf(10000.0f, -(float)(2 * j) / 64.0f); float s, c; sincosf((float)pos * inv, &s, &c); cs[i] = c; sn[i] = s; }
    __syncthreads();
    bf16_t* QKV = (bf16_t*)(F.ws + WS_SCR + SC_QKV);
    const float* qg = F.in[9]; const float* kg = F.in[10];
    const int gw = F.vcu * NWAVES + F.wave, NGW = F.G * NWAVES;
    const int hs = F.lane >> 5, i = F.lane & 31;
    const float gq1 = qg[hs * 64 + i], gq2 = qg[hs * 64 + 32 + i], gk1 = kg[hs * 64 + i], gk2 = kg[hs * 64 + 32 + i];
    for (int tok = gw; tok < NTOK; tok += NGW) {
        const int l = tok & (SEQ - 1), pos = hs ? (l & 63) : (l >> 6);
        bf16_t* p = QKV + (size_t)tok * QKVC + hs * 64 + i;
        float x1[12], x2[12];
#pragma unroll
        for (int hd = 0; hd < 12; ++hd) { x1[hd] = bf2f(p[hd * 128]); x2[hd] = bf2f(p[hd * 128 + 32]); }
        const float c = cs[pos * 32 + i], s = sn[pos * 32 + i];
#pragma unroll
        for (int hd = 0; hd < 12; ++hd) {
            const float ss = wave_sum(x1[hd] * x1[hd] + x2[hd] * x2[hd]), r = __builtin_amdgcn_rsqf(ss * (1.f / 128.f) + RMS_EPS);
            const float y1 = x1[hd] * r * (hd < 8 ? gq1 : gk1), y2 = x2[hd] * r * (hd < 8 ? gq2 : gk2);
            p[hd * 128] = f2bf(y1 * c - y2 * s); p[hd * 128 + 32] = f2bf(y2 * c + y1 * s); }
    }
}
__device__ __forceinline__ void attn_phase(Frame& F) {
    const bf16_t* QKV = (const bf16_t*)(F.ws + WS_SCR + SC_QKV); bf16_t* O = (bf16_t*)(F.ws + WS_SCR + SC_O);
    for (int id0 = F.vcu; id0 < 512; id0 += F.G) {
        const int bk = id0 >> 5, j = id0 & 31, b = bk >> 2, kvh = bk & 3, h = kvh * 2 + (j >> 4), qb = j & 15;
        const bf16_t* Qb = QKV + ((size_t)b * SEQ + qb * 256) * QKVC + h * 128;
        const bf16_t* Kh = QKV + ((size_t)b * SEQ) * QKVC + 1024 + kvh * 128;
        const bf16_t* Vh = QKV + ((size_t)b * SEQ) * QKVC + 1536 + kvh * 128;
        bf16_t* Ob = O + ((size_t)b * SEQ + qb * 256) * D + h * 128;
        att::attn_dense_body(Qb, Kh, Vh, Ob, SEQ, F.ldsg, F.wave);
    }
}

__device__ __forceinline__ void s5_scan_unit(Frame& F, int g, int b) {
    const float* S = (const float*)(F.ws + WS_SCR + SC_SST); bf16_t* AOP = (bf16_t*)(F.ws + WS_SCR + SC_AOP);
    const f32x2* aT = (const f32x2*)(F.ws + WS_SMALL + SM_AT);
    if (F.tid < 128) {
        const int p = F.tid & 63, dir = F.tid >> 6;
        const f32x2 a = aT[(dir * S5G + g) * S5P + p];
        const size_t rowbase = (size_t)g * 1024 + b * 256; const int n = dir * 128 + p;
        float er = 0.f, ei = 0.f;
        for (int jj = 0; jj < S5NCH; jj += 32) {
            float sr[32], si[32];
#pragma unroll
            for (int q = 0; q < 32; ++q) { const int j = dir ? (S5NCH - 1 - (jj + q)) : (jj + q); sr[q] = S[(rowbase + j) * 256 + n]; si[q] = S[(rowbase + j) * 256 + n + 64]; }
#pragma unroll
            for (int q = 0; q < 32; ++q) { const int j = dir ? (S5NCH - 1 - (jj + q)) : (jj + q);
                bf16_t* o = AOP + (rowbase + j) * 512 + 256 + n; o[0] = f2bf(er); o[64] = f2bf(ei);
                const float nr = a.x * er - a.y * ei + sr[q], ni = a.x * ei + a.y * er + si[q]; er = nr; ei = ni; }
        }
    }
}

namespace hg {
constexpr int PQ = 272, PK = 144;
constexpr int IMG_QD = 0, IMG_KLT = 64 * PQ, IMG_ATT = IMG_KLT + 128 * PK, IMG_DEC = IMG_ATT + 64 * PK, IMG_BYTES = IMG_DEC + 512, IMG_PIECES = IMG_BYTES / 16;
__device__ __forceinline__ bf16x8 ldsv(LAS unsigned char* base, int off) { return *(const LAS bf16x8*)(base + off); }
__device__ __forceinline__ unsigned char* img_ptr(unsigned char* ws, int b, int hh, int dir, int n) { return ws + WS_HGIMG + (size_t)((((b * 8 + hh) * 2 + dir) * 64) + n) * IMG_BYTES; }

__device__ __forceinline__ void hgrn_prep(Frame& F) {
    constexpr int RAWQ = 0, RAWF = 16384, KD = 32768, PS = KD + 64 * PQ, IMG = PS + 4096;
    const bf16_t* P = (const bf16_t*)(F.ws + WS_SCR + SC_P);
    const float* lbp = (const float*)(F.ws + WS_SMALL + SM_LB);
    LAS unsigned char* L = F.lds;
    const int tid = F.tid, lane = F.lane, w = F.wave, fr = lane & 15, fq = lane >> 4;
    const int d0 = 2 * lane, t0 = w * 8;
    unsigned rq[8], rf[8];
#define HG_LOAD(item_) do { const int n_ = (item_) & 63, dir_ = ((item_) >> 6) & 1, hh_ = ((item_) >> 7) & 7, b_ = (item_) >> 10; \
        _Pragma("unroll") for (int i_ = 0; i_ < 8; ++i_) { const int tau = n_ * 64 + t0 + i_; const size_t l_ = dir_ ? (size_t)(SEQ - 1 - tau) : (size_t)tau; \
            const bf16_t* row_ = P + ((size_t)b_ * SEQ + l_) * 5120 + hh_ * 128 + d0; rq[i_] = *(const unsigned*)(row_); rf[i_] = *(const unsigned*)(row_ + 1024 * (1 + dir_)); } } while (0)
    int item = F.vcu;
    if (item < 4096) HG_LOAD(item);
    for (; item < 4096; item += F.G) {
        const int n = item & 63, dir = (item >> 6) & 1, hh = (item >> 7) & 7, b = item >> 10;
        const float lb0 = lbp[hh * 128 + d0], lb1 = lbp[hh * 128 + d0 + 1], om0 = 1.f - lb0, om1 = 1.f - lb1;
        unsigned cq[8], cf[8];
#pragma unroll
        for (int i = 0; i < 8; ++i) { cq[i] = rq[i]; cf[i] = rf[i]; }
        if (item + F.G < 4096) HG_LOAD(item + F.G);
        float cs0[8], cs1[8], k0[8], k1[8]; float c0 = 1.f, c1 = 1.f;
#pragma unroll
        for (int i = 0; i < 8; ++i) { const unsigned fw = cf[i];
            const float s0 = sigmoidf_(bflo(fw)), s1 = sigmoidf_(bfhi(fw));
            c0 *= lb0 + om0 * s0; c1 *= lb1 + om1 * s1; cs0[i] = c0; cs1[i] = c1; k0[i] = om0 * (1.f - s0); k1[i] = om1 * (1.f - s1); }
        *(LAS f32x2*)(L + PS + (w * 128 + d0) * 4) = (f32x2){c0, c1};
        __syncthreads();
        float off0 = 1.f, off1 = 1.f, tot0 = 1.f, tot1 = 1.f;
#pragma unroll
        for (int q = 0; q < 8; ++q) { const f32x2 x = *(const LAS f32x2*)(L + PS + (q * 128 + d0) * 4); tot0 *= x.x; tot1 *= x.y; if (q < w) { off0 *= x.x; off1 *= x.y; } }
        float kl0[8], kl1[8]; const float et0 = tot0, et1 = tot1;
        const float ri0 = __builtin_amdgcn_rcpf(off0 * cs0[7]), ri1 = __builtin_amdgcn_rcpf(off1 * cs1[7]); float suf0 = 1.f, suf1 = 1.f;
#pragma unroll
        for (int i = 7; i >= 0; --i) { const int t = t0 + i;
            const unsigned qw = cq[i]; const float q0 = bflo(qw), q1 = bfhi(qw);
            const float e0 = off0 * cs0[i], e1 = off1 * cs1[i], r0 = ri0 * suf0, r1 = ri1 * suf1; suf0 *= 1.f - k0[i]; suf1 *= 1.f - k1[i];
            *(LAS unsigned*)(L + IMG + IMG_QD + t * PQ + d0 * 2) = cvt_pk_bf16(siluf_(q0) * e0, siluf_(q1) * e1);
            *(LAS unsigned*)(L + KD + t * PQ + d0 * 2) = cvt_pk_bf16(k0[i] * r0, k1[i] * r1);
            kl0[i] = k0[i] * r0 * et0; kl1[i] = k1[i] * r1 * et1; }
        *(LAS u32x4*)(L + IMG + IMG_KLT + d0 * PK + t0 * 2) = (u32x4){cvt_pk_bf16(kl0[0], kl0[1]), cvt_pk_bf16(kl0[2], kl0[3]), cvt_pk_bf16(kl0[4], kl0[5]), cvt_pk_bf16(kl0[6], kl0[7])};
        *(LAS u32x4*)(L + IMG + IMG_KLT + (d0 + 1) * PK + t0 * 2) = (u32x4){cvt_pk_bf16(kl1[0], kl1[1]), cvt_pk_bf16(kl1[2], kl1[3]), cvt_pk_bf16(kl1[4], kl1[5]), cvt_pk_bf16(kl1[6], kl1[7])};
        if (w == 0) *(LAS f32x2*)(L + IMG + IMG_DEC + d0 * 4) = (f32x2){et0, et1};
        __syncthreads();
        { const int a = w >> 1;
#pragma unroll
            for (int bi = 0; bi < 2; ++bi) { const int bt_ = (w & 1) * 2 + bi; f32x4 acc = {0.f, 0.f, 0.f, 0.f};
#pragma unroll
                for (int ks = 0; ks < 4; ++ks) { const bf16x8 X = ldsv(L, KD + (16 * bt_ + fr) * PQ + (ks * 32 + 8 * fq) * 2), Y = ldsv(L, IMG + IMG_QD + (16 * a + fr) * PQ + (ks * 32 + 8 * fq) * 2);
                    acc = __builtin_amdgcn_mfma_f32_16x16x32_bf16(X, Y, acc, 0, 0, 0); }
                const int t = 16 * a + fr, s0 = 16 * bt_ + 4 * fq;
                const float v0 = (s0 + 0 <= t) ? acc[0] : 0.f, v1 = (s0 + 1 <= t) ? acc[1] : 0.f, v2 = (s0 + 2 <= t) ? acc[2] : 0.f, v3 = (s0 + 3 <= t) ? acc[3] : 0.f;
                *(LAS u32x2*)(L + IMG + IMG_ATT + t * PK + s0 * 2) = (u32x2){cvt_pk_bf16(v0, v1), cvt_pk_bf16(v2, v3)}; } }
        __syncthreads();
        { unsigned char* g = img_ptr(F.ws, b, hh, dir, n);
#pragma unroll
            for (int it = 0; it < 6; ++it) { const int pc = it * 512 + tid; if (pc < IMG_PIECES) *(u32x4*)(g + pc * 16) = *(const LAS u32x4*)(L + IMG + pc * 16); } }
    }
    __syncthreads();
#undef HG_LOAD
}

__device__ __forceinline__ void hgrn_rec(Frame& F) {
    constexpr int IMG0 = 0, IMG1 = IMG_BYTES, VT = 2 * IMG_BYTES, ST = VT + 2 * 32 * PK;
    const bf16_t* P = (const bf16_t*)(F.ws + WS_SCR + SC_P); float* OFB = (float*)(F.ws + WS_SCR + SC_OFB);
    LAS unsigned char* L = F.lds;
    const int tid = F.tid, lane = F.lane, w = F.wave, fr = lane & 15, fq = lane >> 4;
    for (int unit = F.vcu; unit < 256; unit += F.G) {
        const int vs = unit & 3, dir = (unit >> 2) & 1, hh = (unit >> 3) & 7, b = unit >> 6;
        const size_t tok0 = (size_t)b * SEQ; const int cv = 3072 + hh * 128 + vs * 32;
        for (int i = tid; i < 2 * 32 * PQ / 4; i += NTHR) ((LAS unsigned*)(L + ST))[i] = 0u;
        f32x4 sacc[2] = {(f32x4){0.f, 0.f, 0.f, 0.f}, (f32x4){0.f, 0.f, 0.f, 0.f}};
        u32x4 rv = {0u, 0u, 0u, 0u};
#define HG_DMA(n_, buf_) do { const unsigned char* g_ = img_ptr(F.ws, b, hh, dir, (n_)); _Pragma("unroll") for (int it = 0; it < 6; ++it) { const int pc = it * 512 + tid; \
            if (pc < IMG_PIECES) __builtin_amdgcn_global_load_lds((const unsigned*)(g_ + (size_t)pc * 16), (LAS unsigned*)(L + (buf_) + (it * 512 + w * 64) * 16), 16, 0, 0); } } while (0)
#define HG_LOADV(n_) do { if (tid < 256) { const int t_ = tid >> 2, v8 = (tid & 3) * 8; const int tau = (n_) * 64 + t_; const size_t l_ = dir ? (size_t)(SEQ - 1 - tau) : (size_t)tau; rv = *(const u32x4*)(P + (tok0 + l_) * 5120 + cv + v8); } } while (0)
        HG_DMA(0, IMG0); HG_LOADV(0);
        for (int n = 0; n < HGNCH; ++n) {
            const int cur = n & 1, nxt = cur ^ 1; LAS unsigned char* I = L + (cur ? IMG1 : IMG0); LAS unsigned char* V = L + VT + cur * 32 * PK;
            VM_WAIT();
            if (tid < 256) { const int s = tid >> 2, v8 = (tid & 3) * 8; const unsigned wv[4] = {rv.x, rv.y, rv.z, rv.w};
#pragma unroll
                for (int q = 0; q < 4; ++q) { *(LAS unsigned short*)(V + (v8 + 2 * q) * PK + s * 2) = (unsigned short)(wv[q] & 0xffffu); *(LAS unsigned short*)(V + (v8 + 2 * q + 1) * PK + s * 2) = (unsigned short)(wv[q] >> 16); } }
            __syncthreads();
            if (n + 1 < HGNCH) { if (nxt) HG_DMA(n + 1, IMG1); else HG_DMA(n + 1, IMG0); HG_LOADV(n + 1); }
            { const int a = w >> 1, cvt = w & 1; f32x4 acc = {0.f, 0.f, 0.f, 0.f};
#pragma unroll
                for (int ks = 0; ks < 2; ++ks) { const bf16x8 X = ldsv(V, (16 * cvt + fr) * PK + (ks * 32 + 8 * fq) * 2), Y = ldsv(I, IMG_ATT + (16 * a + fr) * PK + (ks * 32 + 8 * fq) * 2);
                    acc = __builtin_amdgcn_mfma_f32_16x16x32_bf16(X, Y, acc, 0, 0, 0); }
#pragma unroll
                for (int ks = 0; ks < 4; ++ks) { const bf16x8 X = ldsv(L, ST + cur * 32 * PQ + (16 * cvt + fr) * PQ + (ks * 32 + 8 * fq) * 2), Y = ldsv(I, IMG_QD + (16 * a + fr) * PQ + (ks * 32 + 8 * fq) * 2);
                    acc = __builtin_amdgcn_mfma_f32_16x16x32_bf16(X, Y, acc, 0, 0, 0); }
                { const int tau = n * 64 + 16 * a + fr; const size_t l_ = dir ? (size_t)(SEQ - 1 - tau) : (size_t)tau;
                    *(f32x4*)(OFB + ((size_t)dir * NTOK + tok0 + l_) * D + hh * 128 + vs * 32 + 16 * cvt + 4 * fq) = acc; }
#pragma unroll
                for (int i = 0; i < 2; ++i) { const int e = (w >> 1) * 2 + i; f32x4 a2 = {0.f, 0.f, 0.f, 0.f};
#pragma unroll
                    for (int ks = 0; ks < 2; ++ks) { const bf16x8 X = ldsv(I, IMG_KLT + (16 * e + fr) * PK + (ks * 32 + 8 * fq) * 2), Y = ldsv(V, (16 * cvt + fr) * PK + (ks * 32 + 8 * fq) * 2);
                        a2 = __builtin_amdgcn_mfma_f32_16x16x32_bf16(X, Y, a2, 0, 0, 0); }
                    const f32x4 dc = *(const LAS f32x4*)(I + IMG_DEC + (16 * e + 4 * fq) * 4);
                    sacc[i] = dc * sacc[i] + a2;
                    *(LAS u32x2*)(L + ST + nxt * 32 * PQ + (16 * cvt + fr) * PQ + (16 * e + 4 * fq) * 2) = (u32x2){cvt_pk_bf16(sacc[i][0], sacc[i][1]), cvt_pk_bf16(sacc[i][2], sacc[i][3])}; } }
        }
        VM_WAIT(); __syncthreads();
#undef HG_DMA
#undef HG_LOADV
    }
}
__device__ __forceinline__ void hgrn_combine(Frame& F) {
    const float* OFB = (const float*)(F.ws + WS_SCR + SC_OFB); const bf16_t* P = (const bf16_t*)(F.ws + WS_SCR + SC_P); bf16_t* HA = (bf16_t*)(F.ws + WS_SCR + SC_HA);
    const float* ng = F.in[24];
    const int gw = F.vcu * NWAVES + F.wave, NGW = F.G * NWAVES;
    struct Trip { f32x4 a[2][4], bq[2][4]; u32x2 g[2][4]; };
    auto load_trip = [&](int row0, Trip& T) {
#pragma unroll
        for (int rr = 0; rr < 2; ++rr) { const int row = row0 + rr * NGW;
#pragma unroll
            for (int j = 0; j < 4; ++j) { const int col = 256 * j + 4 * F.lane; T.a[rr][j] = *(const f32x4*)(OFB + (size_t)row * D + col); T.bq[rr][j] = *(const f32x4*)(OFB + ((size_t)NTOK + row) * D + col); T.g[rr][j] = *(const u32x2*)(P + (size_t)row * 5120 + 4096 + col); } } };
    Trip cur; if (gw < NTOK) load_trip(gw, cur);
    for (int row0 = gw; row0 < NTOK; row0 += 2 * NGW) {
        Trip nxt; if (row0 + 2 * NGW < NTOK) load_trip(row0 + 2 * NGW, nxt);
#pragma unroll
        for (int rr = 0; rr < 2; ++rr) { const int row = row0 + rr * NGW;
#pragma unroll
            for (int j = 0; j < 4; ++j) { const int col = 256 * j + 4 * F.lane; const f32x4 o = cur.a[rr][j] + cur.bq[rr][j];
                float ss = (o[0] * o[0] + o[1] * o[1]) + (o[2] * o[2] + o[3] * o[3]);
                ss = half_wave_sum(ss);
                const float r = __builtin_amdgcn_rsqf(ss * (1.f / 128.f) + RMS_EPS);
                const f32x4 gn = *(const f32x4*)(ng + col);
                const float g0 = bflo(cur.g[rr][j].x), g1 = bfhi(cur.g[rr][j].x), g2 = bflo(cur.g[rr][j].y), g3 = bfhi(cur.g[rr][j].y);
                const float r0 = o[0] * r * gn[0] * siluf_(g0), r1 = o[1] * r * gn[1] * siluf_(g1), r2 = o[2] * r * gn[2] * siluf_(g2), r3 = o[3] * r * gn[3] * siluf_(g3);
                *(u32x2*)(HA + (size_t)row * D + col) = (u32x2){cvt_pk_bf16(r0, r1), cvt_pk_bf16(r2, r3)}; } }
        cur = nxt;
    }
}
}
#ifndef PROBE_KIND
#define PROBE_KIND 0
#endif
constexpr int probe_reps(int id) {
    const int k = (id >= 1 && id <= 64) ? (id - 1) % 16 : -1, layer = (id >= 1 && id <= 64) ? (id - 1) / 16 : -1;
    return (PROBE_KIND == 1 && (k == 8 || k == 9)) ? 2 : (PROBE_KIND == 2 && id == 0) ? 2 : (PROBE_KIND == 3 && layer == 3 && (k == 2 || k == 3)) ? 2 : (PROBE_KIND == 4 && layer == 1 && k == 3) ? 2 :
           (PROBE_KIND == 5 && layer == 0 && k == 1) ? 2 : (PROBE_KIND == 6 && k == 7) ? 2 : (PROBE_KIND == 8 && layer == 2 && k >= 1 && k <= 5) ? 2 : (PROBE_KIND == 9 && layer == 3 && k == 1) ? 2 : (PROBE_KIND == 11 && layer == 3 && k == 2) ? 2 : (PROBE_KIND == 17 && layer == 3 && k == 3) ? 2 : (PROBE_KIND == 18 && layer == 3 && k == 4) ? 2 : (PROBE_KIND == 19 && layer == 1 && k == 2) ? 2 : (PROBE_KIND == 20 && layer == 2 && k == 2) ? 2 : (PROBE_KIND == 21 && layer == 0 && k == 0) ? 2 : 1;
}
#define IN(id) (lo <= (id) && (id) < hi)
#define SEAM(id) do { if ((id) + 1 < hi) { xcd_barrier(bar); if (PROBE_KIND == 7) xcd_barrier(bar); } } while (0)
#define RUN(id, ...) do { if (IN(id)) { _Pragma("unroll") for (int rep_ = 0; rep_ < probe_reps(id); ++rep_) { F.lane = lane_now(); F.tid = F.wave * 64 + F.lane; __VA_ARGS__; SEAM(id); } } } while (0)
constexpr int FILL_PER_SLOT = 3;
template <int layer> __device__ __forceinline__ void layer_body(Frame& F, const int lo, const int hi, const XcdBarrier& bar) {
    unsigned char* const ws = F.ws; const char* wsm = (const char*)(ws + WS_WSM);
        constexpr int pb = 1 + 16 * layer;
        RUN(pb, rowpass(F, layer, 0));
        if constexpr (layer == 0) {
            RUN(pb + 1, {
                pg8::Gemm g{(const char*)(ws + WS_DFTL), (const char*)(ws + WS_H), SEQ / 2, SEQ / 2, SEQ / 2};
                {
                    const unsigned char* hT = ws + WS_H; bf16_t* C1 = (bf16_t*)(ws + WS_SCR + SC_C1);
                    for (int rowi = F.vcu * NWAVES + F.wave; rowi < NB * D; rowi += F.G * NWAVES) { float sgn = 0.f;
                        _Pragma("unroll") for (int q = 0; q < 4; ++q) { const u32x4 w4 = *(const u32x4*)(hT + (size_t)rowi * SEQ + F.lane * 64 + q * 16);
                            _Pragma("unroll") for (int d = 0; d < 4; ++d) { const int w = (int)w4[d]; const f32x2 lo = __builtin_amdgcn_cvt_pk_f32_fp8(w, false), hi = __builtin_amdgcn_cvt_pk_f32_fp8(w, true); sgn += (lo.x - lo.y) + (hi.x - hi.y); } }
                        sgn = wave_sum(sgn) * (1.0f / (S8_H * 64.0f));
                        if (F.lane == 0) { const int b = rowi >> 10, ch = rowi & 1023; bf16_t* o = C1 + (((size_t)b * SEQ + 2048) * 4 + (ch >> 8)) * 512 + (ch & 255); o[0] = f2bf(sgn); o[256] = f2bf(0.f); } } }
                pg8::Order<MapF1> S; S.init(16, 4, NB, F.G, F.vcu, MapF1{});
                EpiBf16 E{(bf16_t*)(ws + WS_SCR + SC_C1), 2048, 1.0f / (256.0f * S8_H * 64.0f)};
                pg8::gemm_phase<EpiBf16, pg8::Order<MapF1>, true>(F.lds, F.wave, g, S, E); });
            RUN(pb + 2, {
                pg8::Gemm g{(const char*)(ws + WS_SCR + SC_C1), (const char*)(ws + WS_SMALL + SM_DFTC), 512, 512, 512};
                pg8::Order<MapF2h> S; S.init(4 * 33, 1, 1, F.G, F.vcu, MapF2h{});
                EpiF2 E{(bf16_t*)(ws + WS_SCR + SC_MIX)};
                pg8::gemm_phase(F.lds, F.wave, g, S, E); });
            RUN(pb + 3, {
                pg8::Gemm g{(const char*)(ws + WS_SCR + SC_MIX), wsm + W_FNET, D, D, D};
                pg8::Order<MapPlain> S; S.init(64, 4, 1, F.G, F.vcu, MapPlain{D, D, D});
                EpiBf16B E{(bf16_t*)(ws + WS_Y), D, 1.f, F.in[7]};
                pg8::gemm_phase(F.lds, F.wave, g, S, E); });
        }
        if constexpr (layer == 1) {
            RUN(pb + 1, {
                LAS unsigned* cs2 = (LAS unsigned*)(F.lds + pg8::BIAS_LDS_OFF);
                for (int i = F.tid; i < 2048; i += NTHR) { const int pos = i >> 5, j = i & 31; const float inv = powf(10000.0f, -(float)(2 * j) / 64.0f); float sn_, cs_; sincosf((float)pos * inv, &sn_, &cs_); cs2[i] = cvt_pk_bf16(cs_, sn_); }
                __syncthreads();
                pg8::Gemm g{(const char*)(ws + WS_H), wsm + W_QKV, D / 2, 64, D / 2, 128, 32768};
                pg8::Order<MapPlain> S; S.init(64, 8, 1, F.G, F.vcu, MapPlain{D / 2, D / 2, QKVC});
                EpiQKV E{(bf16_t*)(ws + WS_SCR + SC_QKV), 1.0f / (S8_H * S8_WGU), F.in[9], F.in[10], cs2};
                pg8::gemm_phase<EpiQKV, pg8::Order<MapPlain>, true>(F.lds, F.wave, g, S, E); });
            RUN(pb + 3, attn_phase(F));
            RUN(pb + 4, {
                pg8::Gemm g{(const char*)(ws + WS_SCR + SC_O), wsm + W_AO, D, D, D};
                pg8::Order<MapPlain> S; S.init(64, 4, 1, F.G, F.vcu, MapPlain{D, D, D});
                EpiBf16 E{(bf16_t*)(ws + WS_Y), D};
                pg8::gemm_phase(F.lds, F.wave, g, S, E); });
        }
        if constexpr (layer == 2) {
            RUN(pb + 1, {
                pg8::Gemm g{(const char*)(ws + WS_SCR + SC_AOP), (const char*)(ws + WS_S5M), 512, 256, 256};
                pg8::Order<MapS5> S; S.init(4, 1, S5G, F.G, F.vcu, MapS5{256});
                EpiF32 E{(float*)(ws + WS_SCR + SC_SST), 256, nullptr};
                pg8::gemm_phase(F.lds, F.wave, g, S, E);
                VM_WAIT(); __syncthreads(); __builtin_amdgcn_fence(__ATOMIC_ACQUIRE, "agent"); VM_WAIT();
                { pg8::Unit uu; for (int i = 0; S.next(i, uu); ++i) s5_scan_unit(F, uu.z, uu.pm); } });
            RUN(pb + 3, {
                pg8::Gemm g{(const char*)(ws + WS_SCR + SC_AOP), (const char*)(ws + WS_S5T), 512, 512, 512};
                pg8::Order<MapS5> S; S.init(4, 1, S5G, F.G, F.vcu, MapS5{512});
                EpiS5Out E{(bf16_t*)(ws + WS_SCR + SC_YBF)};
                pg8::gemm_phase(F.lds, F.wave, g, S, E); });
            RUN(pb + 4, {
                pg8::Gemm g{(const char*)(ws + WS_SCR + SC_YBF), wsm + W_GLU, D, D, D};
                pg8::Order<MapPlain> S; S.init(64, 4, 1, F.G, F.vcu, MapPlain{D, D, D});
                EpiGlu E{(const bf16_t*)(ws + WS_SCR + SC_YBF), (bf16_t*)(ws + WS_SCR + SC_Z)};
                pg8::gemm_phase(F.lds, F.wave, g, S, E); });
            RUN(pb + 5, {
                pg8::Gemm g{(const char*)(ws + WS_SCR + SC_Z), wsm + W_SO, D, D, D};
                pg8::Order<MapPlain> S; S.init(64, 4, 1, F.G, F.vcu, MapPlain{D, D, D});
                EpiBf16 E{(bf16_t*)(ws + WS_Y), D};
                pg8::gemm_phase(F.lds, F.wave, g, S, E); });
        }
        if constexpr (layer == 3) {
            RUN(pb + 1, {
                pg8::Gemm g{(const char*)(ws + WS_H), wsm + W_HIN, D / 2, 64, D / 2, 128, 32768};
                pg8::Order<MapPlain> S; S.init(64, 20, 1, F.G, F.vcu, MapPlain{D / 2, D / 2, 5 * D});
                EpiBf16 E{(bf16_t*)(ws + WS_SCR + SC_P), 5 * D, 1.0f / (S8_H * S8_WGU)};
                pg8::gemm_phase<EpiBf16, pg8::Order<MapPlain>, true>(F.lds, F.wave, g, S, E); });
            RUN(pb + 2, hg::hgrn_prep(F));
            RUN(pb + 3, hg::hgrn_rec(F));
            RUN(pb + 4, hg::hgrn_combine(F));
            RUN(pb + 5, {
                pg8::Gemm g{(const char*)(ws + WS_SCR + SC_HA), wsm + W_HO, D, D, D};
                pg8::Order<MapPlain> S; S.init(64, 4, 1, F.G, F.vcu, MapPlain{D, D, D});
                EpiBf16 E{(bf16_t*)(ws + WS_Y), D};
                pg8::gemm_phase(F.lds, F.wave, g, S, E); });
        }
        RUN(pb + 6, rowpass(F, layer, 1));
        RUN(pb + 7, { moe_place(F); if (layer == DEPTH - 1) deferred_fill(F, -1); });
        RUN(pb + 8, {
            const int ntiles = load_tile_table(F); const LAS int* tile = (const LAS int*)(F.lds + TILE_LDS_OFF) - 1;
            pg8::Gemm g{(const char*)(ws + WS_H), (const char*)(ws + WS_WGU), D / 2, 64, D / 2, 128, 32768};
            pg8::Order<MapMoe> S; S.init(ntiles, 8, 1, F.G, F.vcu, MapMoe{tile + 1, (size_t)layer * NE * 2 * DEX * D, 2 * DEX, 0});
            LAS unsigned short* tbl = (LAS unsigned short*)(F.lds + ROWTBL_LDS_OFF);
            { const unsigned short* rowtok = (const unsigned short*)(ws + WS_ROUTE + RT_ROWTOK);
                int pms[ROWTBL_MAXU];
                _Pragma("unroll") for (int i = 0; i < ROWTBL_MAXU; ++i) { pg8::Unit uu; pms[i] = S.next(i, uu) ? uu.pm : -1; }
                if (F.tid < 256) { unsigned short vals[ROWTBL_MAXU];
                    _Pragma("unroll") for (int i = 0; i < ROWTBL_MAXU; ++i) vals[i] = (pms[i] >= 0) ? rowtok[pms[i] * 256 + F.tid] : (unsigned short)0;
                    _Pragma("unroll") for (int i = 0; i < ROWTBL_MAXU; ++i) tbl[i * 256 + F.tid] = vals[i]; }
                __syncthreads(); }
            EpiMoeGU E{ws + WS_SCR + SC_ACT, F.in[29] + (size_t)layer * NE * 2 * DEX};
            pg8::gemm_phase<EpiMoeGU, pg8::Order<MapMoe>, true, true>(F.lds, F.wave, g, S, E, tbl);
            if (layer < DEPTH - 1) { const int total = ntiles * 8, maxu = (total + F.G - 1) / F.G, mine = (F.vcu < total) ? (total - F.vcu + F.G - 1) / F.G : 0; deferred_fill(F, (maxu - mine) * FILL_PER_SLOT); }
            if (PROBE_KIND >= 13 && PROBE_KIND <= 15) { xcd_barrier(bar); EpiNull E0; S.mp.probe = PROBE_KIND - 13; pg8::gemm_phase<EpiNull, pg8::Order<MapMoe>, true, true>(F.lds, F.wave, g, S, E0, tbl); } });
        RUN(pb + 9, {
            const int ntiles = load_tile_table(F); const LAS int* tile = (const LAS int*)(F.lds + TILE_LDS_OFF) - 1;
            pg8::Gemm g{(const char*)(ws + WS_SCR + SC_ACT), (const char*)(ws + WS_WDN), 64, 64, DEX / 2, 32768, 32768};
            pg8::Order<MapMoe> S; S.init(ntiles, 4, 1, F.G, F.vcu, MapMoe{tile + 1, (size_t)layer * NE * D * DEX, D});
            EpiMoeDown E{ws + WS_SCR + SC_DNO, F.in[31] + (size_t)layer * NE * D};
            pg8::gemm_phase<EpiMoeDown, pg8::Order<MapMoe>, true>(F.lds, F.wave, g, S, E);
            if (layer < DEPTH - 1) { const int total = ntiles * 4, maxu = (total + F.G - 1) / F.G, mine = (F.vcu < total) ? (total - F.vcu + F.G - 1) / F.G : 0; deferred_fill(F, (maxu - mine) * FILL_PER_SLOT); }
            if (PROBE_KIND >= 13 && PROBE_KIND <= 15) { xcd_barrier(bar); EpiNull E0; S.mp.probe = PROBE_KIND - 13; pg8::gemm_phase<EpiNull, pg8::Order<MapMoe>, true>(F.lds, F.wave, g, S, E0); } });
}
constexpr int PH_END = 66;
__global__ void __launch_bounds__(NTHR, 2) fwd_kernel(Args args) {
    extern __shared__ __attribute__((aligned(16))) unsigned char lds_raw[];
    Frame F;
    F.lds = (LAS unsigned char*)lds_raw; F.ldsg = (char*)lds_raw;
    F.tid = threadIdx.x; F.lane = F.tid & 63; F.wave = __builtin_amdgcn_readfirstlane(F.tid >> 6);
    F.G = gridDim.x; { const int bx = blockIdx.x; F.vcu = (F.G % 8 == 0) ? (bx % 8) * (F.G / 8) + bx / 8 : bx; }
    F.in = args.in; F.out = args.out; F.ws = args.ws;
    volatile LAS unsigned* MISC = (volatile LAS unsigned*)(F.lds + MISC_OFF);
    for (int u = F.tid; u < (LDS_BYTES - LDSCTL_OFF) / 4; u += NTHR) ((LAS unsigned*)(F.lds + LDSCTL_OFF))[u] = 0u;
    __syncthreads();
    const int lo = args.ph_lo, hi = args.ph_hi;
    XcdBarrier bar; bar.bar = (unsigned*)(F.ws + WS_CTL) + 4096; bar.x = 0; bar.st = MISC + 8; bar.wave = F.wave;
    if (hi - lo > 1) bar = xcd_barrier_post((unsigned*)(F.ws + WS_CTL) + 4096, MISC + 8, F.wave);
    unsigned char* const ws = F.ws;
    const char* wsm = (const char*)(ws + WS_WSM);

    RUN(0, p0_prologue(F));

    layer_body<0>(F, lo, hi, bar); layer_body<1>(F, lo, hi, bar); layer_body<2>(F, lo, hi, bar); layer_body<3>(F, lo, hi, bar);
    if (IN(65)) { F.lane = lane_now(); F.tid = F.wave * 64 + F.lane; rowpass(F, DEPTH, 0); }
}

#ifndef MK_ONE_LAUNCH
#define MK_ONE_LAUNCH 1
#endif
extern "C" void kernel_launch(void* const* d_in, const int* in_sizes, int n_in, void* d_out, int out_size, void* d_ws, size_t ws_size, hipStream_t stream) {
    static int grid = 0;
    if (grid == 0) {
        if (n_in != 32 || out_size != NTOK * D || ws_size < WS_END) { fprintf(stderr, "kernel_launch: unexpected shapes (n_in %d out %d ws %zu, need ws >= %zu)\n", n_in, out_size, ws_size, (size_t)WS_END); grid = -1; return; }
        int dev = 0, cus = 0, per_cu = 0;
        if (hipGetDevice(&dev) != hipSuccess || hipDeviceGetAttribute(&cus, hipDeviceAttributeMultiprocessorCount, dev) != hipSuccess) { grid = -1; return; }
        if (hipFuncSetAttribute((const void*)fwd_kernel, hipFuncAttributeMaxDynamicSharedMemorySize, LDS_BYTES) != hipSuccess) { fprintf(stderr, "kernel_launch: hipFuncSetAttribute failed\n"); grid = -1; return; }
        if (hipOccupancyMaxActiveBlocksPerMultiprocessor(&per_cu, (const void*)fwd_kernel, NTHR, LDS_BYTES) != hipSuccess || per_cu < 1)
            fprintf(stderr, "kernel_launch: occupancy query reports %d blocks per CU\n", per_cu);
        (void)hipGetLastError();
        grid = cus;
    }
    if (grid < 0) return;
    (void)hipMemsetAsync((char*)d_ws + WS_CTL, 0, CTL_ZERO_BYTES, stream);
    Args a{};
    for (int i = 0; i < 32; ++i) a.in[i] = (const float*)d_in[i];
    a.out = (float*)d_out; a.ws = (unsigned char*)d_ws;
#if MK_ONE_LAUNCH
    a.ph_lo = 0; a.ph_hi = PH_END;
    hipLaunchKernelGGL(fwd_kernel, dim3(grid), dim3(NTHR), LDS_BYTES, stream, a);
#else
    static const int nmix[4] = {3, 4, 5, 5};
    int ids[80], n = 0; ids[n++] = 0;
    for (int l = 0; l < DEPTH; ++l) { const int pb = 1 + 16 * l; ids[n++] = pb; for (int k = 1; k <= nmix[l]; ++k) ids[n++] = pb + k; for (int k = 6; k <= 9; ++k) ids[n++] = pb + k; }
    ids[n++] = 65;
    for (int i = 0; i < n; ++i) { a.ph_lo = ids[i]; a.ph_hi = ids[i] + 1; hipLaunchKernelGGL(fwd_kernel, dim3(grid), dim3(NTHR), LDS_BYTES, stream, a); }
#endif
    const hipError_t le = hipPeekAtLastError();
    if (le != hipSuccess) fprintf(stderr, "kernel_launch: launch failed: %s\n", hipGetErrorName(le));
}
```

```cpp
#include <hip/hip_runtime.h>
#include <cstdio>
#include <cstdint>

#ifndef PROBE_KIND
#define PROBE_KIND 0
#endif
#define LAS __attribute__((address_space(3)))
#define GAS __attribute__((address_space(1)))
typedef unsigned short bf16_t;
typedef short bf16x8 __attribute__((ext_vector_type(8)));
typedef short s16x4 __attribute__((ext_vector_type(4)));
typedef float f32x2 __attribute__((ext_vector_type(2)));
typedef float f32x4 __attribute__((ext_vector_type(4)));
typedef float f32x8 __attribute__((ext_vector_type(8)));
typedef float f32x16 __attribute__((ext_vector_type(16)));
typedef unsigned u32x2 __attribute__((ext_vector_type(2)));
typedef unsigned u32x4 __attribute__((ext_vector_type(4)));

constexpr int D = 1024, NB = 4, SEQ = 4096, NTOK = NB * SEQ, DEPTH = 4;
constexpr int HQ = 8, HK = 4, DH = 128, QKVC = (HQ + 2 * HK) * DH;
constexpr int S5G = 64, S5C = 16, S5P = 64, S5T = 16, S5NCH = SEQ / S5T;
constexpr int HGH = 8, HGD = 128, HGC = 64, HGNCH = SEQ / HGC;
constexpr int NE = 32, TOPK = 4, DEX = 1024;
constexpr int CAP = NTOK * TOPK + NE * 256;
constexpr float LN_EPS = 1e-5f, RMS_EPS = 1e-6f;
constexpr float DN_ALPHA = 1.6817928305074290f;
constexpr int NWAVES = 8, NTHR = 512;
constexpr int ADA_PARTS = 2, ADA_KP = D / ADA_PARTS;

constexpr size_t MiB = 1u << 20;
constexpr size_t WS_CTL = 0, CTL_ZERO_BYTES = 64 * 1024;
constexpr size_t WS_MODP = 1 * MiB;
constexpr size_t WS_SMALL = 4 * MiB;
constexpr size_t   SM_LB = 0;
constexpr size_t   SM_AT = 8192;
constexpr size_t   SM_TILE = 131072;
constexpr size_t   SM_DFTC = 262144;
constexpr size_t WS_ROUTE = 5 * MiB;
constexpr size_t   RT_TOPI = 0, RT_TOPG = 262144, RT_DEST = 524288, RT_HIST = 786432, RT_ROWTOK = 851968;
constexpr size_t WS_WSM = 6 * MiB;
constexpr size_t   W_FNET = 0, W_QKV = 2 * MiB, W_AO = 6 * MiB, W_GLU = 8 * MiB, W_SO = 10 * MiB, W_HIN = 12 * MiB, W_HO = 22 * MiB;
constexpr size_t WS_S5M = 30 * MiB;
constexpr size_t WS_S5T = 38 * MiB;
constexpr size_t WS_DFTL = 54 * MiB;
constexpr size_t WS_WGU = 118 * MiB;
constexpr size_t WS_HGIMG = 374 * MiB;
constexpr size_t WS_WDN = 630 * MiB;
constexpr size_t WS_H = 886 * MiB;
constexpr size_t WS_Y = 918 * MiB;
constexpr size_t WS_SCR = 982 * MiB;
constexpr size_t   SC_DNO = 0, SC_BUF = 144 * MiB, SC_ACT = 216 * MiB;
constexpr size_t   SC_C1 = 0, SC_MIX = 64 * MiB;
constexpr size_t   SC_QKV = 0, SC_O = 64 * MiB;
constexpr size_t   SC_AOP = 144 * MiB, SC_SST = 208 * MiB, SC_YBF = 272 * MiB, SC_Z = 0;
constexpr size_t   SC_P = 0, SC_OFB = 160 * MiB, SC_HA = 288 * MiB;
constexpr size_t WS_X16 = 1302 * MiB;
constexpr size_t WS_END = 1334 * MiB;

typedef _Float16 h16x4 __attribute__((ext_vector_type(4)));
typedef _Float16 h16x8 __attribute__((ext_vector_type(8)));
constexpr int RING_BYTES = 131072, LDSCTL_OFF = RING_BYTES, MISC_OFF = LDSCTL_OFF + 320, LDS_BYTES = 147456;

#define RLX_AGENT __ATOMIC_RELAXED, __HIP_MEMORY_SCOPE_AGENT
#define LDS_WAIT() asm volatile("s_waitcnt lgkmcnt(0)" ::: "memory")
#define VM_WAIT() asm volatile("s_waitcnt vmcnt(0)" ::: "memory")
__device__ __forceinline__ unsigned cvt_pk_bf16(float lo, float hi) { unsigned r; asm volatile("v_cvt_pk_bf16_f32 %0, %1, %2" : "=v"(r) : "v"(lo), "v"(hi)); return r; }
__device__ __forceinline__ float bf2f(unsigned short b) { return __uint_as_float(((unsigned)b) << 16); }
__device__ __forceinline__ float bflo(unsigned w) { return __uint_as_float(w << 16); }
__device__ __forceinline__ float bfhi(unsigned w) { return __uint_as_float(w & 0xffff0000u); }
__device__ __forceinline__ unsigned short f2bf(float f) { unsigned u = __float_as_uint(f); return (unsigned short)((u + 0x7fffu + ((u >> 16) & 1u)) >> 16); }
__device__ __forceinline__ float wave_sum(float v) {
    v += __uint_as_float(__builtin_amdgcn_update_dpp(0, __float_as_uint(v), 0xB1, 0xF, 0xF, true));
    v += __uint_as_float(__builtin_amdgcn_update_dpp(0, __float_as_uint(v), 0x4E, 0xF, 0xF, true));
    v += __uint_as_float(__builtin_amdgcn_update_dpp(0, __float_as_uint(v), 0x141, 0xF, 0xF, true));
    v += __uint_as_float(__builtin_amdgcn_update_dpp(0, __float_as_uint(v), 0x140, 0xF, 0xF, true));
    { const auto r = __builtin_amdgcn_permlane16_swap(__float_as_uint(v), __float_as_uint(v), false, false); const float a = __uint_as_float(r[0]), b = __uint_as_float(r[1]); v = a + b; }
    { const auto r = __builtin_amdgcn_permlane32_swap(__float_as_uint(v), __float_as_uint(v), false, false); const float a = __uint_as_float(r[0]), b = __uint_as_float(r[1]); v = a + b; }
    return v;
}
__device__ __forceinline__ float half_wave_sum(float v) {
    v += __uint_as_float(__builtin_amdgcn_update_dpp(0, __float_as_uint(v), 0xB1, 0xF, 0xF, true));
    v += __uint_as_float(__builtin_amdgcn_update_dpp(0, __float_as_uint(v), 0x4E, 0xF, 0xF, true));
    v += __uint_as_float(__builtin_amdgcn_update_dpp(0, __float_as_uint(v), 0x141, 0xF, 0xF, true));
    v += __uint_as_float(__builtin_amdgcn_update_dpp(0, __float_as_uint(v), 0x140, 0xF, 0xF, true));
    { const auto r = __builtin_amdgcn_permlane16_swap(__float_as_uint(v), __float_as_uint(v), false, false); const float a = __uint_as_float(r[0]), b = __uint_as_float(r[1]); v = a + b; }
    return v;
}
__device__ __forceinline__ float frcp(float x) { return __builtin_amdgcn_rcpf(x); }
__device__ __forceinline__ float sigmoidf_(float x) { return frcp(1.f + __builtin_amdgcn_exp2f(x * -1.4426950408889634f)); }
__device__ __forceinline__ float siluf_(float x) { return x * sigmoidf_(x); }
__device__ __forceinline__ int lane_now() { int l; asm volatile("v_mbcnt_lo_u32_b32 %0, -1, 0\n\tv_mbcnt_hi_u32_b32 %0, -1, %0" : "=v"(l)); return l; }
__device__ __forceinline__ int tid_from(int wave) { return wave * 64 + lane_now(); }
#ifndef Q8_MODE
#define Q8_MODE 0
#endif
__device__ __forceinline__ float q8(float x, float s) { const int p = __builtin_amdgcn_cvt_pk_fp8_f32(x * s, x * s, 0, false); return __builtin_amdgcn_cvt_f32_fp8(p, 0) * (1.0f / s); }
constexpr float S8_H = 16.f, S8_WGU = 256.f, S8_ACT = 4.f, S8_WDN = 512.f, S8_Y = 32.f;
__device__ __forceinline__ float sat8(float a) { return __builtin_amdgcn_fmed3f(a, -448.f, 448.f); }
__device__ __forceinline__ unsigned pk4_fp8(float a, float b, float c, float d) { int w = __builtin_amdgcn_cvt_pk_fp8_f32(sat8(a), sat8(b), 0, false); w = __builtin_amdgcn_cvt_pk_fp8_f32(sat8(c), sat8(d), w, true); return (unsigned)w; }
namespace pg8 {
constexpr int BIAS_LDS_OFF = 131072 + 1024;
constexpr int BM = 256, BK = 64, HALF = 128, HTB = HALF * BK * 2, STAGE_BYTES = 8 * HTB, NXCD = 8, WGM = 8;
__host__ __device__ __forceinline__ int lds_byte(int r, int c) { const int st = (r >> 4) * 2 + (c >> 5), rr = r & 15, cc = c & 31, ob = rr * 64 + cc * 2; return st * 1024 + (ob ^ (((ob >> 9) & 1) << 5)); }
__host__ __device__ __forceinline__ void stage_rc(int b, int& R, int& C) { const int st = b / 1024, sb = b % 1024, swz = sb ^ (((sb >> 9) & 1) << 5); R = (st >> 1) * 16 + swz / 64; C = (st & 1) * 32 + (swz % 64) / 2; }
__host__ __device__ __forceinline__ int perm32(int rho) { const int n = rho >> 4, i = rho & 15; return 8 * (i >> 2) + 4 * n + (i & 3); }

struct Unit { int pm, pn, z; size_t aoff, boff, ooff; };
struct Gemm { const char* A; const char* Bt; int lda, ldb, K; int kstepA = 128, kstepB = 128; };

template <class Map> struct Order {
    int nM, nN, per, total, G, c; Map mp;
    __device__ void init(int nM_, int nN_, int nz, int G_, int c_, const Map& m) { nM = nM_; nN = nN_; per = nM * nN; total = per * nz; G = G_; c = c_; mp = m; }
    __device__ bool next(int i, Unit& u) const {
        const long L = (long)i * G + c; if (L >= total) return false;
        int id = (int)L; { const int q = total / NXCD, r = total % NXCD, xcd = id % NXCD, off = id / NXCD; id = (xcd < r ? xcd * (q + 1) : r * (q + 1) + (xcd - r) * q) + off; }
        const int z = id / per, w = id - z * per;
        const int nig = WGM * nN, gid = w / nig, fm = gid * WGM, gsz = (nM - fm) < WGM ? (nM - fm) : WGM;
        u.pm = fm + ((w % nig) % gsz); u.pn = (w % nig) / gsz; u.z = z; mp(u); return true;
    }
};

typedef int v4i_t __attribute__((ext_vector_type(4)));
typedef int v8i_t __attribute__((ext_vector_type(8)));
template <class Epi, class Sched, bool FP8 = false, bool AIND = false>
__device__ __forceinline__ void gemm_phase(LAS unsigned char* lds, const int wave, const Gemm g, const Sched& S, const Epi& E, const LAS unsigned short* tbl = nullptr) {
    const int wid = wave, lane = lane_now(), tid = wid * 64 + lane, wr = wid >> 2, wc = wid & 3, fr = lane & 15, fq = lane >> 4;
    const int K = g.K, nt = K / BK;
    unsigned voffA[2], voffB[2];
#pragma unroll
    for (int i = 0; i < 2; ++i) { int R, C; stage_rc(tid * 16 + i * 8192, R, C); const int Rb = Epi::PERM ? ((R & ~31) + perm32(R & 31)) : R;
        voffA[i] = (unsigned)(R * g.lda + C) * 2u; voffB[i] = (unsigned)(Rb * g.ldb + C) * 2u; }
    const size_t kstepA = (size_t)g.kstepA, kstepB = (size_t)g.kstepB;
    int aR[2], aC[2];
#pragma unroll
    for (int i = 0; i < 2; ++i) stage_rc(tid * 16 + i * 8192, aR[i], aC[i]);
    unsigned voA[2][2], vnA[2][2];
#define PG8_AOFFS(dst, ui_) do { _Pragma("unroll") for (int h_ = 0; h_ < 2; ++h_) _Pragma("unroll") for (int i_ = 0; i_ < 2; ++i_) dst[h_][i_] = (unsigned)tbl[(ui_) * 256 + h_ * 128 + aR[i_]] * 1024u + (unsigned)aC[i_] * 2u; } while (0)
#define PG8_STAGEA(bufoff, ptr, h, nx) do { if constexpr (AIND) { const unsigned vv_[2] = {(nx) ? vnA[h][0] : voA[h][0], (nx) ? vnA[h][1] : voA[h][1]}; PG8_STAGE(bufoff, ptr, vv_); } else PG8_STAGE(bufoff, (ptr) + (h) * hstepA, voffA); } while (0)
    const size_t hstepA = (size_t)HALF * g.lda * 2, hstepB = (size_t)HALF * g.ldb * 2;
    const unsigned ldsw = (unsigned)wid * 1024u;
    const int aoff = lds_byte(wr * 64 + fr, fq * 8), boff = lds_byte(wc * 32 + fr, fq * 8);
#define PG8_SA(b, h) (((b) * 2 + (h)) * HTB)
#define PG8_SB(b, h) ((4 + (b) * 2 + (h)) * HTB)
#define PG8_STAGE(bufoff, gbase, voff) do { _Pragma("unroll") for (int _i = 0; _i < 2; ++_i) \
        __builtin_amdgcn_global_load_lds((const unsigned*)((const char*)(gbase) + (voff)[_i]), (LAS unsigned*)(lds + (bufoff) + ldsw + _i * 8192), 16, 0, 0); } while (0)
#define PG8_LD8(base_) __builtin_shufflevector(*(const LAS v4i_t*)(base_), *(const LAS v4i_t*)((base_) + 1024), 0, 1, 2, 3, 4, 5, 6, 7)
#define PG8_LDA(dst, b, h) do { _Pragma("unroll") for (int m = 0; m < 4; ++m) dst[m] = PG8_LD8(lds + PG8_SA(b, h) + aoff + m * 2048); } while (0)
#define PG8_LDB(dst, b, h) do { _Pragma("unroll") for (int n = 0; n < 2; ++n) dst[n] = PG8_LD8(lds + PG8_SB(b, h) + boff + n * 2048); } while (0)
#define PG8_HALF(v, k) __builtin_bit_cast(bf16x8, (k) ? __builtin_shufflevector(v, v, 4, 5, 6, 7) : __builtin_shufflevector(v, v, 0, 1, 2, 3))
#define PG8_MMA(ai, bj, At, Bt) do { __builtin_amdgcn_s_setprio(1); \
        if constexpr (FP8) { _Pragma("unroll") for (int m = 0; m < 4; ++m) _Pragma("unroll") for (int n = 0; n < 2; ++n) \
            asm volatile("v_mfma_f32_16x16x128_f8f6f4 %0, %1, %2, %0" : "+v"(acc[ai][bj][m][n]) : "v"(Bt[n]), "v"(At[m])); } \
        else { _Pragma("unroll") for (int m = 0; m < 4; ++m) _Pragma("unroll") for (int n = 0; n < 2; ++n) _Pragma("unroll") for (int k = 0; k < 2; ++k) \
            acc[ai][bj][m][n] = __builtin_amdgcn_mfma_f32_16x16x32_bf16(PG8_HALF(Bt[n], k), PG8_HALF(At[m], k), acc[ai][bj][m][n], 0, 0, 0); } \
        __builtin_amdgcn_s_setprio(0); } while (0)
#define PG8_WAIT_V(n) asm volatile("s_waitcnt vmcnt(" #n ")" ::: "memory")
#define PG8_WAIT_L(n) asm volatile("s_waitcnt lgkmcnt(" #n ")" ::: "memory")
#define PG8_BAR __builtin_amdgcn_s_barrier()
#define PG8_SCHED __builtin_amdgcn_sched_barrier(0)
    Unit cur, nxt; int ui = 0;
    if (!S.next(0, cur)) return;
    f32x4 acc[2][2][4][2];
#pragma unroll
    for (int a = 0; a < 2; ++a)
#pragma unroll
        for (int b = 0; b < 2; ++b)
#pragma unroll
            for (int m = 0; m < 4; ++m)
#pragma unroll
                for (int n = 0; n < 2; ++n) acc[a][b][m][n] = (f32x4){0.f, 0.f, 0.f, 0.f};
    v8i_t At[4], B0[2], B1[2];
    const char* cA = g.A + cur.aoff; const char* cB = g.Bt + cur.boff;
    if constexpr (AIND) { PG8_AOFFS(voA, 0); }
    PG8_STAGE(PG8_SB(0, 0), cB, voffB); PG8_STAGE(PG8_SB(0, 1), cB + hstepB, voffB); PG8_STAGEA(PG8_SA(0, 0), cA, 0, false); PG8_STAGEA(PG8_SA(0, 1), cA, 1, false);
    if (wr == 1) PG8_BAR;
    PG8_WAIT_V(2); PG8_BAR;
    PG8_STAGE(PG8_SB(1, 0), cB + kstepB, voffB); PG8_STAGEA(PG8_SA(1, 0), cA + kstepA, 0, false); PG8_STAGE(PG8_SB(1, 1), cB + hstepB + kstepB, voffB);
    PG8_WAIT_V(6); PG8_BAR;
    for (;;) {
        const bool has_next = S.next(ui + 1, nxt);
        const char* nA = has_next ? g.A + nxt.aoff : cA; const char* nB = has_next ? g.Bt + nxt.boff : cB;
        if constexpr (AIND) { if (has_next) { PG8_AOFFS(vnA, ui + 1); } else { _Pragma("unroll") for (int h_ = 0; h_ < 2; ++h_) _Pragma("unroll") for (int i_ = 0; i_ < 2; ++i_) vnA[h_][i_] = voA[h_][i_]; } }
#pragma nounroll
        for (int t = 0; t < nt; t += 2) {
            const bool last = (t == nt - 2);
            const char* a1 = cA + (size_t)(t + 1) * kstepA;
            const char* a2 = last ? nA : cA + (size_t)(t + 2) * kstepA; const char* b2 = last ? nB : cB + (size_t)(t + 2) * kstepB;
            const char* a3 = a2 + kstepA; const char* b3 = b2 + kstepB;
            if constexpr (Epi::BIAS_LDS) { if (last) __builtin_amdgcn_global_load_lds((const unsigned*)E.bias_ptr(cur, lane), (LAS unsigned*)(lds + BIAS_LDS_OFF + wid * 1024), 16, 0, 0); }
            PG8_LDB(B0, 0, 0); PG8_LDB(B1, 0, 1); PG8_SCHED; PG8_LDA(At, 0, 0); PG8_STAGEA(PG8_SA(1, 1), a1, 1, false);
            PG8_WAIT_V(8); PG8_WAIT_L(0); PG8_BAR; PG8_MMA(0, 0, At, B0); PG8_MMA(0, 1, At, B1); PG8_BAR; PG8_SCHED;
            PG8_LDA(At, 0, 1); PG8_STAGE(PG8_SB(0, 0), b2, voffB); PG8_STAGE(PG8_SB(0, 1), b2 + hstepB, voffB); PG8_STAGEA(PG8_SA(0, 0), a2, 0, last);
            PG8_WAIT_V(8); PG8_WAIT_L(0); PG8_BAR; PG8_MMA(1, 0, At, B0); PG8_MMA(1, 1, At, B1); PG8_BAR; PG8_SCHED;
            PG8_LDB(B0, 1, 0); PG8_LDB(B1, 1, 1); PG8_SCHED; PG8_LDA(At, 1, 0); PG8_STAGEA(PG8_SA(0, 1), a2, 1, last);
            PG8_WAIT_V(8); PG8_WAIT_L(0); PG8_BAR; PG8_MMA(0, 0, At, B0); PG8_MMA(0, 1, At, B1); PG8_BAR; PG8_SCHED;
            PG8_LDA(At, 1, 1); PG8_STAGE(PG8_SB(1, 0), b3, voffB); PG8_STAGE(PG8_SB(1, 1), b3 + hstepB, voffB); PG8_STAGEA(PG8_SA(1, 0), a3, 0, last);
            PG8_WAIT_V(8); PG8_WAIT_L(0); PG8_BAR; PG8_MMA(1, 0, At, B0); PG8_MMA(1, 1, At, B1); PG8_BAR; PG8_SCHED;
        }
        if (wr == 0) PG8_BAR;
        if constexpr (FP8) asm volatile("s_nop 15\n\ts_nop 15" ::: "memory");
        { const int t2_ = lane_now(), fr_ = t2_ & 15, fq_ = (t2_ >> 4) & 3; const LAS float* bl_ = (const LAS float*)(lds + BIAS_LDS_OFF + wid * 1024); E(acc, cur, wr, wc, fr_, fq_, bl_);
#if defined(PROBE_KIND)
          if (PROBE_KIND == 12) { asm volatile("" ::: "memory"); E(acc, cur, wr, wc, fr_, fq_, bl_); }
#endif
        }
        if (!has_next) break;
#pragma unroll
        for (int a = 0; a < 2; ++a)
#pragma unroll
            for (int b = 0; b < 2; ++b)
#pragma unroll
                for (int m = 0; m < 4; ++m)
#pragma unroll
                    for (int n = 0; n < 2; ++n) acc[a][b][m][n] = (f32x4){0.f, 0.f, 0.f, 0.f};
        cur = nxt; cA = nA; cB = nB; ++ui;
        if constexpr (AIND) { _Pragma("unroll") for (int h_ = 0; h_ < 2; ++h_) _Pragma("unroll") for (int i_ = 0; i_ < 2; ++i_) voA[h_][i_] = vnA[h_][i_]; }
        if (wr == 1) PG8_BAR;
    }
    PG8_WAIT_V(0);
    PG8_BAR;
#undef PG8_SA
#undef PG8_SB
#undef PG8_STAGE
#undef PG8_STAGEA
#undef PG8_AOFFS
#undef PG8_LDA
#undef PG8_LD8
#undef PG8_HALF
#undef PG8_LDB
#undef PG8_MMA
#undef PG8_WAIT_V
#undef PG8_WAIT_L
#undef PG8_BAR
#undef PG8_SCHED
}

__device__ __forceinline__ u32x4 pack8(const f32x4& v0, const f32x4& v1) { u32x4 w; w.x = cvt_pk_bf16(v0[0], v0[1]); w.y = cvt_pk_bf16(v0[2], v0[3]); w.z = cvt_pk_bf16(v1[0], v1[1]); w.w = cvt_pk_bf16(v1[2], v1[3]); return w; }
}
using pg8::Unit;
typedef f32x4 AccT[2][2][4][2];

template <bool HAS_BIAS> struct EpiBf16T {
    static constexpr bool PERM = true, BIAS_LDS = HAS_BIAS;
    bf16_t* O; int ldc; float scale = 1.f; const float* bias = nullptr;
    __device__ __forceinline__ const float* bias_ptr(const Unit& u, int lane) const { return bias + u.pn * 256 + 4 * lane; }
    __device__ __forceinline__ void operator()(const AccT& acc, const Unit& u, int wr, int wc, int fr, int fq, const LAS float* bl) const {
        bf16_t* base = O + u.ooff + (size_t)(wr * 64 + fr) * ldc + wc * 32 + 8 * fq;
        f32x4 b0[2], b1[2];
#pragma unroll
        for (int bj = 0; bj < 2; ++bj) { b0[bj] = HAS_BIAS ? *(const LAS f32x4*)(bl + bj * 128 + wc * 32 + 8 * fq) : (f32x4){0.f, 0.f, 0.f, 0.f}; b1[bj] = HAS_BIAS ? *(const LAS f32x4*)(bl + bj * 128 + wc * 32 + 8 * fq + 4) : (f32x4){0.f, 0.f, 0.f, 0.f}; }
#pragma unroll
        for (int ai = 0; ai < 2; ++ai)
#pragma unroll
            for (int m = 0; m < 4; ++m) { bf16_t* rowp = base + (size_t)(ai * 128 + m * 16) * ldc;
#pragma unroll
                for (int bj = 0; bj < 2; ++bj) *(u32x4*)(rowp + bj * 128) = pg8::pack8(acc[ai][bj][m][0] * scale + b0[bj], acc[ai][bj][m][1] * scale + b1[bj]); }
    }
};
typedef EpiBf16T<false> EpiBf16;
typedef EpiBf16T<true> EpiBf16B;
template <bool HAS_BIAS> struct EpiF32T {
    static constexpr bool PERM = false, BIAS_LDS = HAS_BIAS;
    float* C; int ldc; const float* bias;
    __device__ __forceinline__ const float* bias_ptr(const Unit& u, int lane) const { return bias + u.pn * 256 + 4 * lane; }
    __device__ __forceinline__ void operator()(const AccT& acc, const Unit& u, int wr, int wc, int fr, int fq, const LAS float* bl) const {
        const int col0 = wc * 32 + 4 * fq;
        f32x4 bv[2][2];
#pragma unroll
        for (int bj = 0; bj < 2; ++bj)
#pragma unroll
            for (int n = 0; n < 2; ++n) bv[bj][n] = HAS_BIAS ? *(const LAS f32x4*)(bl + col0 + bj * 128 + n * 16) : (f32x4){0.f, 0.f, 0.f, 0.f};
        float* base = C + u.ooff + (size_t)(wr * 64 + fr) * ldc + col0;
#pragma unroll
        for (int ai = 0; ai < 2; ++ai)
#pragma unroll
            for (int m = 0; m < 4; ++m) { float* rowp = base + (size_t)(ai * 128 + m * 16) * ldc;
#pragma unroll
                for (int bj = 0; bj < 2; ++bj)
#pragma unroll
                    for (int n = 0; n < 2; ++n) *(f32x4*)(rowp + bj * 128 + n * 16) = acc[ai][bj][m][n] + bv[bj][n]; }
    }
};
typedef EpiF32T<false> EpiF32;
typedef EpiF32T<true> EpiF32B;
__device__ __forceinline__ float gelu_tanh(float x) {
    const float u = 0.7978845608028654f * (x + 0.044715f * x * x * x);
    const float t = 1.f - 2.f * frcp(1.f + __builtin_amdgcn_exp2f(u * 2.8853900817779268f));
    return 0.5f * x * (1.f + t);
}
struct EpiS5Out {
    static constexpr bool PERM = true, BIAS_LDS = false;
    bf16_t* O;
    __device__ __forceinline__ void operator()(const AccT& acc, const Unit& u, int wr, int wc, int fr, int fq, const LAS float* bl) const {
        const int g = u.z, b = u.pm;
#pragma unroll
        for (int ai = 0; ai < 2; ++ai)
#pragma unroll
            for (int m = 0; m < 4; ++m) { const int j = ai * 128 + wr * 64 + m * 16 + fr;
#pragma unroll
                for (int bj = 0; bj < 2; ++bj) { const int col = bj * 128 + wc * 32 + 8 * fq, t = col >> 4, c8 = col & 15;
                    f32x4 v0 = acc[ai][bj][m][0], v1 = acc[ai][bj][m][1];
#pragma unroll
                    for (int i = 0; i < 4; ++i) { v0[i] = gelu_tanh(v0[i]); v1[i] = gelu_tanh(v1[i]); }
                    *(u32x4*)(O + ((size_t)(b * SEQ + j * 16 + t)) * D + g * 16 + c8) = pg8::pack8(v0, v1); } }
    }
};
struct EpiGlu {
    static constexpr bool PERM = true, BIAS_LDS = false;
    const bf16_t* Yb; bf16_t* Z;
    __device__ __forceinline__ void operator()(const AccT& acc, const Unit& u, int wr, int wc, int fr, int fq, const LAS float* bl) const {
        const size_t base = u.ooff + (size_t)(wr * 64 + fr) * D + wc * 32 + 8 * fq;
#pragma unroll
        for (int ai = 0; ai < 2; ++ai)
#pragma unroll
            for (int m = 0; m < 4; ++m) {
#pragma unroll
                for (int bj = 0; bj < 2; ++bj) { const size_t off = base + (size_t)(ai * 128 + m * 16) * D + bj * 128;
                    const u32x4 yw = *(const u32x4*)(Yb + off);
                    f32x4 v0 = acc[ai][bj][m][0], v1 = acc[ai][bj][m][1];
                    v0[0] = bflo(yw.x) * sigmoidf_(v0[0]); v0[1] = bfhi(yw.x) * sigmoidf_(v0[1]); v0[2] = bflo(yw.y) * sigmoidf_(v0[2]); v0[3] = bfhi(yw.y) * sigmoidf_(v0[3]);
                    v1[0] = bflo(yw.z) * sigmoidf_(v1[0]); v1[1] = bfhi(yw.z) * sigmoidf_(v1[1]); v1[2] = bflo(yw.w) * sigmoidf_(v1[2]); v1[3] = bfhi(yw.w) * sigmoidf_(v1[3]);
                    *(u32x4*)(Z + off) = pg8::pack8(v0, v1); } }
    }
};
struct EpiMoeGU {
    static constexpr bool PERM = true, BIAS_LDS = true;
    __device__ __forceinline__ const float* bias_ptr(const Unit& u, int lane) const { return bgu + (size_t)u.z * 2048 + u.pn * 128 + (lane < 32 ? 4 * lane : 1024 + 4 * (lane - 32)); }
    unsigned char* ACT; const float* bgu;
    __device__ __forceinline__ void operator()(const AccT& acc, const Unit& u, int wr, int wc, int fr, int fq, const LAS float* bl) const {
        const int f0 = u.pn * 128 + wc * 32 + 8 * fq;
        const LAS float* bg = bl + wc * 32 + 8 * fq;
        const f32x4 bg0 = *(const LAS f32x4*)bg, bg1 = *(const LAS f32x4*)(bg + 4), bu0 = *(const LAS f32x4*)(bg + 128) + 1.f, bu1 = *(const LAS f32x4*)(bg + 132) + 1.f;
        unsigned char* base = ACT + (size_t)u.pm * 262144 + (size_t)u.pn * 32768 + (wr * 64 + fr) * 128 + wc * 32 + 8 * fq;
        constexpr float SC = 1.0f / (S8_H * S8_WGU), C1 = -1.702f * 1.4426950408889634f, Q = 1.0f / S8_ACT;
#define GU1(G, U) do { const float ga_ = fminf((G), 7.f), up1_ = __builtin_amdgcn_fmed3f((U), -6.f, 8.f), e_ = __builtin_amdgcn_exp2f(ga_ * C1); (G) = (ga_ * up1_) * frcp(__builtin_fmaf(e_, Q, Q)); } while (0)
#pragma unroll
        for (int ai = 0; ai < 2; ++ai)
#pragma unroll
            for (int m = 0; m < 4; ++m) {
                f32x4 g0 = acc[ai][0][m][0] * SC + bg0, g1 = acc[ai][0][m][1] * SC + bg1, u0 = acc[ai][1][m][0] * SC + bu0, u1 = acc[ai][1][m][1] * SC + bu1;
#pragma unroll
                for (int i = 0; i < 4; ++i) { GU1(g0[i], u0[i]); GU1(g1[i], u1[i]); }
                int w0 = __builtin_amdgcn_cvt_pk_fp8_f32(g0[0], g0[1], 0, false); w0 = __builtin_amdgcn_cvt_pk_fp8_f32(g0[2], g0[3], w0, true);
                int w1 = __builtin_amdgcn_cvt_pk_fp8_f32(g1[0], g1[1], 0, false); w1 = __builtin_amdgcn_cvt_pk_fp8_f32(g1[2], g1[3], w1, true);
                *(u32x2*)(base + (ai * 128 + m * 16) * 128) = (u32x2){(unsigned)w0, (unsigned)w1}; }
#undef GU1
    }
};
struct EpiMoeDown {
    static constexpr bool PERM = true, BIAS_LDS = true;
    __device__ __forceinline__ const float* bias_ptr(const Unit& u, int lane) const { return bdn + (size_t)u.z * 1024 + u.pn * 256 + 4 * lane; }
    unsigned char* YB; const float* bdn;
    __device__ __forceinline__ void operator()(const AccT& acc, const Unit& u, int wr, int wc, int fr, int fq, const LAS float* bl) const {
        const int c0 = u.pn * 256 + wc * 32 + 8 * fq;
        const LAS float* bp = bl + wc * 32 + 8 * fq;
        f32x4 b0[2], b1[2];
#pragma unroll
        for (int bj = 0; bj < 2; ++bj) { b0[bj] = *(const LAS f32x4*)(bp + bj * 128) * S8_Y; b1[bj] = *(const LAS f32x4*)(bp + bj * 128 + 4) * S8_Y; }
        unsigned char* base = YB + (size_t)(u.pm * 256 + wr * 64 + fr) * D + c0;
        constexpr float SC = S8_Y / (S8_ACT * S8_WDN);
#pragma unroll
        for (int ai = 0; ai < 2; ++ai)
#pragma unroll
            for (int m = 0; m < 4; ++m) { unsigned char* rowp = base + (size_t)(ai * 128 + m * 16) * D;
#pragma unroll
                for (int bj = 0; bj < 2; ++bj) { const f32x4 v0 = acc[ai][bj][m][0] * SC + b0[bj], v1 = acc[ai][bj][m][1] * SC + b1[bj];
                    *(u32x2*)(rowp + bj * 128) = (u32x2){pk4_fp8(v0[0], v0[1], v0[2], v0[3]), pk4_fp8(v1[0], v1[1], v1[2], v1[3])}; } }
    }
};

struct EpiQKV {
    static constexpr bool PERM = true, BIAS_LDS = false;
    bf16_t* O; float scale; const float* qg; const float* kg; const LAS unsigned* cs2;
    __device__ __forceinline__ void operator()(const AccT& acc, const Unit& u, int wr, int wc, int fr, int fq, const LAS float* bl) const {
        bf16_t* base = O + u.ooff + (size_t)(wr * 64 + fr) * QKVC + wc * 32 + 8 * fq;
#pragma unroll
        for (int ai = 0; ai < 2; ++ai)
#pragma unroll
            for (int m = 0; m < 4; ++m) { bf16_t* rowp = base + (size_t)(ai * 128 + m * 16) * QKVC;
#pragma unroll
                for (int bj = 0; bj < 2; ++bj) *(u32x4*)(rowp + bj * 128) = pg8::pack8(acc[ai][bj][m][0] * scale, acc[ai][bj][m][1] * scale); }
        if (u.pn >= 6) return;
        asm volatile("s_waitcnt vmcnt(0)" ::: "memory");
        __builtin_amdgcn_s_barrier();
        __builtin_amdgcn_fence(__ATOMIC_ACQUIRE, "agent"); asm volatile("s_waitcnt vmcnt(0)" ::: "memory");
        const int lane = lane_now(), w = wr * 4 + wc, hd = lane >> 5, lp = lane & 31, hs = lp >> 4, i2 = (lp & 15) * 2;
        const float* gn = (u.pn < 4) ? qg : kg;
        const float ga0 = gn[hs * 64 + i2], ga1 = gn[hs * 64 + i2 + 1], gb0 = gn[hs * 64 + 32 + i2], gb1 = gn[hs * 64 + 32 + i2 + 1];
        bf16_t* tp = O + u.ooff + (size_t)(32 * w) * QKVC + hd * 128 + hs * 64 + i2;
        const int row0 = u.pm * 256 + 32 * w;
#pragma unroll 1
        for (int rb8 = 0; rb8 < 32; rb8 += 8) { unsigned xa[8], xb[8];
#pragma unroll
            for (int q = 0; q < 8; ++q) { const bf16_t* p = tp + (size_t)(rb8 + q) * QKVC; xa[q] = *(const unsigned*)p; xb[q] = *(const unsigned*)(p + 32); }
#pragma unroll
            for (int q = 0; q < 8; ++q) { const int l = (row0 + rb8 + q) & (SEQ - 1), pos = hs ? (l & 63) : (l >> 6);
                const float a0 = bflo(xa[q]), a1 = bfhi(xa[q]), b0 = bflo(xb[q]), b1 = bfhi(xb[q]);
                const float ss = half_wave_sum((a0 * a0 + a1 * a1) + (b0 * b0 + b1 * b1)), r = __builtin_amdgcn_rsqf(ss * (1.f / 128.f) + RMS_EPS);
                const unsigned c0 = cs2[pos * 32 + i2], c1 = cs2[pos * 32 + i2 + 1];
                const float ya0 = a0 * r * ga0, ya1 = a1 * r * ga1, yb0 = b0 * r * gb0, yb1 = b1 * r * gb1;
                bf16_t* p = tp + (size_t)(rb8 + q) * QKVC;
                *(unsigned*)p = cvt_pk_bf16(ya0 * bflo(c0) - yb0 * bfhi(c0), ya1 * bflo(c1) - yb1 * bfhi(c1));
                *(unsigned*)(p + 32) = cvt_pk_bf16(yb0 * bflo(c0) + ya0 * bfhi(c0), yb1 * bflo(c1) + ya1 * bfhi(c1)); } }
    }
};

struct EpiNull {
    static constexpr bool PERM = true, BIAS_LDS = false;
    __device__ __forceinline__ void operator()(const AccT& acc, const Unit& u, int wr, int wc, int fr, int fq, const LAS float* bl) const {}
};

struct MapPlain {
    int lda, ldb, ldc;
    __device__ __forceinline__ void operator()(Unit& u) const { u.aoff = (size_t)u.pm * 256 * lda * 2; u.boff = (size_t)u.pn * 256 * ldb * 2; u.ooff = (size_t)u.pm * 256 * ldc + u.pn * 256; }
};
struct MapF1 {
    __device__ __forceinline__ void operator()(Unit& u) const { u.aoff = ((size_t)(u.pm >> 3) * 4096 + (u.pm & 7) * 256) * SEQ; u.boff = ((size_t)u.z * D + u.pn * 256) * SEQ;
        u.ooff = (((size_t)u.z * SEQ + (u.pm & 7) * 256) * 4 + u.pn) * 512 + (u.pm >> 3) * 256; }
};
struct MapF2h {
    __device__ __forceinline__ void operator()(Unit& u) const { const int b = u.pm / 33, t = u.pm - b * 33; const size_t row0 = (size_t)b * 16384 + 256 * t; u.aoff = row0 * 512 * 2; u.boff = 0; u.ooff = row0 * 256; u.z = t; }
};
struct EpiF2 {
    static constexpr bool PERM = true, BIAS_LDS = false;
    bf16_t* O;
    __device__ __forceinline__ const float* bias_ptr(const Unit& u, int lane) const { return nullptr; }
    __device__ __forceinline__ void operator()(const AccT& acc, const Unit& u, int wr, int wc, int fr, int fq, const LAS float* bl) const {
        const int c0 = wc * 32 + 8 * fq;
#pragma unroll
        for (int ai = 0; ai < 2; ++ai)
#pragma unroll
            for (int m = 0; m < 4; ++m) { const int r = ai * 128 + wr * 64 + m * 16 + fr, lq = u.z * 64 + (r >> 2);
                if (lq <= 2048) { bf16_t* rowp = O + u.ooff + (size_t)r * 256; bf16_t* mir = rowp + (size_t)(4096 - 2 * lq) * 1024; const bool hasm = lq > 0 && lq < 2048;
#pragma unroll
                    for (int bj = 0; bj < 2; ++bj) { const int cb = bj * 128 + c0; const u32x4 w = pg8::pack8(acc[ai][bj][m][0], acc[ai][bj][m][1]);
                        *(u32x4*)(rowp + cb) = w;
                        if (hasm) { unsigned short* mp = (unsigned short*)mir;
                            mp[(256 - cb) & 255] = (unsigned short)(w.x & 0xffffu);
                            mp[249 - cb] = (unsigned short)(w.w >> 16);
                            *(unsigned*)(mp + 250 - cb) = (w.w & 0xffffu) | (w.z & 0xffff0000u);
                            *(unsigned*)(mp + 252 - cb) = (w.z & 0xffffu) | (w.y & 0xffff0000u);
                            *(unsigned*)(mp + 254 - cb) = (w.y & 0xffffu) | (w.x & 0xffff0000u); } } } }
    }
};
struct MapS5 {
    int ldb;
    __device__ __forceinline__ void operator()(Unit& u) const { u.aoff = ((size_t)u.z * 1024 + u.pm * 256) * 512 * 2; u.boff = (size_t)u.z * 256 * ldb * 2; u.ooff = ((size_t)u.z * 1024 + u.pm * 256) * 256; }
};
struct MapMoe {
    const LAS int* tile_e; size_t wbase; int nrows; int a_tiled = 1; int probe = 0;
    __device__ __forceinline__ void operator()(Unit& u) const { const int e = __builtin_amdgcn_readfirstlane(tile_e[u.pm]); u.z = e; u.aoff = a_tiled ? (size_t)u.pm * 256 * 1024 : 0; u.boff = wbase + ((size_t)e * nrows + u.pn * 256) * 1024; u.ooff = 0;
        if (probe == 1) u.boff = wbase; }
};
constexpr int TILE_LDS_OFF = 131072 + 1024 + 8192;
constexpr int ROWTBL_LDS_OFF = TILE_LDS_OFF + 1280, ROWTBL_MAXU = 10;
static_assert(ROWTBL_LDS_OFF + ROWTBL_MAXU * 512 <= LDS_BYTES, "LDS map");
namespace att {
constexpr int NW = 8, QBLK = 32, KVBLK = 64;
constexpr float SCALE = 0.088388347648318440f;
constexpr float THR = 8.f;
constexpr int LDQ = QKVC, LDK = QKVC, LDO = D;
constexpr size_t SHM_V = KVBLK * DH * 2, SHM_K = KVBLK * DH * 2, SHM_ATTN = 2 * SHM_V + 2 * SHM_K + NW * 64 * 4;
#define KSWZ(row, colB) ((row) * 256 + ((colB) ^ (((row) & 7) << 4)))
#define SBAR() __builtin_amdgcn_sched_barrier(0)
__device__ __forceinline__ int crow(int r, int hi) { return (r & 3) + 8 * (r >> 2) + 4 * hi; }
__device__ __forceinline__ void partialSM(f32x16& p0, f32x16& p1, float& m_reg, float& mn, float& alpha) {
  constexpr float C = SCALE * 1.4426950408889634f;
  float pmax = p0[0]; for (int r = 1; r < 16; ++r) pmax = fmaxf(pmax, p0[r]); for (int r = 0; r < 16; ++r) pmax = fmaxf(pmax, p1[r]);
  { auto rr = __builtin_amdgcn_permlane32_swap(__float_as_uint(pmax), __float_as_uint(pmax), false, false);
    pmax = fmaxf(__uint_as_float(rr[0]), __uint_as_float(rr[1])); }
  if (__builtin_expect(__all(pmax - m_reg <= THR / SCALE), 1)) { mn = m_reg; alpha = 1.f; }
  else { mn = fmaxf(m_reg, pmax); alpha = __builtin_amdgcn_exp2f((m_reg - mn) * C); m_reg = mn; }
  float mnC = -mn * C;
  for (int r = 0; r < 16; ++r) p0[r] = fmaf(p0[r], C, mnC); for (int r = 0; r < 16; ++r) p1[r] = fmaf(p1[r], C, mnC);
  for (int r = 0; r < 16; ++r) p0[r] = __builtin_amdgcn_exp2f(p0[r]);
}
__device__ __forceinline__ void finishSM(f32x16& p0, f32x16& p1, float alpha, float& l_reg, bf16x8& pa0, bf16x8& pa1, bf16x8& pa2, bf16x8& pa3) {
  for (int r = 0; r < 16; ++r) p1[r] = __builtin_amdgcn_exp2f(p1[r]);
  float ps = 0; for (int r = 0; r < 16; ++r) ps += p0[r]; for (int r = 0; r < 16; ++r) ps += p1[r];
  { auto rr = __builtin_amdgcn_permlane32_swap(__float_as_uint(ps), __float_as_uint(ps), false, false);
    ps = __uint_as_float(rr[0]) + __uint_as_float(rr[1]); }
  l_reg = l_reg * alpha + ps;
#define PK4(P, BASE, OUT) do { unsigned a0 = cvt_pk_bf16(P[BASE + 0], P[BASE + 1]), a1 = cvt_pk_bf16(P[BASE + 2], P[BASE + 3]);   \
    unsigned b0 = cvt_pk_bf16(P[BASE + 4], P[BASE + 5]), b1 = cvt_pk_bf16(P[BASE + 6], P[BASE + 7]);                              \
    auto r0 = __builtin_amdgcn_permlane32_swap(a0, b0, false, false); auto r1 = __builtin_amdgcn_permlane32_swap(a1, b1, false, false); \
    u32x4 w = {r0[0], r1[0], r0[1], r1[1]}; OUT = *reinterpret_cast<bf16x8*>(&w); } while (0)
  PK4(p0, 0, pa0); PK4(p0, 8, pa1); PK4(p1, 0, pa2); PK4(p1, 8, pa3);
#undef PK4
}
__device__ __forceinline__ void qkt(f32x16& p0, f32x16& p1, const bf16_t* Ks, const bf16x8* qr, int r32, int hi) {
  p0 = f32x16{}; p1 = f32x16{};
  for (int d0 = 0; d0 < 8; ++d0) { int cb = (d0 * 16 + hi * 8) * 2;
    bf16x8 b0 = *reinterpret_cast<const bf16x8*>((const char*)Ks + KSWZ(r32, cb));
    bf16x8 b1 = *reinterpret_cast<const bf16x8*>((const char*)Ks + KSWZ(32 + r32, cb));
    p0 = __builtin_amdgcn_mfma_f32_32x32x16_bf16(b0, qr[d0], p0, 0, 0, 0);
    p1 = __builtin_amdgcn_mfma_f32_32x32x16_bf16(b1, qr[d0], p1, 0, 0, 0); }
}
__device__ __forceinline__ int v_st(int k, int c) { const int kk = (k & ~0xC) | ((k & 4) << 1) | ((k & 8) >> 1); return ((kk >> 3) * 4 + (c >> 5)) * 512 + ((kk & 7) * 32 + (c & 31)) * 2; }
__device__ __forceinline__ int v_rd_base(int lane) { return ((lane & 3) << 3) | (((lane >> 2) & 3) << 6) | (((lane >> 4) & 1) << 5) | (((lane >> 5) & 1) << 8); }
constexpr int v_rd_off(int d0, int ks, int half) { return d0 * 512 + ks * 4096 + half * 2048; }
template <int OFF> __device__ __forceinline__ s16x4 tr_read(int vb) {
  s16x4 r; asm volatile("ds_read_b64_tr_b16 %0, %1 offset:%2" : "=&v"(r) : "v"(vb), "i"(OFF) : "memory"); return r;
}
template <int D0> __device__ __forceinline__ void pv_one(f32x16& od, int vb, bf16x8 pa0, bf16x8 pa1, bf16x8 pa2, bf16x8 pa3) {
  const s16x4 l0 = tr_read<v_rd_off(D0, 0, 0)>(vb), h0 = tr_read<v_rd_off(D0, 0, 1)>(vb), l1 = tr_read<v_rd_off(D0, 1, 0)>(vb), h1 = tr_read<v_rd_off(D0, 1, 1)>(vb);
  const s16x4 l2 = tr_read<v_rd_off(D0, 2, 0)>(vb), h2 = tr_read<v_rd_off(D0, 2, 1)>(vb), l3 = tr_read<v_rd_off(D0, 3, 0)>(vb), h3 = tr_read<v_rd_off(D0, 3, 1)>(vb);
  asm volatile("s_waitcnt lgkmcnt(0)" ::: "memory"); SBAR();
#define PK(L, H) (bf16x8){L[0], L[1], L[2], L[3], H[0], H[1], H[2], H[3]}
  od = __builtin_amdgcn_mfma_f32_32x32x16_bf16(pa0, PK(l0, h0), od, 0, 0, 0);
  od = __builtin_amdgcn_mfma_f32_32x32x16_bf16(pa1, PK(l1, h1), od, 0, 0, 0);
  od = __builtin_amdgcn_mfma_f32_32x32x16_bf16(pa2, PK(l2, h2), od, 0, 0, 0);
  od = __builtin_amdgcn_mfma_f32_32x32x16_bf16(pa3, PK(l3, h3), od, 0, 0, 0);
#undef PK
}
__device__ __forceinline__ void pv_d0(f32x16* o, int vb, bf16x8 pa0, bf16x8 pa1, bf16x8 pa2, bf16x8 pa3) {
  pv_one<0>(o[0], vb, pa0, pa1, pa2, pa3); pv_one<1>(o[1], vb, pa0, pa1, pa2, pa3); pv_one<2>(o[2], vb, pa0, pa1, pa2, pa3); pv_one<3>(o[3], vb, pa0, pa1, pa2, pa3);
}
__device__ __forceinline__ void attn_dense_body(const bf16_t* __restrict__ Qb, const bf16_t* __restrict__ Kh, const bf16_t* __restrict__ Vh,
                                                bf16_t* __restrict__ Ob, int seq, char* lds, const int wave) {
  const int wid = wave, lane = lane_now(), tid = wid * 64 + lane, r32 = lane & 31, hi = lane >> 5;
  bf16_t* V_lds = (bf16_t*)lds; bf16_t* K_lds = (bf16_t*)(lds + 2 * SHM_V);
  float* ws = (float*)(lds + 2 * SHM_V + 2 * SHM_K) + wid * 64; float* li_l = ws; float* al_l = ws + 32;
  float m_reg = -1e30f, l_reg = 0; f32x16 o[4] = {}; bf16x8 qr[8];
  const bf16_t* Qw = Qb + (long)(wid * QBLK + r32) * LDQ + hi * 8;
#pragma unroll
  for (int d0 = 0; d0 < 8; ++d0) qr[d0] = *reinterpret_cast<const bf16x8*>(Qw + d0 * 16);
  const int sr = tid >> 4, sc = (tid & 15) * 8, vst0 = v_st(sr, sc), vst1 = v_st(32 + sr, sc);
  const int vb0 = (int)(uintptr_t)V_lds + v_rd_base(lane);
  const unsigned goff = (unsigned)(sr * LDK + sc) * 2u;
  struct { bf16x8 vs0, vs1, ks0, ks1; } sr_[2];
#define SLOAD(i, k0) do { const char* kb_ = (const char*)Kh + (size_t)(k0) * (LDK * 2); \
    sr_[i].ks0 = *reinterpret_cast<const bf16x8*>(kb_ + goff); sr_[i].ks1 = *reinterpret_cast<const bf16x8*>(kb_ + goff + 32 * LDK * 2); \
    sr_[i].vs0 = *reinterpret_cast<const bf16x8*>(kb_ + goff + 1024); sr_[i].vs1 = *reinterpret_cast<const bf16x8*>(kb_ + goff + 32 * LDK * 2 + 1024); } while (0)
#define SWRITE(b, i) do { *(bf16x8*)((char*)V_lds + (b) * SHM_V + vst0) = sr_[i].vs0;          \
    *(bf16x8*)((char*)V_lds + (b) * SHM_V + vst1) = sr_[i].vs1; int kc = sc * 2;               \
    *(bf16x8*)((char*)K_lds + (b) * SHM_K + KSWZ(sr, kc)) = sr_[i].ks0;                       \
    *(bf16x8*)((char*)K_lds + (b) * SHM_K + KSWZ(32 + sr, kc)) = sr_[i].ks1; } while (0)
#define SWAIT() asm volatile("s_waitcnt vmcnt(4)" ::: "memory")
#define RESC(a) do { if (__any((a) < 1.f)) { if (hi == 0) al_l[r32] = (a); asm volatile("s_waitcnt lgkmcnt(0)" ::: "memory"); \
    for (int d = 0; d < 4; ++d) for (int r = 0; r < 16; ++r) o[d][r] *= al_l[crow(r, hi)]; } } while (0)
  f32x16 pA0, pA1, pB0, pB1; float mnA, mnB, alA, alB; bf16x8 pa0, pa1, pa2, pa3; const int NT = seq / KVBLK;
  constexpr int SE = 0, SO = 1;
  SLOAD(SE, 0); asm volatile("s_waitcnt vmcnt(0)" ::: "memory"); SWRITE(0, SE); __syncthreads();
  qkt(pA0, pA1, K_lds, qr, r32, hi); partialSM(pA0, pA1, m_reg, mnA, alA);
  SLOAD(SO, KVBLK); if (2 < NT) SLOAD(SE, 2 * KVBLK);
  SWAIT(); SWRITE(1, SO); __syncthreads();
  for (int j = 1; j + 1 < NT; j += 2) {
    SBAR(); qkt(pB0, pB1, (bf16_t*)((char*)K_lds + SHM_K), qr, r32, hi);
    finishSM(pA0, pA1, alA, l_reg, pa0, pa1, pa2, pa3); SBAR();
    SLOAD(SO, (j + 2) * KVBLK); SBAR();
    pv_d0(o, vb0, pa0, pa1, pa2, pa3); partialSM(pB0, pB1, m_reg, mnB, alB);
    __syncthreads(); SWAIT(); SWRITE(0, SE);
    RESC(alB); __syncthreads();
    SBAR(); qkt(pA0, pA1, K_lds, qr, r32, hi);
    finishSM(pB0, pB1, alB, l_reg, pa0, pa1, pa2, pa3); SBAR();
    if (j + 3 < NT) SLOAD(SE, (j + 3) * KVBLK); SBAR();
    pv_d0(o, vb0 + (int)SHM_V, pa0, pa1, pa2, pa3); partialSM(pA0, pA1, m_reg, mnA, alA);
    __syncthreads(); SWAIT(); SWRITE(1, SO);
    RESC(alA); __syncthreads();
  }
  SBAR(); qkt(pB0, pB1, (bf16_t*)((char*)K_lds + SHM_K), qr, r32, hi);
  finishSM(pA0, pA1, alA, l_reg, pa0, pa1, pa2, pa3); SBAR();
  pv_d0(o, vb0, pa0, pa1, pa2, pa3); partialSM(pB0, pB1, m_reg, mnB, alB);
  __syncthreads(); RESC(alB);
  finishSM(pB0, pB1, alB, l_reg, pa0, pa1, pa2, pa3); SBAR();
  pv_d0(o, vb0 + (int)SHM_V, pa0, pa1, pa2, pa3);
  if (hi == 0) li_l[r32] = l_reg; asm volatile("s_waitcnt lgkmcnt(0)" ::: "memory");
  float rli[16];
#pragma unroll
  for (int r = 0; r < 16; ++r) rli[r] = __builtin_amdgcn_rcpf(li_l[crow(r, hi)]);
  bf16_t* Ow = Ob + (long)(wid * QBLK) * LDO;
#pragma unroll
  for (int r = 0; r < 16; ++r) { int orow = crow(r, hi);
    for (int d0 = 0; d0 < 4; ++d0) Ow[(long)orow * LDO + d0 * 32 + r32] = f2bf(o[d0][r] * rli[r]); }
  __syncthreads();
#undef SLOAD
#undef SWRITE
#undef SWAIT
#undef RESC
}
#undef KSWZ
#undef SBAR
}
#define XB_TMO      128
#define XB_XCNT(j)  (256  + 64 * (j))
#define XB_XSUB(j)  (1280 + 64 * (j))
#define XB_XGEN(j)  (2304 + 64 * (j))
#define XB_TOP      3328
#define XB_TOPGEN   3392
#define XCD_BAR_WORDS 3456
#define XB_SPIN_CAP (1u << 20)
__device__ __forceinline__ unsigned xb_ld(unsigned* p)              { return __hip_atomic_load(p, __ATOMIC_RELAXED, __HIP_MEMORY_SCOPE_AGENT); }
__device__ __forceinline__ unsigned xb_add(unsigned* p, unsigned v) { return __hip_atomic_fetch_add(p, v, __ATOMIC_RELAXED, __HIP_MEMORY_SCOPE_AGENT); }
__device__ __forceinline__ unsigned xb_xcc_id() { return (unsigned)__builtin_amdgcn_s_getreg((3 << 11) | 20) & 0xFu; }
#define XB_SPIN(cond, bar) do { unsigned _sp = 0; while (cond) { __builtin_amdgcn_s_sleep(1); \
    if ((++_sp & 255u) == 0u) { if (xb_ld(&(bar)[XB_TMO])) break; if (_sp > XB_SPIN_CAP) { atomicAdd(&(bar)[XB_TMO], 1u); break; } } } } while (0)
struct XcdBarrier { unsigned* bar; unsigned x; volatile LAS unsigned* st; int wave; };
__device__ __forceinline__ XcdBarrier xcd_barrier_post(unsigned* bar, volatile LAS unsigned* st, int wave) {
    XcdBarrier b; b.bar = bar; b.x = xb_xcc_id(); b.st = st; b.wave = wave;
    if (tid_from(wave) == 0) (void)xb_add(&bar[XB_XCNT(b.x)], 1u);
    return b;
}
__device__ __forceinline__ void xcd_barrier_complete(unsigned* bar, unsigned x, unsigned& nloc, unsigned& nx) {
    const unsigned G = gridDim.x * gridDim.y * gridDim.z;
    unsigned sum, cnt, mine, sp = 0u;
    for (;;) {
        sum = 0u; cnt = 0u; mine = 0u;
#pragma unroll
        for (unsigned j = 0; j < 16; ++j) { const unsigned c = xb_ld(&bar[XB_XCNT(j)]); sum += c; cnt += (c > 0u) ? 1u : 0u; mine = (j == x) ? c : mine; }
        if (sum == G) break;
        __builtin_amdgcn_s_sleep(1);
        if ((++sp & 255u) == 0u) { if (xb_ld(&bar[XB_TMO])) break; if (sp > XB_SPIN_CAP) { atomicAdd(&bar[XB_TMO], 1u); break; } }
    }
    nloc = mine > 0u ? mine : 1u; nx = cnt > 0u ? cnt : 1u;
}
__device__ __forceinline__ void xcd_barrier(const XcdBarrier& b) {
    asm volatile("s_waitcnt vmcnt(0)" ::: "memory");
    __syncthreads();
    if (tid_from(b.wave) == 0) {
        unsigned* bar = b.bar;
        __builtin_amdgcn_s_waitcnt(0);
        unsigned nloc = b.st[0], nx = b.st[1];
        if (nloc == 0u) { xcd_barrier_complete(bar, b.x, nloc, nx); b.st[0] = nloc; b.st[1] = nx; }
        const unsigned old = xb_add(&bar[XB_XSUB(b.x)], 1u);
        const unsigned gen = old / nloc;
        if (old + 1u == (gen + 1u) * nloc) {
            __builtin_amdgcn_fence(__ATOMIC_RELEASE, "agent");
            asm volatile("s_waitcnt vmcnt(0)" ::: "memory");
            const unsigned og = xb_add(&bar[XB_TOP], 1u);
            const unsigned tg = og / nx;
            if (og + 1u == (tg + 1u) * nx) xb_add(&bar[XB_TOPGEN], 1u);
            else XB_SPIN(xb_ld(&bar[XB_TOPGEN]) == tg, bar);
            __builtin_amdgcn_fence(__ATOMIC_ACQUIRE, "agent");
            xb_add(&bar[XB_XGEN(b.x)], 1u);
            asm volatile("s_waitcnt vmcnt(0)" ::: "memory");
        } else {
            XB_SPIN(xb_ld(&bar[XB_XGEN(b.x)]) == gen, bar);
            __builtin_amdgcn_fence(__ATOMIC_ACQUIRE, "agent");
            asm volatile("s_waitcnt vmcnt(0)" ::: "memory");
        }
    }
    __syncthreads();
}

struct Frame {
    LAS unsigned char* lds; char* ldsg;
    int tid, lane, wave, vcu, G;
    const float* const* in; float* out; unsigned char* ws;
};
struct Args { const float* in[32]; float* out; unsigned char* ws; int ph_lo, ph_hi; };
__device__ __forceinline__ void transpose_item64(const float* __restrict__ W, int K, int N, bf16_t* __restrict__ WT, int drow0, LAS float* scr, int k0, int n0, int lane, float qs = 0.f) {
    const int kr = lane >> 4, n4 = (lane & 15) * 4;
#pragma unroll 4
    for (int i = 0; i < 16; ++i) { const int kk = 4 * i + kr; const f32x4 v = *(const f32x4*)(W + (size_t)(k0 + kk) * N + n0 + n4);
        LAS float* s = scr + kk * 64;
        s[(n4 + 0) ^ kk] = v[0]; s[(n4 + 1) ^ kk] = v[1]; s[(n4 + 2) ^ kk] = v[2]; s[(n4 + 3) ^ kk] = v[3]; }
    LDS_WAIT(); asm volatile("" ::: "memory");
    const int c = lane & 7;
#pragma unroll
    for (int j = 0; j < 8; ++j) { const int n = (lane >> 3) + 8 * j; float v[8];
#pragma unroll
        for (int q = 0; q < 8; ++q) { const int kk = 8 * c + q; v[q] = scr[kk * 64 + (n ^ kk)]; if (qs != 0.f) v[q] = q8(v[q], qs); }
        u32x4 o; o.x = cvt_pk_bf16(v[0], v[1]); o.y = cvt_pk_bf16(v[2], v[3]); o.z = cvt_pk_bf16(v[4], v[5]); o.w = cvt_pk_bf16(v[6], v[7]);
        *(u32x4*)(WT + (size_t)(drow0 + n) * K + k0 + 8 * c) = o; }
    LDS_WAIT(); asm volatile("" ::: "memory");
}
__device__ __forceinline__ void transpose_matrix_items(const float* W, int K, int N, bf16_t* WT, int gu, LAS float* scr, int item, int lane, float qs = 0.f) {
    const int nblk = N / 64, kb = item / nblk, nb = item % nblk, k0 = 64 * kb, n0 = 64 * nb;
    int drow0 = n0;
    if (gu) { const int f0 = n0 & 1023; drow0 = (f0 >> 7) * 256 + ((n0 >= 1024) ? 128 : 0) + (f0 & 127); }
    transpose_item64(W, K, N, WT, drow0, scr, k0, n0, lane, qs);
}

__device__ __forceinline__ void transpose_item_f8(const float* __restrict__ W, int K, int N, unsigned char* __restrict__ WT8, int drow0, LAS float* scr, int k0, int n0, int lane, float sc, bool readonly = false) {
    const int kr = lane >> 3, n4 = (lane & 7) * 4;
    if (readonly) { f32x4 a = {0.f, 0.f, 0.f, 0.f};
        const int item = (k0 >> 7) * (N / 32) + (n0 >> 5), nb256 = N / 256, kq = item / nb256, nq = item % nb256;
#pragma unroll
        for (int i = 0; i < 16; ++i) a += *(const f32x4*)(W + (size_t)(16 * kq + i) * N + 256 * nq + 4 * lane);
        asm volatile("" :: "v"(a)); return; }
#define TSWZ(kk) (((kk) & 7) | ((((kk) >> 4) & 3) << 3))
#pragma unroll
    for (int h = 0; h < 2; ++h) { f32x4 v[8];
#pragma unroll
        for (int i = 0; i < 8; ++i) v[i] = __builtin_nontemporal_load((const f32x4*)(W + (size_t)(k0 + 64 * h + 8 * i + kr) * N + n0 + n4));
#pragma unroll
        for (int i = 0; i < 8; ++i) { const int kk = 64 * h + 8 * i + kr; LAS float* s = scr + kk * 32; const int x = TSWZ(kk);
            s[(n4 + 0) ^ x] = v[i][0]; s[(n4 + 1) ^ x] = v[i][1]; s[(n4 + 2) ^ x] = v[i][2]; s[(n4 + 3) ^ x] = v[i][3]; } }
    LDS_WAIT(); asm volatile("" ::: "memory");
    const int c = lane & 7;
#pragma unroll 1
    for (int j = 0; j < 4; ++j) { const int n = (lane >> 3) + 8 * j; float u[16];
#pragma unroll
        for (int q = 0; q < 16; ++q) { const int kk = 16 * c + q; u[q] = scr[kk * 32 + (n ^ TSWZ(kk))] * sc; }
        u32x4 o; o.x = pk4_fp8(u[0], u[1], u[2], u[3]); o.y = pk4_fp8(u[4], u[5], u[6], u[7]); o.z = pk4_fp8(u[8], u[9], u[10], u[11]); o.w = pk4_fp8(u[12], u[13], u[14], u[15]);
        const int r = drow0 + n;
        *(u32x4*)(WT8 + (size_t)(r >> 8) * 256 * K + (size_t)(k0 >> 7) * 32768 + (r & 255) * 128 + 16 * c) = o; }
    LDS_WAIT(); asm volatile("" ::: "memory");
#undef TSWZ
}
__device__ __forceinline__ void transpose_matrix_items_f8(const float* W, int K, int N, unsigned char* WT8, int gu, LAS float* scr, int item, int lane, float sc, bool readonly = false) {
    const int nblk = N / 32, kb = item / nblk, nb = item % nblk, k0 = 128 * kb, n0 = 32 * nb;
    int drow0 = n0;
    if (gu) { const int f0 = n0 & 1023; drow0 = (f0 >> 7) * 256 + ((n0 >= 1024) ? 128 : 0) + (f0 & 127); }
    transpose_item_f8(W, K, N, WT8, drow0, scr, k0, n0, lane, sc, readonly);
}

__device__ __forceinline__ void p0_prologue(Frame& F) {
    const int gw = F.vcu * NWAVES + F.wave, NGW = F.G * NWAVES;
    const int gt = F.vcu * NTHR + F.tid, NGT = F.G * NTHR;
    {
        LAS float* cond = (LAS float*)F.lds;
        LAS float* part = cond + NB * D;
        for (int i = F.tid; i < NB * D; i += NTHR) { const float c = F.in[1][i]; cond[i] = c * sigmoidf_(c); }
        __syncthreads();
        float* modf = (float*)(F.ws + WS_MODP);
        const float* aw = F.in[2]; const float* ab = F.in[3];
        for (int it = F.vcu; it < DEPTH * 64; it += F.G) {
            const int layer = it >> 6, cb = it & 63, n = cb * 96 + F.lane * 2;
            float a0[4] = {0.f, 0.f, 0.f, 0.f}, a1[4] = {0.f, 0.f, 0.f, 0.f};
            if (F.lane < 48) { const float* wp = aw + ((size_t)layer * D + F.wave * 128) * (6 * D) + n;
#pragma unroll 32
                for (int k = 0; k < 128; ++k) { const f32x2 w = *(const f32x2*)(wp + (size_t)k * (6 * D));
#pragma unroll
                    for (int b = 0; b < 4; ++b) { const float cv = cond[b * D + F.wave * 128 + k]; a0[b] += cv * w.x; a1[b] += cv * w.y; } }
#pragma unroll
                for (int b = 0; b < 4; ++b) *(LAS f32x2*)(part + (F.wave * 4 + b) * 96 + F.lane * 2) = (f32x2){a0[b], a1[b]}; }
            __syncthreads();
            if (F.tid < 4 * 96) { const int b = F.tid / 96, c = F.tid % 96; float sum = ab[(size_t)layer * 6 * D + cb * 96 + c];
#pragma unroll
                for (int w = 0; w < 8; ++w) sum += part[(w * 4 + b) * 96 + c];
                modf[((size_t)layer * NB + b) * (6 * D) + cb * 96 + c] = sum; }
            __syncthreads();
        }
    }
    {
        LAS float* ct = (LAS float*)F.lds;
        for (int m = F.tid; m < 4096; m += NTHR) ct[m] = cospif((float)m * (1.0f / 2048.0f));
        __syncthreads();
        unsigned char* dl = F.ws + WS_DFTL;
        for (int it = gt; it < 8192 * 256; it += NGT) {
            const int row = it >> 8, l0 = (it & 255) * 16, part = row >> 12, lp = row & 4095;
            if (lp >= 2048) continue;
            float v[16];
#pragma unroll
            for (int q = 0; q < 16; ++q) { int m = (lp * (l0 + q)) & 4095; if (part) m = (m - 1024) & 4095; v[q] = ct[m] * 256.0f; }
            *(u32x4*)(dl + (size_t)row * 4096 + l0) = (u32x4){pk4_fp8(v[0], v[1], v[2], v[3]), pk4_fp8(v[4], v[5], v[6], v[7]), pk4_fp8(v[8], v[9], v[10], v[11]), pk4_fp8(v[12], v[13], v[14], v[15])};
        }
        bf16_t* dc = (bf16_t*)(F.ws + WS_SMALL + SM_DFTC);
        for (int it = gt; it < 256 * 512; it += NGT) {
            const int k = it >> 9, col = it & 511, part = col >> 8, c = col & 255;
            int m = (16 * c * k) & 4095; float v;
            if (part) { m = (m - 1024) & 4095; v = -ct[m]; } else v = ct[m];
            dc[it] = f2bf(v * (1.0f / 16.0f));
        }
        float* lbo = (float*)(F.ws + WS_SMALL + SM_LB);
        for (int n = gt; n < D; n += NGT) { const float* hl = F.in[23];
            const float x0 = hl[n], x1 = hl[D + n], x2 = hl[2 * D + n], x3 = hl[3 * D + n], mx = fmaxf(fmaxf(x0, x1), fmaxf(x2, x3));
            const float e0 = __expf(x0 - mx), e1 = __expf(x1 - mx), e2 = __expf(x2 - mx), e3 = __expf(x3 - mx);
            lbo[n] = (e1 + e2 + e3) / (e0 + e1 + e2 + e3); }
        __syncthreads();
    }
    for (int gu_ = F.vcu; gu_ < S5G * 4; gu_ += F.G) {
        const int g = gu_ >> 2, part = gu_ & 3;
        LAS f32x2* apow = (LAS f32x2*)F.lds;
        LAS f32x2* bbar = apow + 2 * 17 * 64;
        LAS f32x2* cm = bbar + 2 * 64 * 16;
        LAS f32x2* coef = cm + 2 * 16 * 64;
        LAS float* Kt = (LAS float*)(coef + 128);
        const float *a_re = F.in[12], *a_im = F.in[13], *ldt = F.in[14], *b_re = F.in[15], *b_im = F.in[16], *c_re = F.in[17], *c_im = F.in[18], *dv = F.in[19];
        if (F.tid < 128) { const int dir = F.tid >> 6, p = F.tid & 63;
            const float lr = a_re[(dir * S5G + g) * S5P + p], li = a_im[(dir * S5G + g) * S5P + p], dt = expf(ldt[dir * S5G + g]);
            const float er = lr * dt, th = li * dt;
            for (int m = 0; m <= 16; ++m) { const float mag = expf(er * (float)m); float s, c; sincosf(th * (float)m, &s, &c); apow[(dir * 17 + m) * 64 + p] = (f32x2){mag * c, mag * s}; }
            const f32x2 a1 = apow[(dir * 17 + 1) * 64 + p]; const float nr = a1.x - 1.f, ni = a1.y, den = lr * lr + li * li;
            coef[dir * 64 + p] = (f32x2){(nr * lr + ni * li) / den, (ni * lr - nr * li) / den};
            ((f32x2*)(F.ws + WS_SMALL + SM_AT))[(dir * S5G + g) * S5P + p] = apow[(dir * 17 + 16) * 64 + p];
        }
        __syncthreads();
        for (int i = F.tid; i < 2048; i += NTHR) { const int dir = i >> 10, p = (i >> 4) & 63, c = i & 15;
            const size_t bi = (((size_t)dir * S5G + g) * S5P + p) * S5C + c; const f32x2 cf = coef[dir * 64 + p]; const float br = b_re[bi], bim = b_im[bi];
            bbar[i] = (f32x2){cf.x * br - cf.y * bim, cf.x * bim + cf.y * br};
            const int c2 = (i >> 6) & 15, p2 = i & 63; const size_t ci = (((size_t)dir * S5G + g) * S5C + c2) * S5P + p2;
            cm[i] = (f32x2){c_re[ci], c_im[ci]}; }
        __syncthreads();
        {
            const int dir = F.tid >> 8, tau = (F.tid >> 4) & 15, co = F.tid & 15; float acc[16];
#pragma unroll
            for (int ci = 0; ci < 16; ++ci) acc[ci] = 0.f;
            for (int p = 0; p < 64; ++p) { const f32x2 cc = cm[(dir * 16 + co) * 64 + p], aa = apow[(dir * 17 + tau) * 64 + p];
                const float zr = cc.x * aa.x - cc.y * aa.y, zi = cc.x * aa.y + cc.y * aa.x;
#pragma unroll
                for (int ci = 0; ci < 16; ++ci) { const f32x2 bb = bbar[(dir * 64 + p) * 16 + ci]; acc[ci] += zr * bb.x - zi * bb.y; } }
#pragma unroll
            for (int ci = 0; ci < 16; ++ci) Kt[((dir * 16 + tau) * 16 + co) * 16 + ci] = acc[ci];
        }
        __syncthreads();
        bf16_t* mst = (bf16_t*)(F.ws + WS_S5M) + (size_t)g * 256 * 256;
        for (int it = part * 64 * 32 + F.tid; it < (part + 1) * 64 * 32; it += NTHR) {
            const int n = it >> 5, k0 = (it & 31) * 8, dir = n >> 7, ri = (n >> 6) & 1, p = n & 63, t = k0 >> 4, c0 = k0 & 15;
            const f32x2 aa = apow[(dir * 17 + (dir ? t : 15 - t)) * 64 + p]; float v[8];
#pragma unroll
            for (int q = 0; q < 8; ++q) { const f32x2 bb = bbar[(dir * 64 + p) * 16 + c0 + q]; v[q] = ri ? (aa.x * bb.y + aa.y * bb.x) : (aa.x * bb.x - aa.y * bb.y); }
            u32x4 o; o.x = cvt_pk_bf16(v[0], v[1]); o.y = cvt_pk_bf16(v[2], v[3]); o.z = cvt_pk_bf16(v[4], v[5]); o.w = cvt_pk_bf16(v[6], v[7]);
            *(u32x4*)(mst + (size_t)n * 256 + k0) = o;
        }
        bf16_t* tout = (bf16_t*)(F.ws + WS_S5T) + (size_t)g * 256 * 512;
        for (int it = part * 64 * 64 + F.tid; it < (part + 1) * 64 * 64; it += NTHR) {
            const int n = it >> 6, k0 = (it & 63) * 8, t = n >> 4, co = n & 15; float v[8];
            if (k0 < 256) { const int s = k0 >> 4, ci0 = k0 & 15, dl_ = t - s;
#pragma unroll
                for (int q = 0; q < 8; ++q) { const int ci = ci0 + q; float x;
                    if (dl_ > 0) x = Kt[((0 * 16 + dl_) * 16 + co) * 16 + ci];
                    else if (dl_ < 0) x = Kt[((1 * 16 - dl_) * 16 + co) * 16 + ci];
                    else x = Kt[((0 * 16 + 0) * 16 + co) * 16 + ci] + Kt[((1 * 16 + 0) * 16 + co) * 16 + ci] + (co == ci ? dv[g * 16 + co] : 0.f);
                    v[q] = x; }
            } else { const int np = k0 - 256, dir = np >> 7, ri = (np >> 6) & 1, p0 = np & 63, m = dir ? 16 - t : t + 1;
#pragma unroll
                for (int q = 0; q < 8; ++q) { const f32x2 cc = cm[(dir * 16 + co) * 64 + p0 + q], aa = apow[(dir * 17 + m) * 64 + p0 + q];
                    v[q] = ri ? -(cc.x * aa.y + cc.y * aa.x) : (cc.x * aa.x - cc.y * aa.y); } }
            u32x4 o; o.x = cvt_pk_bf16(v[0], v[1]); o.y = cvt_pk_bf16(v[2], v[3]); o.z = cvt_pk_bf16(v[4], v[5]); o.w = cvt_pk_bf16(v[6], v[7]);
            *(u32x4*)(tout + (size_t)n * 512 + k0) = o;
        }
        __syncthreads();
    }
    {
        LAS float* scr = (LAS float*)(F.lds + F.wave * 16384);
        bf16_t* wsm = (bf16_t*)(F.ws + WS_WSM);
        constexpr int I_SQ = 16 * 16, I_QKV = 16 * 32, I_HIN = 16 * 80, I_GU = 16 * 32, I_DN = 16 * 16;
        constexpr int O1 = I_SQ, O2 = O1 + I_QKV, O3 = O2 + I_SQ, O4 = O3 + I_SQ, O5 = O4 + I_SQ, O6 = O5 + I_HIN, O7 = O6 + I_SQ;
        constexpr int NSMALL = O7, NGU = DEPTH * NE * I_GU, NDN = DEPTH * NE * I_DN, NITEMS = NSMALL + NGU + NDN;
#ifndef PROBE_KIND
#define PROBE_KIND 0
#endif
        for (int it = gw; it < NSMALL; it += NGW) {
            int r = it;
            {
                if (r < O1) { transpose_matrix_items(F.in[6], D, D, wsm + W_FNET / 2, 0, scr, r, F.lane); continue; }
                if (r < O2) { transpose_matrix_items_f8(F.in[8], D, QKVC, F.ws + WS_WSM + W_QKV, 0, scr, r - O1, F.lane, S8_WGU); continue; }
                if (r < O3) { transpose_matrix_items(F.in[11], D, D, wsm + W_AO / 2, 0, scr, r - O2, F.lane); continue; }
                if (r < O4) { transpose_matrix_items(F.in[20], D, D, wsm + W_GLU / 2, 0, scr, r - O3, F.lane); continue; }
                if (r < O5) { transpose_matrix_items(F.in[21], D, D, wsm + W_SO / 2, 0, scr, r - O4, F.lane); continue; }
                if (r < O6) { transpose_matrix_items_f8(F.in[22], D, 5 * D, F.ws + WS_WSM + W_HIN, 0, scr, r - O5, F.lane, S8_WGU); continue; }
                transpose_matrix_items(F.in[25], D, D, wsm + W_HO / 2, 0, scr, r - O6, F.lane); continue;
            }
        }
        {
            struct TItem { const float* W; unsigned char* WT8; int N, k0, n0, drow0; float sc; };
            auto moe_item = [&](int r) { TItem t; int it, gu;
                if (r < NGU) { const int mi = r / I_GU; it = r % I_GU; t.N = 2 * DEX; t.W = F.in[28] + (size_t)mi * D * 2 * DEX; t.WT8 = F.ws + WS_WGU + (size_t)mi * 2 * DEX * D; gu = 1; t.sc = S8_WGU; }
                else { const int r2 = r - NGU, mi = r2 / I_DN; it = r2 % I_DN; t.N = D; t.W = F.in[30] + (size_t)mi * DEX * D; t.WT8 = F.ws + WS_WDN + (size_t)mi * D * DEX; gu = 0; t.sc = S8_WDN; }
                const int nblk = t.N / 32, kb = it / nblk, nb = it % nblk; t.k0 = 128 * kb; t.n0 = 32 * nb; t.drow0 = t.n0;
                if (gu) { const int f0 = t.n0 & 1023; t.drow0 = (f0 >> 7) * 256 + ((t.n0 >= 1024) ? 128 : 0) + (f0 & 127); }
                return t; };
            const int lane = F.lane, kr = lane >> 3, n4 = (lane & 7) * 4, c = lane & 7;
#define TSWZ(kk) (((kk) & 7) | ((((kk) >> 4) & 3) << 3))
#define TLOAD(v, t, h) do { _Pragma("unroll") for (int i = 0; i < 8; ++i) v[i] = __builtin_nontemporal_load((const f32x4*)(t.W + (size_t)(t.k0 + 64 * (h) + 8 * i + kr) * t.N + t.n0 + n4)); } while (0)
#define TWRITE(v, h) do { _Pragma("unroll") for (int i = 0; i < 8; ++i) { const int kk = 64 * (h) + 8 * i + kr; LAS float* s_ = scr + kk * 32; const int x = TSWZ(kk); \
                s_[(n4 + 0) ^ x] = v[i][0]; s_[(n4 + 1) ^ x] = v[i][1]; s_[(n4 + 2) ^ x] = v[i][2]; s_[(n4 + 3) ^ x] = v[i][3]; } } while (0)
            constexpr int NMOE = (NGU + NDN) / DEPTH * (DEPTH - 1), NGU_E = NGU / DEPTH * (DEPTH - 1);
#define RMAP(rp) ((rp) < NGU_E ? (rp) : (rp) + NGU / DEPTH)
            for (int rep = 0; rep < ((PROBE_KIND == 10) ? 2 : 1); ++rep) {
                int r = gw; TItem cur = moe_item(r < NMOE ? RMAP(r) : 0); f32x4 v0[8], v1[8];
                if (r < NMOE) TLOAD(v0, cur, 0);
                for (; r < NMOE; r += NGW) {
                    TLOAD(v1, cur, 1);
                    TWRITE(v0, 0);
                    TWRITE(v1, 1);
                    const int rn = r + NGW; TItem nxt = moe_item(rn < NMOE ? RMAP(rn) : RMAP(r));
                    if (rn < NMOE) TLOAD(v0, nxt, 0);
                    LDS_WAIT(); asm volatile("" ::: "memory");
#pragma unroll 1
                    for (int j = 0; j < 4; ++j) { const int n = (lane >> 3) + 8 * j; float u[16];
#pragma unroll
                        for (int q = 0; q < 16; ++q) { const int kk = 16 * c + q; u[q] = scr[kk * 32 + (n ^ TSWZ(kk))] * cur.sc; }
                        u32x4 o; o.x = pk4_fp8(u[0], u[1], u[2], u[3]); o.y = pk4_fp8(u[4], u[5], u[6], u[7]); o.z = pk4_fp8(u[8], u[9], u[10], u[11]); o.w = pk4_fp8(u[12], u[13], u[14], u[15]);
                        const int rr = cur.drow0 + n;
                        *(u32x4*)(cur.WT8 + (size_t)(rr >> 8) * 256 * 1024 + (size_t)(cur.k0 >> 7) * 32768 + (rr & 255) * 128 + 16 * c) = o; }
                    LDS_WAIT(); asm volatile("" ::: "memory");
                    cur = nxt;
                }
            }
#undef TSWZ
#undef TLOAD
#undef TWRITE
#undef RMAP
        }
    }
}

constexpr int DEF_GU = NE * 16 * 32, DEF_DN = NE * 16 * 16, NDEF = DEF_GU + DEF_DN;
__device__ __forceinline__ void deferred_fill(Frame& F, int nblocks) {
    unsigned* ctr = (unsigned*)(F.ws + WS_CTL) + 1024;
    LAS float* scr = (LAS float*)(F.lds + F.wave * 16384);
    volatile LAS unsigned* slot = (volatile LAS unsigned*)(F.lds + MISC_OFF) + 16;
    for (int k = 0; nblocks < 0 || k < nblocks; ++k) {
        __syncthreads();
        if (tid_from(F.wave) == 0) slot[0] = atomicAdd(ctr, 8u);
        __syncthreads();
        const unsigned base = __builtin_amdgcn_readfirstlane(slot[0]);
        if (base >= (unsigned)NDEF) break;
        const int q = (int)base + F.wave, lane = lane_now();
        constexpr int L = DEPTH - 1;
        if (q < DEF_GU) { const int mi = L * NE + q / 512, it = q % 512;
            transpose_matrix_items_f8(F.in[28] + (size_t)mi * D * 2 * DEX, D, 2 * DEX, F.ws + WS_WGU + (size_t)mi * 2 * DEX * D, 1, scr, it, lane, S8_WGU); }
        else { const int q2 = q - DEF_GU, mi = L * NE + q2 / 256, it = q2 % 256;
            transpose_matrix_items_f8(F.in[30] + (size_t)mi * DEX * D, DEX, D, F.ws + WS_WDN + (size_t)mi * D * DEX, 0, scr, it, lane, S8_WDN); }
    }
    __syncthreads();
}
__device__ __forceinline__ float modval(const float* modf, const float* ada_b, int layer, int b, int idx, int n) {
    return modf[((size_t)layer * NB + b) * (6 * D) + idx * D + n];
}
__device__ __forceinline__ void rowpass(Frame& F, int layer, int stage) {
    const bool has_post = !(layer == 0 && stage == 0), has_h = layer < DEPTH;
    const int pl = (stage == 0) ? layer - 1 : layer, ps = (stage == 0) ? 1 : 0;
    const int hmode = !has_h ? 0 : (stage == 1 ? 1 : (layer == 0 ? 2 : (layer == 2 ? 3 : 1)));
    const float* xsrc = F.in[0]; _Float16* x16 = (_Float16*)(F.ws + WS_X16);
    const float* modp = (const float*)(F.ws + WS_MODP); const float* ada_b = F.in[3];
    const bf16_t* Yd = (const bf16_t*)(F.ws + WS_Y);
    const unsigned char* YB = F.ws + WS_SCR + SC_DNO;
    int* topi = (int*)(F.ws + WS_ROUTE + RT_TOPI); float* topg = (float*)(F.ws + WS_ROUTE + RT_TOPG); int* destp = (int*)(F.ws + WS_ROUTE + RT_DEST); int* hist = (int*)(F.ws + WS_ROUTE + RT_HIST);
    bf16_t* H = (bf16_t*)(F.ws + WS_H); bf16_t* AOP = (bf16_t*)(F.ws + WS_SCR + SC_AOP);
    LAS float* gv = (LAS float*)F.lds;
    LAS float* pgv = gv + D, *pbv = pgv + D;
    LAS float* scv = pbv + D, *shv = scv + D;
    LAS float* stt = shv + D;
    LAS unsigned char* big = F.lds + 6 * D * 4;
    for (int rb = F.vcu; rb < NTOK / 64; rb += F.G) {
        const int b = rb / (SEQ / 64);
        struct Raw { f32x4 xf[4]; h16x4 xh[4]; u32x2 yd[4]; int yb[4][4]; float gk[4]; };
        int dall = 0, gall = 0;
        if (has_post && ps == 1) { const int q = F.lane & 31, rr = rb * 64 + (q >> 4) * 32 + F.wave * 4 + ((q >> 2) & 3); dall = destp[rr * 4 + (q & 3)]; gall = __float_as_int(topg[rr * 4 + (q & 3)]); }
        auto load_raw = [&](int rnd_, int i_, Raw& R) { const int row_ = rb * 64 + rnd_ * 32 + F.wave * 4 + i_;
#pragma unroll
            for (int j = 0; j < 4; ++j) { if (layer == 0) R.xf[j] = *(const f32x4*)(xsrc + (size_t)row_ * D + 256 * j + 4 * F.lane); else R.xh[j] = *(const h16x4*)(x16 + (size_t)row_ * D + 256 * j + 4 * F.lane); }
            if (has_post) {
                if (ps == 0) {
#pragma unroll
                    for (int j = 0; j < 4; ++j) R.yd[j] = *(const u32x2*)(Yd + (size_t)row_ * D + 256 * j + 4 * F.lane);
                } else {
#pragma unroll
                    for (int k = 0; k < 4; ++k) { const int dr = __builtin_amdgcn_readlane(dall, rnd_ * 16 + i_ * 4 + k); R.gk[k] = __int_as_float(__builtin_amdgcn_readlane(gall, rnd_ * 16 + i_ * 4 + k)) * (1.0f / S8_Y);
#pragma unroll
                        for (int j = 0; j < 4; ++j) R.yb[k][j] = *(const int*)(YB + (size_t)dr * D + 256 * j + 4 * F.lane); }
                } } };
        Raw cur; load_raw(0, 0, cur);
        for (int n = F.tid; n < D; n += NTHR) {
            if (has_post) { gv[n] = modval(modp, ada_b, pl, b, ps ? 5 : 2, n); pgv[n] = F.in[4][(pl * 2 + ps) * D + n]; pbv[n] = F.in[5][(pl * 2 + ps) * D + n]; }
            if (has_h) { scv[n] = 1.f + modval(modp, ada_b, layer, b, stage ? 4 : 1, n); shv[n] = modval(modp, ada_b, layer, b, stage ? 3 : 0, n); }
        }
        __syncthreads();
        for (int rnd = 0; rnd < 2; ++rnd) {
            for (int i = 0; i < 4; ++i) {
                const int lr = rnd * 32 + F.wave * 4 + i, row = rb * 64 + lr;
                Raw nxt; if (!(rnd == 1 && i == 3)) load_raw(i == 3 ? 1 : rnd, i == 3 ? 0 : i + 1, nxt);
                f32x4 v[4];
#pragma unroll
                for (int j = 0; j < 4; ++j) { if (layer == 0) v[j] = cur.xf[j]; else v[j] = __builtin_convertvector(cur.xh[j], f32x4); }
                if (has_post) {
                    f32x4 y[4];
                    if (ps == 0) {
#pragma unroll
                        for (int j = 0; j < 4; ++j) { const u32x2 w = cur.yd[j]; y[j] = (f32x4){bflo(w.x), bfhi(w.x), bflo(w.y), bfhi(w.y)}; }
                    } else {
#pragma unroll
                        for (int j = 0; j < 4; ++j) y[j] = (f32x4){0.f, 0.f, 0.f, 0.f};
#pragma unroll
                        for (int k = 0; k < 4; ++k) { const float gk = cur.gk[k];
#pragma unroll
                            for (int j = 0; j < 4; ++j) { const int w = cur.yb[k][j];
                                const f32x2 lo = __builtin_amdgcn_cvt_pk_f32_fp8(w, false), hi = __builtin_amdgcn_cvt_pk_f32_fp8(w, true);
                                y[j][0] += gk * lo.x; y[j][1] += gk * lo.y; y[j][2] += gk * hi.x; y[j][3] += gk * hi.y; } }
                    }
                    float s = 0.f;
#pragma unroll
                    for (int j = 0; j < 4; ++j) { const f32x4 gg = *(const LAS f32x4*)(gv + 256 * j + 4 * F.lane); v[j] = DN_ALPHA * v[j] + gg * y[j]; s += (v[j][0] + v[j][1]) + (v[j][2] + v[j][3]); }
                    const float mean = wave_sum(s) * (1.f / D); float q = 0.f;
#pragma unroll
                    for (int j = 0; j < 4; ++j) { v[j] = v[j] - mean; q += (v[j][0] * v[j][0] + v[j][1] * v[j][1]) + (v[j][2] * v[j][2] + v[j][3] * v[j][3]); }
                    const float rstd = 1.f / sqrtf(wave_sum(q) * (1.f / D) + LN_EPS);
#pragma unroll
                    for (int j = 0; j < 4; ++j) { const f32x4 pg = *(const LAS f32x4*)(pgv + 256 * j + 4 * F.lane), pb = *(const LAS f32x4*)(pbv + 256 * j + 4 * F.lane);
                        v[j] = v[j] * rstd * pg + pb;
                        if (has_h) { const h16x4 hx = __builtin_convertvector(v[j], h16x4); *(h16x4*)(x16 + (size_t)row * D + 256 * j + 4 * F.lane) = hx; v[j] = __builtin_convertvector(hx, f32x4); }
                        else *(f32x4*)(F.out + (size_t)row * D + 256 * j + 4 * F.lane) = v[j]; }
                }
                if (has_h) {
                    float s = 0.f;
#pragma unroll
                    for (int j = 0; j < 4; ++j) s += (v[j][0] + v[j][1]) + (v[j][2] + v[j][3]);
                    const float mean = wave_sum(s) * (1.f / D); float q = 0.f;
#pragma unroll
                    for (int j = 0; j < 4; ++j) { v[j] = v[j] - mean; q += (v[j][0] * v[j][0] + v[j][1] * v[j][1]) + (v[j][2] * v[j][2] + v[j][3] * v[j][3]); }
                    const float rstd = 1.f / sqrtf(wave_sum(q) * (1.f / D) + LN_EPS);
                    if (F.lane == 0) { stt[lr * 2] = mean; stt[lr * 2 + 1] = rstd; }
#pragma unroll
                    for (int j = 0; j < 4; ++j) { const f32x4 sc = *(const LAS f32x4*)(scv + 256 * j + 4 * F.lane), sh = *(const LAS f32x4*)(shv + 256 * j + 4 * F.lane);
                        const f32x4 h = v[j] * rstd * sc + sh; const u32x2 w = {cvt_pk_bf16(h[0], h[1]), cvt_pk_bf16(h[2], h[3])};
                        if (hmode == 1) *(unsigned*)((unsigned char*)H + (size_t)row * D + 256 * j + 4 * F.lane) = pk4_fp8(h[0] * S8_H, h[1] * S8_H, h[2] * S8_H, h[3] * S8_H);
                        else if (hmode == 2) *(LAS unsigned*)(big + (size_t)(lr & 31) * 1028 + 256 * j + 4 * F.lane) = pk4_fp8(h[0] * S8_H, h[1] * S8_H, h[2] * S8_H, h[3] * S8_H);
                        else *(LAS u32x2*)(big + (size_t)(lr & 31) * 2064 + (256 * j + 4 * F.lane) * 2) = w;
                    }
                }
                cur = nxt;
            }
            if (hmode == 3) {
                __syncthreads();
                const int j0 = ((rb * 64 + rnd * 32) & (SEQ - 1)) >> 4;
                for (int q = F.tid; q < 4096; q += NTHR) { const int g = q >> 6, jj = (q >> 5) & 1, t = (q >> 1) & 15, c8 = (q & 1) * 8;
                    *(u32x4*)(AOP + ((size_t)(g * 1024 + b * 256 + j0 + jj)) * 512 + t * 16 + c8) = *(const LAS u32x4*)(big + (size_t)(16 * jj + t) * 2064 + (g * 16 + c8) * 2); }
                __syncthreads();
            }
            if (hmode == 2) {
                __syncthreads();
                const int l0 = (rb * 64 + rnd * 32) & (SEQ - 1);
                for (int it = F.tid; it < 2048; it += NTHR) { const int ch = it >> 1, lg = it & 1; unsigned wq[4];
#pragma unroll
                    for (int q = 0; q < 4; ++q) { const LAS unsigned char* pz = big + (size_t)(lg * 16 + 4 * q) * 1028 + ch;
                        wq[q] = (unsigned)pz[0] | ((unsigned)pz[1028] << 8) | ((unsigned)pz[2056] << 16) | ((unsigned)pz[3084] << 24); }
                    *(u32x4*)((unsigned char*)H + ((size_t)b * D + ch) * SEQ + l0 + lg * 16) = (u32x4){wq[0], wq[1], wq[2], wq[3]}; }
                __syncthreads();
            }
        }
        if (has_h && stage == 1) {
            VM_WAIT(); __syncthreads();
            __builtin_amdgcn_fence(__ATOMIC_ACQUIRE, "agent"); VM_WAIT();
            constexpr int HP = 68;
            LAS float* hsT = (LAS float*)big;
            LAS float* wt = hsT + 64 * HP;
            LAS float* lg = wt + 64 * 32;
            LAS int* hh = (LAS int*)(lg + 64 * 33);
            LAS float* red = (LAS float*)(hh + 32);
            const float* wr = F.in[26] + (size_t)layer * D * NE; const float* br = F.in[27] + layer * NE;
            if (F.tid < 32) hh[F.tid] = 0;
            const int kq = F.tid >> 7, rg = (F.tid & 127) >> 3, eg = F.tid & 7;
            const int r = F.tid >> 3, ks = (F.tid & 7) * 8, kk = F.tid >> 3, e4 = (F.tid & 7) * 4;
            const float mean = stt[r * 2], rstd = stt[r * 2 + 1];
            const _Float16* xp = x16 + (size_t)(rb * 64 + r) * D + ks; const float* wp = wr + (size_t)kk * NE + e4;
            f32x4 acc[4] = {(f32x4){0.f, 0.f, 0.f, 0.f}, (f32x4){0.f, 0.f, 0.f, 0.f}, (f32x4){0.f, 0.f, 0.f, 0.f}, (f32x4){0.f, 0.f, 0.f, 0.f}};
            h16x8 xh = *(const h16x8*)xp; f32x4 wv = *(const f32x4*)wp;
            for (int k0 = 0; k0 < D; k0 += 64) {
                { const f32x4 sa = *(const LAS f32x4*)(scv + k0 + ks), sb = *(const LAS f32x4*)(scv + k0 + ks + 4), ha = *(const LAS f32x4*)(shv + k0 + ks), hb = *(const LAS f32x4*)(shv + k0 + ks + 4);
                    const f32x4 xa = __builtin_convertvector(__builtin_shufflevector(xh, xh, 0, 1, 2, 3), f32x4), xb = __builtin_convertvector(__builtin_shufflevector(xh, xh, 4, 5, 6, 7), f32x4);
                    const f32x4 va = (xa - mean) * rstd * sa + ha, vb = (xb - mean) * rstd * sb + hb;
#pragma unroll
                    for (int q = 0; q < 4; ++q) { hsT[(ks + q) * HP + r] = va[q]; hsT[(ks + 4 + q) * HP + r] = vb[q]; }
                    *(LAS f32x4*)(wt + kk * 32 + e4) = wv; }
                if (k0 + 64 < D) { xh = *(const h16x8*)(xp + k0 + 64); wv = *(const f32x4*)(wp + (size_t)(k0 + 64) * NE); }
                __syncthreads();
#pragma unroll 4
                for (int k = 16 * kq; k < 16 * kq + 16; ++k) { const f32x4 h4 = *(const LAS f32x4*)(hsT + k * HP + 4 * rg), w4 = *(const LAS f32x4*)(wt + k * 32 + 4 * eg);
#pragma unroll
                    for (int a = 0; a < 4; ++a) acc[a] += h4[a] * w4; }
                __syncthreads();
            }
#pragma unroll
            for (int a = 0; a < 4; ++a) *(LAS f32x4*)(red + (kq * 64 + 4 * rg + a) * 32 + 4 * eg) = acc[a];
            __syncthreads();
            { const int row = F.tid >> 3, e0 = (F.tid & 7) * 4;
                f32x4 sum = *(const LAS f32x4*)(red + row * 32 + e0) + *(const LAS f32x4*)(red + (64 + row) * 32 + e0) + *(const LAS f32x4*)(red + (128 + row) * 32 + e0) + *(const LAS f32x4*)(red + (192 + row) * 32 + e0);
#pragma unroll
                for (int q = 0; q < 4; ++q) lg[row * 33 + e0 + q] = sum[q] + br[e0 + q]; }
            __syncthreads();
            if (F.tid < 64) { const int tok = rb * 64 + F.tid; float vals[4]; int idx[4]; unsigned taken = 0u;
#pragma unroll
                for (int k = 0; k < 4; ++k) { float best = -3.0e38f; int bi = 0;
                    for (int e = 0; e < NE; ++e) { const float x = lg[F.tid * 33 + e]; if (!((taken >> e) & 1u) && x > best) { best = x; bi = e; } }
                    taken |= 1u << bi; vals[k] = best; idx[k] = bi; }
                float den = 0.f, ex[4];
#pragma unroll
                for (int k = 0; k < 4; ++k) { ex[k] = __expf(vals[k] - vals[0]); den += ex[k]; }
#pragma unroll
                for (int k = 0; k < 4; ++k) { topi[tok * 4 + k] = idx[k]; topg[tok * 4 + k] = ex[k] / den; atomicAdd((int*)&hh[idx[k]], 1); }
            }
            __syncthreads();
            if (F.tid < 32) hist[rb * 32 + F.tid] = hh[F.tid];
        }
        __syncthreads();
    }
}

__device__ __forceinline__ void moe_place(Frame& F) {
    const int* topi = (const int*)(F.ws + WS_ROUTE + RT_TOPI); int* destp = (int*)(F.ws + WS_ROUTE + RT_DEST); const int* hist = (const int*)(F.ws + WS_ROUTE + RT_HIST);
    int* tile = (int*)(F.ws + WS_SMALL + SM_TILE);
    unsigned short* rowtok = (unsigned short*)(F.ws + WS_ROUTE + RT_ROWTOK);
    LAS int* tot = (LAS int*)F.lds; LAS int* pre = tot + 32; LAS int* pst = pre + 32; LAS int* es = pst + 32; LAS int* dst = es + 256;
    for (int rb = F.vcu; rb < NTOK / 64; rb += F.G) {
        if (F.tid < 64) tot[F.tid] = 0;
        __syncthreads();
        { const int e = F.tid & 31, part = F.tid >> 5; int sa = 0, sp = 0;
            for (int q = 0; q < 16; ++q) { const int bb = part * 16 + q; const int hv = hist[bb * 32 + e]; sa += hv; if (bb < rb) sp += hv; }
            atomicAdd((int*)&tot[e], sa); atomicAdd((int*)&pre[e], sp); }
        if (F.tid < 256) es[F.tid] = topi[rb * 256 + F.tid];
        __syncthreads();
        if (F.tid == 0) { int run = 0; for (int e = 0; e < NE; ++e) { pst[e] = run; run += (tot[e] + 255) & ~255; }
            if (rb == 0) tile[0] = run >> 8; }
        __syncthreads();
        if (rb == 0 && F.tid < NE) { const int e = F.tid, t0 = pst[e] >> 8, n = (tot[e] + 255) >> 8; for (int q = 0; q < n; ++q) tile[1 + t0 + q] = e; }
        LAS int* wcn = dst + 256;
        int myrank = 0; const int me = (F.tid < 256) ? es[F.tid] : -1;
        if (F.tid < 256) { for (int x = 0; x < NE; ++x) { const unsigned long long m = __ballot(me == x); if (me == x) myrank = __popcll(m & ((1ull << F.lane) - 1ull)); if (F.lane == 0) wcn[F.wave * 32 + x] = __popcll(m); } }
        __syncthreads();
        if (F.tid < 256) { int base = 0; for (int w2 = 0; w2 < F.wave; ++w2) base += wcn[w2 * 32 + me];
            const int d = pst[me] + pre[me] + base + myrank; dst[F.tid] = d; destp[rb * 256 + F.tid] = d; }
        __syncthreads();
        if (F.tid < 256) rowtok[dst[F.tid]] = (unsigned short)(rb * 64 + (F.tid >> 2));
        if (rb < NE) { const int e = rb, r0 = pst[e] + tot[e], r1 = pst[e] + ((tot[e] + 255) & ~255);
            for (int r = r0 + F.tid; r < r1; r += NTHR) rowtok[r] = 0; }
        __syncthreads();
    }
}

__device__ __forceinline__ int load_tile_table(Frame& F) {
    const int* tile = (const int*)(F.ws + WS_SMALL + SM_TILE);
    const int ntiles = __builtin_amdgcn_readfirstlane(tile[0]);
    LAS int* tl = (LAS int*)(F.lds + TILE_LDS_OFF);
    if (F.tid < 320) tl[F.tid] = tile[1 + F.tid];
    __syncthreads();
    return ntiles;
}
__device__ __forceinline__ void qk_norm_rope(Frame& F) {
    LAS float* cs = (LAS float*)F.lds;
    LAS float* sn = cs + 2048;
    for (int i = F.tid; i < 2048; i += NTHR) { const int pos = i >> 5, j = i & 31; const float inv = powf(10000.0f, -(float)(2 * j) / 64.0f); float s, c; sincosf((float)pos * inv, &s, &c); cs[i] = c; sn[i] = s; }
    __syncthreads();
    bf16_t* QKV = (bf16_t*)(F.ws + WS_SCR + SC_QKV);
    const float* qg = F.in[9]; const float* kg = F.in[10];
    const int gw = F.vcu * NWAVES + F.wave, NGW = F.G * NWAVES;
    const int hs = F.lane >> 5, i = F.lane & 31;
    const float gq1 = qg[hs * 64 + i], gq2 = qg[hs * 64 + 32 + i], gk1 = kg[hs * 64 + i], gk2 = kg[hs * 64 + 32 + i];
    for (int tok = gw; tok < NTOK; tok += NGW) {
        const int l = tok & (SEQ - 1), pos = hs ? (l & 63) : (l >> 6);
        bf16_t* p = QKV + (size_t)tok * QKVC + hs * 64 + i;
        float x1[12], x2[12];
#pragma unroll
        for (int hd = 0; hd < 12; ++hd) { x1[hd] = bf2f(p[hd * 128]); x2[hd] = bf2f(p[hd * 128 + 32]); }
        const float c = cs[pos * 32 + i], s = sn[pos * 32 + i];
#pragma unroll
        for (int hd = 0; hd < 12; ++hd) {
            const float ss = wave_sum(x1[hd] * x1[hd] + x2[hd] * x2[hd]), r = __builtin_amdgcn_rsqf(ss * (1.f / 128.f) + RMS_EPS);
            const float y1 = x1[hd] * r * (hd < 8 ? gq1 : gk1), y2 = x2[hd] * r * (hd < 8 ? gq2 : gk2);
            p[hd * 128] = f2bf(y1 * c - y2 * s); p[hd * 128 + 32] = f2bf(y2 * c + y1 * s); }
    }
}
__device__ __forceinline__ void attn_phase(Frame& F) {
    const bf16_t* QKV = (const bf16_t*)(F.ws + WS_SCR + SC_QKV); bf16_t* O = (bf16_t*)(F.ws + WS_SCR + SC_O);
    for (int id0 = F.vcu; id0 < 512; id0 += F.G) {
        const int bk = id0 >> 5, j = id0 & 31, b = bk >> 2, kvh = bk & 3, h = kvh * 2 + (j >> 4), qb = j & 15;
        const bf16_t* Qb = QKV + ((size_t)b * SEQ + qb * 256) * QKVC + h * 128;
        const bf16_t* Kh = QKV + ((size_t)b * SEQ) * QKVC + 1024 + kvh * 128;
        const bf16_t* Vh = QKV + ((size_t)b * SEQ) * QKVC + 1536 + kvh * 128;
        bf16_t* Ob = O + ((size_t)b * SEQ + qb * 256) * D + h * 128;
        att::attn_dense_body(Qb, Kh, Vh, Ob, SEQ, F.ldsg, F.wave);
    }
}

__device__ __forceinline__ void s5_scan_unit(Frame& F, int g, int b) {
    const float* S = (const float*)(F.ws + WS_SCR + SC_SST); bf16_t* AOP = (bf16_t*)(F.ws + WS_SCR + SC_AOP);
    const f32x2* aT = (const f32x2*)(F.ws + WS_SMALL + SM_AT);
    if (F.tid < 128) {
        const int p = F.tid & 63, dir = F.tid >> 6;
        const f32x2 a = aT[(dir * S5G + g) * S5P + p];
        const size_t rowbase = (size_t)g * 1024 + b * 256; const int n = dir * 128 + p;
        float er = 0.f, ei = 0.f;
        for (int jj = 0; jj < S5NCH; jj += 32) {
            float sr[32], si[32];
#pragma unroll
            for (int q = 0; q < 32; ++q) { const int j = dir ? (S5NCH - 1 - (jj + q)) : (jj + q); sr[q] = S[(rowbase + j) * 256 + n]; si[q] = S[(rowbase + j) * 256 + n + 64]; }
#pragma unroll
            for (int q = 0; q < 32; ++q) { const int j = dir ? (S5NCH - 1 - (jj + q)) : (jj + q);
                bf16_t* o = AOP + (rowbase + j) * 512 + 256 + n; o[0] = f2bf(er); o[64] = f2bf(ei);
                const float nr = a.x * er - a.y * ei + sr[q], ni = a.x * ei + a.y * er + si[q]; er = nr; ei = ni; }
        }
    }
}

namespace hg {
constexpr int PQ = 272, PK = 144;
constexpr int IMG_QD = 0, IMG_KLT = 64 * PQ, IMG_ATT = IMG_KLT + 128 * PK, IMG_DEC = IMG_ATT + 64 * PK, IMG_BYTES = IMG_DEC + 512, IMG_PIECES = IMG_BYTES / 16;
__device__ __forceinline__ bf16x8 ldsv(LAS unsigned char* base, int off) { return *(const LAS bf16x8*)(base + off); }
__device__ __forceinline__ unsigned char* img_ptr(unsigned char* ws, int b, int hh, int dir, int n) { return ws + WS_HGIMG + (size_t)((((b * 8 + hh) * 2 + dir) * 64) + n) * IMG_BYTES; }

__device__ __forceinline__ void hgrn_prep(Frame& F) {
    constexpr int RAWQ = 0, RAWF = 16384, KD = 32768, PS = KD + 64 * PQ, IMG = PS + 4096;
    const bf16_t* P = (const bf16_t*)(F.ws + WS_SCR + SC_P);
    const float* lbp = (const float*)(F.ws + WS_SMALL + SM_LB);
    LAS unsigned char* L = F.lds;
    const int tid = F.tid, lane = F.lane, w = F.wave, fr = lane & 15, fq = lane >> 4;
    const int d0 = 2 * lane, t0 = w * 8;
    unsigned rq[8], rf[8];
#define HG_LOAD(item_) do { const int n_ = (item_) & 63, dir_ = ((item_) >> 6) & 1, hh_ = ((item_) >> 7) & 7, b_ = (item_) >> 10; \
        _Pragma("unroll") for (int i_ = 0; i_ < 8; ++i_) { const int tau = n_ * 64 + t0 + i_; const size_t l_ = dir_ ? (size_t)(SEQ - 1 - tau) : (size_t)tau; \
            const bf16_t* row_ = P + ((size_t)b_ * SEQ + l_) * 5120 + hh_ * 128 + d0; rq[i_] = *(const unsigned*)(row_); rf[i_] = *(const unsigned*)(row_ + 1024 * (1 + dir_)); } } while (0)
    int item = F.vcu;
    if (item < 4096) HG_LOAD(item);
    for (; item < 4096; item += F.G) {
        const int n = item & 63, dir = (item >> 6) & 1, hh = (item >> 7) & 7, b = item >> 10;
        const float lb0 = lbp[hh * 128 + d0], lb1 = lbp[hh * 128 + d0 + 1], om0 = 1.f - lb0, om1 = 1.f - lb1;
        unsigned cq[8], cf[8];
#pragma unroll
        for (int i = 0; i < 8; ++i) { cq[i] = rq[i]; cf[i] = rf[i]; }
        if (item + F.G < 4096) HG_LOAD(item + F.G);
        float cs0[8], cs1[8], k0[8], k1[8]; float c0 = 1.f, c1 = 1.f;
#pragma unroll
        for (int i = 0; i < 8; ++i) { const unsigned fw = cf[i];
            const float s0 = sigmoidf_(bflo(fw)), s1 = sigmoidf_(bfhi(fw));
            c0 *= lb0 + om0 * s0; c1 *= lb1 + om1 * s1; cs0[i] = c0; cs1[i] = c1; k0[i] = om0 * (1.f - s0); k1[i] = om1 * (1.f - s1); }
        *(LAS f32x2*)(L + PS + (w * 128 + d0) * 4) = (f32x2){c0, c1};
        __syncthreads();
        float off0 = 1.f, off1 = 1.f, tot0 = 1.f, tot1 = 1.f;
#pragma unroll
        for (int q = 0; q < 8; ++q) { const f32x2 x = *(const LAS f32x2*)(L + PS + (q * 128 + d0) * 4); tot0 *= x.x; tot1 *= x.y; if (q < w) { off0 *= x.x; off1 *= x.y; } }
        float kl0[8], kl1[8]; const float et0 = tot0, et1 = tot1;
        const float ri0 = __builtin_amdgcn_rcpf(off0 * cs0[7]), ri1 = __builtin_amdgcn_rcpf(off1 * cs1[7]); float suf0 = 1.f, suf1 = 1.f;
#pragma unroll
        for (int i = 7; i >= 0; --i) { const int t = t0 + i;
            const unsigned qw = cq[i]; const float q0 = bflo(qw), q1 = bfhi(qw);
            const float e0 = off0 * cs0[i], e1 = off1 * cs1[i], r0 = ri0 * suf0, r1 = ri1 * suf1; suf0 *= 1.f - k0[i]; suf1 *= 1.f - k1[i];
            *(LAS unsigned*)(L + IMG + IMG_QD + t * PQ + d0 * 2) = cvt_pk_bf16(siluf_(q0) * e0, siluf_(q1) * e1);
            *(LAS unsigned*)(L + KD + t * PQ + d0 * 2) = cvt_pk_bf16(k0[i] * r0, k1[i] * r1);
            kl0[i] = k0[i] * r0 * et0; kl1[i] = k1[i] * r1 * et1; }
        *(LAS u32x4*)(L + IMG + IMG_KLT + d0 * PK + t0 * 2) = (u32x4){cvt_pk_bf16(kl0[0], kl0[1]), cvt_pk_bf16(kl0[2], kl0[3]), cvt_pk_bf16(kl0[4], kl0[5]), cvt_pk_bf16(kl0[6], kl0[7])};
        *(LAS u32x4*)(L + IMG + IMG_KLT + (d0 + 1) * PK + t0 * 2) = (u32x4){cvt_pk_bf16(kl1[0], kl1[1]), cvt_pk_bf16(kl1[2], kl1[3]), cvt_pk_bf16(kl1[4], kl1[5]), cvt_pk_bf16(kl1[6], kl1[7])};
        if (w == 0) *(LAS f32x2*)(L + IMG + IMG_DEC + d0 * 4) = (f32x2){et0, et1};
        __syncthreads();
        { const int a = w >> 1;
#pragma unroll
            for (int bi = 0; bi < 2; ++bi) { const int bt_ = (w & 1) * 2 + bi; f32x4 acc = {0.f, 0.f, 0.f, 0.f};
#pragma unroll
                for (int ks = 0; ks < 4; ++ks) { const bf16x8 X = ldsv(L, KD + (16 * bt_ + fr) * PQ + (ks * 32 + 8 * fq) * 2), Y = ldsv(L, IMG + IMG_QD + (16 * a + fr) * PQ + (ks * 32 + 8 * fq) * 2);
                    acc = __builtin_amdgcn_mfma_f32_16x16x32_bf16(X, Y, acc, 0, 0, 0); }
                const int t = 16 * a + fr, s0 = 16 * bt_ + 4 * fq;
                const float v0 = (s0 + 0 <= t) ? acc[0] : 0.f, v1 = (s0 + 1 <= t) ? acc[1] : 0.f, v2 = (s0 + 2 <= t) ? acc[2] : 0.f, v3 = (s0 + 3 <= t) ? acc[3] : 0.f;
                *(LAS u32x2*)(L + IMG + IMG_ATT + t * PK + s0 * 2) = (u32x2){cvt_pk_bf16(v0, v1), cvt_pk_bf16(v2, v3)}; } }
        __syncthreads();
        { unsigned char* g = img_ptr(F.ws, b, hh, dir, n);
#pragma unroll
            for (int it = 0; it < 6; ++it) { const int pc = it * 512 + tid; if (pc < IMG_PIECES) *(u32x4*)(g + pc * 16) = *(const LAS u32x4*)(L + IMG + pc * 16); } }
    }
    __syncthreads();
#undef HG_LOAD
}

__device__ __forceinline__ void hgrn_rec(Frame& F) {
    constexpr int IMG0 = 0, IMG1 = IMG_BYTES, VT = 2 * IMG_BYTES, ST = VT + 2 * 32 * PK;
    const bf16_t* P = (const bf16_t*)(F.ws + WS_SCR + SC_P); float* OFB = (float*)(F.ws + WS_SCR + SC_OFB);
    LAS unsigned char* L = F.lds;
    const int tid = F.tid, lane = F.lane, w = F.wave, fr = lane & 15, fq = lane >> 4;
    for (int unit = F.vcu; unit < 256; unit += F.G) {
        const int vs = unit & 3, dir = (unit >> 2) & 1, hh = (unit >> 3) & 7, b = unit >> 6;
        const size_t tok0 = (size_t)b * SEQ; const int cv = 3072 + hh * 128 + vs * 32;
        for (int i = tid; i < 2 * 32 * PQ / 4; i += NTHR) ((LAS unsigned*)(L + ST))[i] = 0u;
        f32x4 sacc[2] = {(f32x4){0.f, 0.f, 0.f, 0.f}, (f32x4){0.f, 0.f, 0.f, 0.f}};
        u32x4 rv = {0u, 0u, 0u, 0u};
#define HG_DMA(n_, buf_) do { const unsigned char* g_ = img_ptr(F.ws, b, hh, dir, (n_)); _Pragma("unroll") for (int it = 0; it < 6; ++it) { const int pc = it * 512 + tid; \
            if (pc < IMG_PIECES) __builtin_amdgcn_global_load_lds((const unsigned*)(g_ + (size_t)pc * 16), (LAS unsigned*)(L + (buf_) + (it * 512 + w * 64) * 16), 16, 0, 0); } } while (0)
#define HG_LOADV(n_) do { if (tid < 256) { const int t_ = tid >> 2, v8 = (tid & 3) * 8; const int tau = (n_) * 64 + t_; const size_t l_ = dir ? (size_t)(SEQ - 1 - tau) : (size_t)tau; rv = *(const u32x4*)(P + (tok0 + l_) * 5120 + cv + v8); } } while (0)
        HG_DMA(0, IMG0); HG_LOADV(0);
        for (int n = 0; n < HGNCH; ++n) {
            const int cur = n & 1, nxt = cur ^ 1; LAS unsigned char* I = L + (cur ? IMG1 : IMG0); LAS unsigned char* V = L + VT + cur * 32 * PK;
            VM_WAIT();
            if (tid < 256) { const int s = tid >> 2, v8 = (tid & 3) * 8; const unsigned wv[4] = {rv.x, rv.y, rv.z, rv.w};
#pragma unroll
                for (int q = 0; q < 4; ++q) { *(LAS unsigned short*)(V + (v8 + 2 * q) * PK + s * 2) = (unsigned short)(wv[q] & 0xffffu); *(LAS unsigned short*)(V + (v8 + 2 * q + 1) * PK + s * 2) = (unsigned short)(wv[q] >> 16); } }
            __syncthreads();
            if (n + 1 < HGNCH) { if (nxt) HG_DMA(n + 1, IMG1); else HG_DMA(n + 1, IMG0); HG_LOADV(n + 1); }
            { const int a = w >> 1, cvt = w & 1; f32x4 acc = {0.f, 0.f, 0.f, 0.f};
#pragma unroll
                for (int ks = 0; ks < 2; ++ks) { const bf16x8 X = ldsv(V, (16 * cvt + fr) * PK + (ks * 32 + 8 * fq) * 2), Y = ldsv(I, IMG_ATT + (16 * a + fr) * PK + (ks * 32 + 8 * fq) * 2);
                    acc = __builtin_amdgcn_mfma_f32_16x16x32_bf16(X, Y, acc, 0, 0, 0); }
#pragma unroll
                for (int ks = 0; ks < 4; ++ks) { const bf16x8 X = ldsv(L, ST + cur * 32 * PQ + (16 * cvt + fr) * PQ + (ks * 32 + 8 * fq) * 2), Y = ldsv(I, IMG_QD + (16 * a + fr) * PQ + (ks * 32 + 8 * fq) * 2);
                    acc = __builtin_amdgcn_mfma_f32_16x16x32_bf16(X, Y, acc, 0, 0, 0); }
                { const int tau = n * 64 + 16 * a + fr; const size_t l_ = dir ? (size_t)(SEQ - 1 - tau) : (size_t)tau;
                    *(f32x4*)(OFB + ((size_t)dir * NTOK + tok0 + l_) * D + hh * 128 + vs * 32 + 16 * cvt + 4 * fq) = acc; }
#pragma unroll
                for (int i = 0; i < 2; ++i) { const int e = (w >> 1) * 2 + i; f32x4 a2 = {0.f, 0.f, 0.f, 0.f};
#pragma unroll
                    for (int ks = 0; ks < 2; ++ks) { const bf16x8 X = ldsv(I, IMG_KLT + (16 * e + fr) * PK + (ks * 32 + 8 * fq) * 2), Y = ldsv(V, (16 * cvt + fr) * PK + (ks * 32 + 8 * fq) * 2);
                        a2 = __builtin_amdgcn_mfma_f32_16x16x32_bf16(X, Y, a2, 0, 0, 0); }
                    const f32x4 dc = *(const LAS f32x4*)(I + IMG_DEC + (16 * e + 4 * fq) * 4);
                    sacc[i] = dc * sacc[i] + a2;
                    *(LAS u32x2*)(L + ST + nxt * 32 * PQ + (16 * cvt + fr) * PQ + (16 * e + 4 * fq) * 2) = (u32x2){cvt_pk_bf16(sacc[i][0], sacc[i][1]), cvt_pk_bf16(sacc[i][2], sacc[i][3])}; } }
        }
        VM_WAIT(); __syncthreads();
#undef HG_DMA
#undef HG_LOADV
    }
}
__device__ __forceinline__ void hgrn_combine(Frame& F) {
    const float* OFB = (const float*)(F.ws + WS_SCR + SC_OFB); const bf16_t* P = (const bf16_t*)(F.ws + WS_SCR + SC_P); bf16_t* HA = (bf16_t*)(F.ws + WS_SCR + SC_HA);
    const float* ng = F.in[24];
    const int gw = F.vcu * NWAVES + F.wave, NGW = F.G * NWAVES;
    for (int row0 = gw; row0 < NTOK; row0 += 2 * NGW) {
        f32x4 a[2][4], bq[2][4]; u32x2 gw_[2][4];
#pragma unroll
        for (int rr = 0; rr < 2; ++rr) { const int row = row0 + rr * NGW;
#pragma unroll
            for (int j = 0; j < 4; ++j) { const int col = 256 * j + 4 * F.lane; a[rr][j] = *(const f32x4*)(OFB + (size_t)row * D + col); bq[rr][j] = *(const f32x4*)(OFB + ((size_t)NTOK + row) * D + col); gw_[rr][j] = *(const u32x2*)(P + (size_t)row * 5120 + 4096 + col); } }
#pragma unroll
        for (int rr = 0; rr < 2; ++rr) { const int row = row0 + rr * NGW;
#pragma unroll
            for (int j = 0; j < 4; ++j) { const int col = 256 * j + 4 * F.lane; const f32x4 o = a[rr][j] + bq[rr][j];
                float ss = (o[0] * o[0] + o[1] * o[1]) + (o[2] * o[2] + o[3] * o[3]);
                ss = half_wave_sum(ss);
                const float r = __builtin_amdgcn_rsqf(ss * (1.f / 128.f) + RMS_EPS);
                const f32x4 gn = *(const f32x4*)(ng + col);
                const float g0 = bflo(gw_[rr][j].x), g1 = bfhi(gw_[rr][j].x), g2 = bflo(gw_[rr][j].y), g3 = bfhi(gw_[rr][j].y);
                const float r0 = o[0] * r * gn[0] * siluf_(g0), r1 = o[1] * r * gn[1] * siluf_(g1), r2 = o[2] * r * gn[2] * siluf_(g2), r3 = o[3] * r * gn[3] * siluf_(g3);
                *(u32x2*)(HA + (size_t)row * D + col) = (u32x2){cvt_pk_bf16(r0, r1), cvt_pk_bf16(r2, r3)}; } }
    }
}
}
#ifndef PROBE_KIND
#define PROBE_KIND 0
#endif
constexpr int probe_reps(int id) {
    const int k = (id >= 1 && id <= 64) ? (id - 1) % 16 : -1, layer = (id >= 1 && id <= 64) ? (id - 1) / 16 : -1;
    return (PROBE_KIND == 1 && (k == 8 || k == 9)) ? 2 : (PROBE_KIND == 2 && id == 0) ? 2 : (PROBE_KIND == 3 && layer == 3 && (k == 2 || k == 3)) ? 2 : (PROBE_KIND == 4 && layer == 1 && k == 3) ? 2 :
           (PROBE_KIND == 5 && layer == 0 && k == 1) ? 2 : (PROBE_KIND == 6 && k == 7) ? 2 : (PROBE_KIND == 8 && layer == 2 && k >= 1 && k <= 5) ? 2 : (PROBE_KIND == 9 && layer == 3 && k == 1) ? 2 : (PROBE_KIND == 11 && layer == 3 && k == 2) ? 2 : (PROBE_KIND == 17 && layer == 3 && k == 3) ? 2 : (PROBE_KIND == 18 && layer == 3 && k == 4) ? 2 : (PROBE_KIND == 19 && layer == 1 && k == 2) ? 2 : (PROBE_KIND == 20 && layer == 2 && k == 2) ? 2 : (PROBE_KIND == 21 && layer == 0 && k == 0) ? 2 : 1;
}
#define IN(id) (lo <= (id) && (id) < hi)
#define SEAM(id) do { if ((id) + 1 < hi) { xcd_barrier(bar); if (PROBE_KIND == 7) xcd_barrier(bar); } } while (0)
#define RUN(id, ...) do { if (IN(id)) { _Pragma("unroll") for (int rep_ = 0; rep_ < probe_reps(id); ++rep_) { F.lane = lane_now(); F.tid = F.wave * 64 + F.lane; __VA_ARGS__; SEAM(id); } } } while (0)
constexpr int FILL_PER_SLOT = 3;
template <int layer> __device__ __forceinline__ void layer_body(Frame& F, const int lo, const int hi, const XcdBarrier& bar) {
    unsigned char* const ws = F.ws; const char* wsm = (const char*)(ws + WS_WSM);
        constexpr int pb = 1 + 16 * layer;
        RUN(pb, rowpass(F, layer, 0));
        if constexpr (layer == 0) {
            RUN(pb + 1, {
                pg8::Gemm g{(const char*)(ws + WS_DFTL), (const char*)(ws + WS_H), SEQ / 2, SEQ / 2, SEQ / 2};
                {
                    const unsigned char* hT = ws + WS_H; bf16_t* C1 = (bf16_t*)(ws + WS_SCR + SC_C1);
                    for (int rowi = F.vcu * NWAVES + F.wave; rowi < NB * D; rowi += F.G * NWAVES) { float sgn = 0.f;
                        _Pragma("unroll") for (int q = 0; q < 4; ++q) { const u32x4 w4 = *(const u32x4*)(hT + (size_t)rowi * SEQ + F.lane * 64 + q * 16);
                            _Pragma("unroll") for (int d = 0; d < 4; ++d) { const int w = (int)w4[d]; const f32x2 lo = __builtin_amdgcn_cvt_pk_f32_fp8(w, false), hi = __builtin_amdgcn_cvt_pk_f32_fp8(w, true); sgn += (lo.x - lo.y) + (hi.x - hi.y); } }
                        sgn = wave_sum(sgn) * (1.0f / (S8_H * 64.0f));
                        if (F.lane == 0) { const int b = rowi >> 10, ch = rowi & 1023; bf16_t* o = C1 + (((size_t)b * SEQ + 2048) * 4 + (ch >> 8)) * 512 + (ch & 255); o[0] = f2bf(sgn); o[256] = f2bf(0.f); } } }
                pg8::Order<MapF1> S; S.init(16, 4, NB, F.G, F.vcu, MapF1{});
                EpiBf16 E{(bf16_t*)(ws + WS_SCR + SC_C1), 2048, 1.0f / (256.0f * S8_H * 64.0f)};
                pg8::gemm_phase<EpiBf16, pg8::Order<MapF1>, true>(F.lds, F.wave, g, S, E); });
            RUN(pb + 2, {
                pg8::Gemm g{(const char*)(ws + WS_SCR + SC_C1), (const char*)(ws + WS_SMALL + SM_DFTC), 512, 512, 512};
                pg8::Order<MapF2h> S; S.init(4 * 33, 1, 1, F.G, F.vcu, MapF2h{});
                EpiF2 E{(bf16_t*)(ws + WS_SCR + SC_MIX)};
                pg8::gemm_phase(F.lds, F.wave, g, S, E);
                if (F.vcu >= 4 * 33) deferred_fill(F, 2); });
            RUN(pb + 3, {
                pg8::Gemm g{(const char*)(ws + WS_SCR + SC_MIX), wsm + W_FNET, D, D, D};
                pg8::Order<MapPlain> S; S.init(64, 4, 1, F.G, F.vcu, MapPlain{D, D, D});
                EpiBf16B E{(bf16_t*)(ws + WS_Y), D, 1.f, F.in[7]};
                pg8::gemm_phase(F.lds, F.wave, g, S, E); });
        }
        if constexpr (layer == 1) {
            RUN(pb + 1, {
                LAS unsigned* cs2 = (LAS unsigned*)(F.lds + pg8::BIAS_LDS_OFF);
                for (int i = F.tid; i < 2048; i += NTHR) { const int pos = i >> 5, j = i & 31; const float inv = powf(10000.0f, -(float)(2 * j) / 64.0f); float sn_, cs_; sincosf((float)pos * inv, &sn_, &cs_); cs2[i] = cvt_pk_bf16(cs_, sn_); }
                __syncthreads();
                pg8::Gemm g{(const char*)(ws + WS_H), wsm + W_QKV, D / 2, 64, D / 2, 128, 32768};
                pg8::Order<MapPlain> S; S.init(64, 8, 1, F.G, F.vcu, MapPlain{D / 2, D / 2, QKVC});
                EpiQKV E{(bf16_t*)(ws + WS_SCR + SC_QKV), 1.0f / (S8_H * S8_WGU), F.in[9], F.in[10], cs2};
                pg8::gemm_phase<EpiQKV, pg8::Order<MapPlain>, true>(F.lds, F.wave, g, S, E); });
            RUN(pb + 3, attn_phase(F));
            RUN(pb + 4, {
                pg8::Gemm g{(const char*)(ws + WS_SCR + SC_O), wsm + W_AO, D, D, D};
                pg8::Order<MapPlain> S; S.init(64, 4, 1, F.G, F.vcu, MapPlain{D, D, D});
                EpiBf16 E{(bf16_t*)(ws + WS_Y), D};
                pg8::gemm_phase(F.lds, F.wave, g, S, E); });
        }
        if constexpr (layer == 2) {
            RUN(pb + 1, {
                pg8::Gemm g{(const char*)(ws + WS_SCR + SC_AOP), (const char*)(ws + WS_S5M), 512, 256, 256};
                pg8::Order<MapS5> S; S.init(4, 1, S5G, F.G, F.vcu, MapS5{256});
                EpiF32 E{(float*)(ws + WS_SCR + SC_SST), 256, nullptr};
                pg8::gemm_phase(F.lds, F.wave, g, S, E);
                VM_WAIT(); __syncthreads(); __builtin_amdgcn_fence(__ATOMIC_ACQUIRE, "agent"); VM_WAIT();
                { pg8::Unit uu; for (int i = 0; S.next(i, uu); ++i) s5_scan_unit(F, uu.z, uu.pm); } });
            RUN(pb + 3, {
                pg8::Gemm g{(const char*)(ws + WS_SCR + SC_AOP), (const char*)(ws + WS_S5T), 512, 512, 512};
                pg8::Order<MapS5> S; S.init(4, 1, S5G, F.G, F.vcu, MapS5{512});
                EpiS5Out E{(bf16_t*)(ws + WS_SCR + SC_YBF)};
                pg8::gemm_phase(F.lds, F.wave, g, S, E); });
            RUN(pb + 4, {
                pg8::Gemm g{(const char*)(ws + WS_SCR + SC_YBF), wsm + W_GLU, D, D, D};
                pg8::Order<MapPlain> S; S.init(64, 4, 1, F.G, F.vcu, MapPlain{D, D, D});
                EpiGlu E{(const bf16_t*)(ws + WS_SCR + SC_YBF), (bf16_t*)(ws + WS_SCR + SC_Z)};
                pg8::gemm_phase(F.lds, F.wave, g, S, E); });
            RUN(pb + 5, {
                pg8::Gemm g{(const char*)(ws + WS_SCR + SC_Z), wsm + W_SO, D, D, D};
                pg8::Order<MapPlain> S; S.init(64, 4, 1, F.G, F.vcu, MapPlain{D, D, D});
                EpiBf16 E{(bf16_t*)(ws + WS_Y), D};
                pg8::gemm_phase(F.lds, F.wave, g, S, E); });
        }
        if constexpr (layer == 3) {
            RUN(pb + 1, {
                pg8::Gemm g{(const char*)(ws + WS_H), wsm + W_HIN, D / 2, 64, D / 2, 128, 32768};
                pg8::Order<MapPlain> S; S.init(64, 20, 1, F.G, F.vcu, MapPlain{D / 2, D / 2, 5 * D});
                EpiBf16 E{(bf16_t*)(ws + WS_SCR + SC_P), 5 * D, 1.0f / (S8_H * S8_WGU)};
                pg8::gemm_phase<EpiBf16, pg8::Order<MapPlain>, true>(F.lds, F.wave, g, S, E); });
            RUN(pb + 2, hg::hgrn_prep(F));
            RUN(pb + 3, hg::hgrn_rec(F));
            RUN(pb + 4, hg::hgrn_combine(F));
            RUN(pb + 5, {
                pg8::Gemm g{(const char*)(ws + WS_SCR + SC_HA), wsm + W_HO, D, D, D};
                pg8::Order<MapPlain> S; S.init(64, 4, 1, F.G, F.vcu, MapPlain{D, D, D});
                EpiBf16 E{(bf16_t*)(ws + WS_Y), D};
                pg8::gemm_phase(F.lds, F.wave, g, S, E); });
        }
        RUN(pb + 6, rowpass(F, layer, 1));
        RUN(pb + 7, { moe_place(F); if (layer == DEPTH - 1) deferred_fill(F, -1); });
        RUN(pb + 8, {
            const int ntiles = load_tile_table(F); const LAS int* tile = (const LAS int*)(F.lds + TILE_LDS_OFF) - 1;
            pg8::Gemm g{(const char*)(ws + WS_H), (const char*)(ws + WS_WGU), D / 2, 64, D / 2, 128, 32768};
            pg8::Order<MapMoe> S; S.init(ntiles, 8, 1, F.G, F.vcu, MapMoe{tile + 1, (size_t)layer * NE * 2 * DEX * D, 2 * DEX, 0});
            LAS unsigned short* tbl = (LAS unsigned short*)(F.lds + ROWTBL_LDS_OFF);
            { const unsigned short* rowtok = (const unsigned short*)(ws + WS_ROUTE + RT_ROWTOK);
                int pms[ROWTBL_MAXU];
                _Pragma("unroll") for (int i = 0; i < ROWTBL_MAXU; ++i) { pg8::Unit uu; pms[i] = S.next(i, uu) ? uu.pm : -1; }
                if (F.tid < 256) { unsigned short vals[ROWTBL_MAXU];
                    _Pragma("unroll") for (int i = 0; i < ROWTBL_MAXU; ++i) vals[i] = (pms[i] >= 0) ? rowtok[pms[i] * 256 + F.tid] : (unsigned short)0;
                    _Pragma("unroll") for (int i = 0; i < ROWTBL_MAXU; ++i) tbl[i * 256 + F.tid] = vals[i]; }
                __syncthreads(); }
            EpiMoeGU E{ws + WS_SCR + SC_ACT, F.in[29] + (size_t)layer * NE * 2 * DEX};
            pg8::gemm_phase<EpiMoeGU, pg8::Order<MapMoe>, true, true>(F.lds, F.wave, g, S, E, tbl);
            if (layer < DEPTH - 1) { const int total = ntiles * 8, maxu = (total + F.G - 1) / F.G, mine = (F.vcu < total) ? (total - F.vcu + F.G - 1) / F.G : 0; deferred_fill(F, (maxu - mine) * FILL_PER_SLOT); }
            if (PROBE_KIND >= 13 && PROBE_KIND <= 15) { xcd_barrier(bar); EpiNull E0; S.mp.probe = PROBE_KIND - 13; pg8::gemm_phase<EpiNull, pg8::Order<MapMoe>, true, true>(F.lds, F.wave, g, S, E0, tbl); } });
        RUN(pb + 9, {
            const int ntiles = load_tile_table(F); const LAS int* tile = (const LAS int*)(F.lds + TILE_LDS_OFF) - 1;
            pg8::Gemm g{(const char*)(ws + WS_SCR + SC_ACT), (const char*)(ws + WS_WDN), 64, 64, DEX / 2, 32768, 32768};
            pg8::Order<MapMoe> S; S.init(ntiles, 4, 1, F.G, F.vcu, MapMoe{tile + 1, (size_t)layer * NE * D * DEX, D});
            EpiMoeDown E{ws + WS_SCR + SC_DNO, F.in[31] + (size_t)layer * NE * D};
            pg8::gemm_phase<EpiMoeDown, pg8::Order<MapMoe>, true>(F.lds, F.wave, g, S, E);
            if (layer < DEPTH - 1) { const int total = ntiles * 4, maxu = (total + F.G - 1) / F.G, mine = (F.vcu < total) ? (total - F.vcu + F.G - 1) / F.G : 0; deferred_fill(F, (maxu - mine) * FILL_PER_SLOT); }
            if (PROBE_KIND >= 13 && PROBE_KIND <= 15) { xcd_barrier(bar); EpiNull E0; S.mp.probe = PROBE_KIND - 13; pg8::gemm_phase<EpiNull, pg8::Order<MapMoe>, true>(F.lds, F.wave, g, S, E0); } });
}
constexpr int PH_END = 66;
__global__ void __launch_bounds__(NTHR, 2) fwd_kernel(Args args) {
    extern __shared__ __attribute__((aligned(16))) unsigned char lds_raw[];
    Frame F;
    F.lds = (LAS unsigned char*)lds_raw; F.ldsg = (char*)lds_raw;
    F.tid = threadIdx.x; F.lane = F.tid & 63; F.wave = __builtin_amdgcn_readfirstlane(F.tid >> 6);
    F.G = gridDim.x; { const int bx = blockIdx.x; F.vcu = (F.G % 8 == 0) ? (bx % 8) * (F.G / 8) + bx / 8 : bx; }
    F.in = args.in; F.out = args.out; F.ws = args.ws;
    volatile LAS unsigned* MISC = (volatile LAS unsigned*)(F.lds + MISC_OFF);
    for (int u = F.tid; u < (LDS_BYTES - LDSCTL_OFF) / 4; u += NTHR) ((LAS unsigned*)(F.lds + LDSCTL_OFF))[u] = 0u;
    __syncthreads();
    const int lo = args.ph_lo, hi = args.ph_hi;
    XcdBarrier bar; bar.bar = (unsigned*)(F.ws + WS_CTL) + 4096; bar.x = 0; bar.st = MISC + 8; bar.wave = F.wave;
    if (hi - lo > 1) bar = xcd_barrier_post((unsigned*)(F.ws + WS_CTL) + 4096, MISC + 8, F.wave);
    unsigned char* const ws = F.ws;
    const char* wsm = (const char*)(ws + WS_WSM);

    RUN(0, p0_prologue(F));

    layer_body<0>(F, lo, hi, bar); layer_body<1>(F, lo, hi, bar); layer_body<2>(F, lo, hi, bar); layer_body<3>(F, lo, hi, bar);
    if (IN(65)) { F.lane = lane_now(); F.tid = F.wave * 64 + F.lane; rowpass(F, DEPTH, 0); }
}

#ifndef MK_ONE_LAUNCH
#define MK_ONE_LAUNCH 1
#endif
extern "C" void kernel_launch(void* const* d_in, const int* in_sizes, int n_in, void* d_out, int out_size, void* d_ws, size_t ws_size, hipStream_t stream) {
    static int grid = 0;
    if (grid == 0) {
        if (n_in != 32 || out_size != NTOK * D || ws_size < WS_END) { fprintf(stderr, "kernel_launch: unexpected shapes (n_in %d out %d ws %zu, need ws >= %zu)\n", n_in, out_size, ws_size, (size_t)WS_END); grid = -1; return; }
        int dev = 0, cus = 0, per_cu = 0;
        if (hipGetDevice(&dev) != hipSuccess || hipDeviceGetAttribute(&cus, hipDeviceAttributeMultiprocessorCount, dev) != hipSuccess) { grid = -1; return; }
        if (hipFuncSetAttribute((const void*)fwd_kernel, hipFuncAttributeMaxDynamicSharedMemorySize, LDS_BYTES) != hipSuccess) { fprintf(stderr, "kernel_launch: hipFuncSetAttribute failed\n"); grid = -1; return; }
        if (hipOccupancyMaxActiveBlocksPerMultiprocessor(&per_cu, (const void*)fwd_kernel, NTHR, LDS_BYTES) != hipSuccess || per_cu < 1)
            fprintf(stderr, "kernel_launch: occupancy query reports %d blocks per CU\n", per_cu);
        (void)hipGetLastError();
        grid = cus;
    }
    if (grid < 0) return;
    (void)hipMemsetAsync((char*)d_ws + WS_CTL, 0, CTL_ZERO_BYTES, stream);
    Args a{};
    for (int i = 0; i < 32; ++i) a.in[i] = (const float*)d_in[i];
    a.out = (float*)d_out; a.ws = (unsigned char*)d_ws;
#if MK_ONE_LAUNCH
    a.ph_lo = 0; a.ph_hi = PH_END;
    hipLaunchKernelGGL(fwd_kernel, dim3(grid), dim3(NTHR), LDS_BYTES, stream, a);
#else
    static const int nmix[4] = {3, 4, 5, 5};
    int ids[80], n = 0; ids[n++] = 0;
    for (int l = 0; l < DEPTH; ++l) { const int pb = 1 + 16 * l; ids[n++] = pb; for (int k = 1; k <= nmix[l]; ++k) ids[n++] = pb + k; for (int k = 6; k <= 9; ++k) ids[n++] = pb + k; }
    ids[n++] = 65;
    for (int i = 0; i < n; ++i) { a.ph_lo = ids[i]; a.ph_hi = ids[i] + 1; hipLaunchKernelGGL(fwd_kernel, dim3(grid), dim3(NTHR), LDS_BYTES, stream, a); }
#endif
    const hipError_t le = hipPeekAtLastError();
    if (le != hipSuccess) fprintf(stderr, "kernel_launch: launch failed: %s\n", hipGetErrorName(le));
}
```
